# Optimizing an MI355X kernel written in HIP

```python
import math
import jax, jax.numpy as jnp
from jax import lax
import numpy as np

D_MODEL = 2048
BATCH = 1
SEQ = 16384
DEPTH = 1

D_MIX = D_MODEL
ATTN_WIDTH = D_MIX // 2
REC_WIDTH = D_MIX - ATTN_WIDTH
DA_HEAD_DIM = 128
DA_HEADS = ATTN_WIDTH // (2 * DA_HEAD_DIM)
REC_BLOCKS = 8
REC_BLOCK_DIM = REC_WIDTH // REC_BLOCKS
CONV_W = 4
RG_C = 8.0
IN_PROJ_DIM = 3 * ATTN_WIDTH + 2 * REC_WIDTH
Q_BLOCK = 128
N_MEM = 256
CROSS_HEADS = 4
CROSS_HEAD_DIM = D_MODEL // CROSS_HEADS
N_EXPERTS = 32
TOP_K = 4
D_FF = D_MODEL
SWIGLU_LIMIT = 7.0
SWIGLU_ALPHA = 1.702
MOE_BLOCK = 128
EPS = 1e-6
DA_EPS = 1e-5

kernel_name = "hymba_diffattn_rglru_moe_layer"


def rmsnorm(x, g, eps=EPS):
    x32 = x.astype(jnp.float32)
    y = x32 * lax.rsqrt(jnp.mean(x32 * x32, axis=-1, keepdims=True) + eps)
    return (y * g.astype(jnp.float32)).astype(x.dtype)


def diff_attention(q, k, v, lq1, lk1, lq2, lk2, subln_g, lambda_init):
    B, S, _ = q.shape
    nb = S // Q_BLOCK
    out_dtype = q.dtype
    qb = q.reshape(B, nb, Q_BLOCK, DA_HEADS, 2, DA_HEAD_DIM).transpose(1, 0, 3, 4, 2, 5).astype(jnp.float32)
    kh = k.reshape(B, S, DA_HEADS, 2, DA_HEAD_DIM).transpose(0, 2, 3, 1, 4).astype(jnp.float32)
    vh = v.reshape(B, S, DA_HEADS, 2 * DA_HEAD_DIM).transpose(0, 2, 1, 3).astype(jnp.float32)
    f32 = jnp.float32
    lam = (jnp.exp(jnp.sum(lq1.astype(f32) * lk1.astype(f32)))
           - jnp.exp(jnp.sum(lq2.astype(f32) * lk2.astype(f32))) + lambda_init)
    scale = DA_HEAD_DIM ** -0.5
    k_pos = jnp.arange(S)

    def one_block(args):
        q_blk, blk = args
        q_pos = blk * Q_BLOCK + jnp.arange(Q_BLOCK)
        s = jnp.einsum('bhiqd,bhikd->bhiqk', q_blk, kh) * scale
        s = jnp.where(k_pos[None, :] <= q_pos[:, None], s, -jnp.inf)
        p = jax.nn.softmax(s, axis=-1)
        a = p[:, :, 0] - lam * p[:, :, 1]
        return jnp.einsum('bhqk,bhkd->bhqd', a, vh)

    o = lax.map(one_block, (qb, jnp.arange(nb)))
    o = o.transpose(1, 0, 3, 2, 4).reshape(B, S, DA_HEADS, 2 * DA_HEAD_DIM)
    o = rmsnorm(o, subln_g, DA_EPS) * (1.0 - lambda_init)
    return o.reshape(B, S, ATTN_WIDTH).astype(out_dtype)


def rg_lru_group(xr, xg, conv_w, conv_b, w_a, b_a, w_x, b_x, rg_lambda, rec_norm_g):
    B, S, C = xr.shape
    xc = lax.conv_general_dilated(
        xr, conv_w[:, None, :].astype(xr.dtype), window_strides=(1,),
        padding=[(CONV_W - 1, 0)], dimension_numbers=('NWC', 'WIO', 'NWC'),
        feature_group_count=C) + conv_b
    xb = xc.reshape(B, S, REC_BLOCKS, REC_BLOCK_DIM)
    r = jax.nn.sigmoid(jnp.einsum('bsnc,ncd->bsnd', xb, w_a).reshape(B, S, C) + b_a)
    i = jax.nn.sigmoid(jnp.einsum('bsnc,ncd->bsnd', xb, w_x).reshape(B, S, C) + b_x)
    log_a = -RG_C * jax.nn.softplus(-rg_lambda.astype(jnp.float32)) * r.astype(jnp.float32)
    a = jnp.exp(log_a)
    b = jnp.sqrt(-jnp.expm1(2.0 * log_a)) * (i * xc).astype(jnp.float32)

    def combine(left, right):
        a1, b1 = left
        a2, b2 = right
        return a1 * a2, a2 * b1 + b2

    _, h = lax.associative_scan(combine, (a, b), axis=1)
    y = h.astype(xr.dtype) * jax.nn.gelu(xg)
    return rmsnorm(y, rec_norm_g)


def cross_attention(h, mem_n, w_cq, w_ckv, w_co):
    B, S, D = h.shape
    M = mem_n.shape[1]
    q = (h @ w_cq).reshape(B, S, CROSS_HEADS, CROSS_HEAD_DIM)
    kv = mem_n @ w_ckv
    k = kv[..., :D].reshape(B, M, CROSS_HEADS, CROSS_HEAD_DIM)
    v = kv[..., D:].reshape(B, M, CROSS_HEADS, CROSS_HEAD_DIM)
    s = jnp.einsum('bshd,bmhd->bhsm', q, k).astype(jnp.float32) * (CROSS_HEAD_DIM ** -0.5)
    p = jax.nn.softmax(s, axis=-1).astype(v.dtype)
    o = jnp.einsum('bhsm,bmhd->bshd', p, v).reshape(B, S, D)
    return o @ w_co


def moe(h, w_router, b_router, w_gu, b_gu, w_down, b_down):
    B, S, D = h.shape
    T = B * S
    M = T * TOP_K
    xf = h.reshape(T, D)
    logits = jnp.dot(xf, w_router).astype(jnp.float32) + b_router.astype(jnp.float32)
    top_vals, top_idx = lax.top_k(logits, TOP_K)
    gates = jax.nn.softmax(top_vals, axis=-1)
    flat_e = top_idx.reshape(M)
    order = jnp.argsort(flat_e)
    e_sorted = flat_e[order]
    tok_sorted = order // TOP_K
    g_sorted = gates.reshape(M)[order]
    counts = jnp.bincount(flat_e, length=N_EXPERTS)
    padded = ((counts + MOE_BLOCK - 1) // MOE_BLOCK) * MOE_BLOCK
    starts = jnp.cumsum(counts) - counts
    pad_ends = jnp.cumsum(padded)
    pad_starts = pad_ends - padded
    dest = pad_starts[e_sorted] + jnp.arange(M) - starts[e_sorted]
    m_pad = M + N_EXPERTS * MOE_BLOCK
    n_blk = m_pad // MOE_BLOCK
    row_tok = jnp.zeros((m_pad,), jnp.int32).at[dest].set(tok_sorted.astype(jnp.int32))
    row_gate = jnp.zeros((m_pad,), jnp.float32).at[dest].set(g_sorted)
    blk_e = jnp.minimum(jnp.searchsorted(pad_ends, jnp.arange(n_blk) * MOE_BLOCK, side='right'),
                        N_EXPERTS - 1)

    def step(acc, args):
        tok, g, e = args
        xb = xf[tok]
        gu = xb @ w_gu[e] + b_gu[e]
        gate = jnp.minimum(gu[:, :D_FF], SWIGLU_LIMIT)
        up = jnp.clip(gu[:, D_FF:], -SWIGLU_LIMIT, SWIGLU_LIMIT)
        act = (up + 1.0) * gate * jax.nn.sigmoid(SWIGLU_ALPHA * gate)
        y = act @ w_down[e] + b_down[e]
        return acc.at[tok].add(y * g[:, None].astype(y.dtype)), None

    acc, _ = lax.scan(step, jnp.zeros_like(xf),
                      (row_tok.reshape(n_blk, MOE_BLOCK), row_gate.reshape(n_blk, MOE_BLOCK), blk_e))
    return acc.reshape(B, S, D)


def setup_inputs(seed: int = 0) -> dict:
    key = jax.random.key(seed)
    ks = iter(jax.random.split(key, 40))
    f32 = jnp.float32

    def nrm(shape, scale):
        return jax.random.normal(next(ks), shape, f32) * scale

    def gain(shape):
        return 1.0 + 0.02 * jax.random.normal(next(ks), shape, f32)

    L = DEPTH
    x = nrm((BATCH, SEQ, D_MODEL), 1.0)
    mem = nrm((BATCH, N_MEM, D_MODEL), 1.0)
    norm_mix_g = gain((L, D_MODEL))
    w_in = nrm((L, D_MODEL, IN_PROJ_DIM), D_MODEL ** -0.5)
    conv_w = nrm((L, CONV_W, REC_WIDTH), CONV_W ** -0.5)
    conv_b = nrm((L, REC_WIDTH), 0.02)
    w_rg_a = nrm((L, REC_BLOCKS, REC_BLOCK_DIM, REC_BLOCK_DIM), REC_BLOCK_DIM ** -0.5)
    b_rg_a = nrm((L, REC_WIDTH), 0.02)
    w_rg_x = nrm((L, REC_BLOCKS, REC_BLOCK_DIM, REC_BLOCK_DIM), REC_BLOCK_DIM ** -0.5)
    b_rg_x = nrm((L, REC_WIDTH), 0.02)
    a_c = jax.random.uniform(next(ks), (L, REC_WIDTH), f32, 0.9, 0.999)
    a0 = a_c ** (1.0 / RG_C)
    rg_lambda = jnp.log(a0) - jnp.log1p(-a0)
    rec_norm_g = gain((L, REC_WIDTH))
    lambda_q1 = nrm((L, DA_HEAD_DIM), 0.1)
    lambda_k1 = nrm((L, DA_HEAD_DIM), 0.1)
    lambda_q2 = nrm((L, DA_HEAD_DIM), 0.1)
    lambda_k2 = nrm((L, DA_HEAD_DIM), 0.1)
    subln_g = gain((L, 2 * DA_HEAD_DIM))
    w_out = nrm((L, D_MIX, D_MODEL), D_MIX ** -0.5)
    norm_cross_g = gain((L, D_MODEL))
    norm_mem_g = gain((L, D_MODEL))
    w_cq = nrm((L, D_MODEL, D_MODEL), D_MODEL ** -0.5)
    w_ckv = nrm((L, D_MODEL, 2 * D_MODEL), D_MODEL ** -0.5)
    w_co = nrm((L, D_MODEL, D_MODEL), D_MODEL ** -0.5)
    norm_ffn_g = gain((L, D_MODEL))
    w_router = nrm((L, D_MODEL, N_EXPERTS), D_MODEL ** -0.5)
    b_router = nrm((L, N_EXPERTS), 0.01)
    w_gate_up = nrm((L, N_EXPERTS, D_MODEL, 2 * D_FF), D_MODEL ** -0.5)
    b_gate_up = nrm((L, N_EXPERTS, 2 * D_FF), 0.02)
    w_down = nrm((L, N_EXPERTS, D_FF, D_MODEL), D_FF ** -0.5)
    b_down = nrm((L, N_EXPERTS, D_MODEL), 0.02)
    norm_final_g = gain((D_MODEL,))
    return {"x": x, "mem": mem, "norm_mix_g": norm_mix_g, "w_in": w_in,
            "conv_w": conv_w, "conv_b": conv_b, "w_rg_a": w_rg_a, "b_rg_a": b_rg_a,
            "w_rg_x": w_rg_x, "b_rg_x": b_rg_x, "rg_lambda": rg_lambda, "rec_norm_g": rec_norm_g,
            "lambda_q1": lambda_q1, "lambda_k1": lambda_k1, "lambda_q2": lambda_q2, "lambda_k2": lambda_k2,
            "subln_g": subln_g, "w_out": w_out, "norm_cross_g": norm_cross_g, "norm_mem_g": norm_mem_g,
            "w_cq": w_cq, "w_ckv": w_ckv, "w_co": w_co, "norm_ffn_g": norm_ffn_g,
            "w_router": w_router, "b_router": b_router, "w_gate_up": w_gate_up, "b_gate_up": b_gate_up,
            "w_down": w_down, "b_down": b_down, "norm_final_g": norm_final_g}


def reference(x, mem, norm_mix_g, w_in, conv_w, conv_b, w_rg_a, b_rg_a, w_rg_x, b_rg_x,
              rg_lambda, rec_norm_g, lambda_q1, lambda_k1, lambda_q2, lambda_k2, subln_g, w_out,
              norm_cross_g, norm_mem_g, w_cq, w_ckv, w_co, norm_ffn_g, w_router, b_router,
              w_gate_up, b_gate_up, w_down, b_down, norm_final_g):
    h = x
    o_k = ATTN_WIDTH
    o_v = 2 * ATTN_WIDTH
    o_r = 3 * ATTN_WIDTH
    o_g = 3 * ATTN_WIDTH + REC_WIDTH
    for l in range(DEPTH):
        lambda_init = 0.8 - 0.6 * math.exp(-0.3 * l)
        n = rmsnorm(h, norm_mix_g[l])
        proj = n @ w_in[l]
        q = proj[..., :o_k]
        k = proj[..., o_k:o_v]
        v = proj[..., o_v:o_r]
        xr = proj[..., o_r:o_g]
        xg = proj[..., o_g:]
        attn_out = diff_attention(q, k, v, lambda_q1[l], lambda_k1[l], lambda_q2[l], lambda_k2[l],
                                  subln_g[l], lambda_init)
        rec_out = rg_lru_group(xr, xg, conv_w[l], conv_b[l], w_rg_a[l], b_rg_a[l], w_rg_x[l], b_rg_x[l],
                               rg_lambda[l], rec_norm_g[l])
        h = h + jnp.concatenate([attn_out, rec_out], axis=-1) @ w_out[l]
        h = h + cross_attention(rmsnorm(h, norm_cross_g[l]), rmsnorm(mem, norm_mem_g[l]),
                                w_cq[l], w_ckv[l], w_co[l])
        h = h + moe(rmsnorm(h, norm_ffn_g[l]), w_router[l], b_router[l], w_gate_up[l], b_gate_up[l],
                    w_down[l], b_down[l])
    return rmsnorm(h, norm_final_g)
```

```cpp
#include <hip/hip_runtime.h>
#include <hip/hip_bf16.h>
#include <cstdio>
#include <cstdint>

namespace pg8 {
#define PG8_LAS __attribute__((address_space(3)))
typedef unsigned short bf16_t;
typedef short bf16x8 __attribute__((ext_vector_type(8)));
typedef float f32x4 __attribute__((ext_vector_type(4)));
typedef unsigned u32x4 __attribute__((ext_vector_type(4)));
constexpr int BM = 256, BK = 64, HALF = 128, HTB = HALF * BK * 2  , STAGE_BYTES = 8 * HTB, NXCD = 8, WGM = 8;

__host__ __device__ __forceinline__ int lds_byte(int r, int c) { const int st = (r >> 4) * 2 + (c >> 5), rr = r & 15, cc = c & 31, ob = rr * 64 + cc * 2; return st * 1024 + (ob ^ (((ob >> 9) & 1) << 5)); }
__host__ __device__ __forceinline__ void stage_rc(int b, int& R, int& C) { const int st = b / 1024, sb = b % 1024, swz = sb ^ (((sb >> 9) & 1) << 5); R = (st >> 1) * 16 + swz / 64; C = (st & 1) * 32 + (swz % 64) / 2; }
__host__ __device__ __forceinline__ int perm32(int rho) { const int n = rho >> 4, i = rho & 15; return 8 * (i >> 2) + 4 * n + (i & 3); }

struct Unit { int pm, pn, e; const char* A; const char* B; };
struct Gemm { int K, lda, ldb; };

__device__ __forceinline__ unsigned cvt_pk_bf16(float lo, float hi) { unsigned r; asm volatile("v_cvt_pk_bf16_f32 %0, %1, %2" : "=v"(r) : "v"(lo), "v"(hi)); return r; }

struct DenseOrder {
    const char* A; const char* B; size_t tsA, tsB; int nM, nN, nwg, G, c;
    __device__ void init(const void* A_, const void* B_, int M, int N, int lda, int ldb, int G_, int c_) { A = (const char*)A_; B = (const char*)B_; tsA = (size_t)BM * lda * 2; tsB = (size_t)BM * ldb * 2; nM = M / BM; nN = N / BM; nwg = nM * nN; G = G_; c = c_; }
    __device__ __forceinline__ bool next(int i, Unit& u) const {
        const long L = (long)i * G + c; if (L >= nwg) return false;
        int wgid = (int)L; { const int q = nwg / NXCD, r = nwg % NXCD, xcd = wgid % NXCD, off = wgid / NXCD; wgid = (xcd < r ? xcd * (q + 1) : r * (q + 1) + (xcd - r) * q) + off; }
        const int nig = WGM * nN, gid = wgid / nig, fm = gid * WGM, gsz = (nM - fm) < WGM ? (nM - fm) : WGM;
        u.pm = fm + ((wgid % nig) % gsz); u.pn = (wgid % nig) / gsz; u.e = i; u.A = A + (size_t)u.pm * tsA; u.B = B + (size_t)u.pn * tsB; return true;
    }
};

typedef int i32x4 __attribute__((ext_vector_type(4)));
template <bool I8> struct AccSel { typedef f32x4 type; };
template <> struct AccSel<true> { typedef i32x4 type; };
__device__ __forceinline__ f32x4 mma16(bf16x8 a, bf16x8 b, f32x4 c) { return __builtin_amdgcn_mfma_f32_16x16x32_bf16(a, b, c, 0, 0, 0); }
__device__ __forceinline__ i32x4 mma16(bf16x8 a, bf16x8 b, i32x4 c) { return __builtin_amdgcn_mfma_i32_16x16x64_i8(__builtin_bit_cast(i32x4, a), __builtin_bit_cast(i32x4, b), c, 0, 0, 0); }
typedef int i32x8 __attribute__((ext_vector_type(8)));
__device__ __forceinline__ f32x4 mma16f8(bf16x8 b0, bf16x8 b1, bf16x8 a0, bf16x8 a1, f32x4 c) {
    const i32x4 B0 = __builtin_bit_cast(i32x4, b0), B1 = __builtin_bit_cast(i32x4, b1), A0 = __builtin_bit_cast(i32x4, a0), A1 = __builtin_bit_cast(i32x4, a1);
    const i32x8 B8 = {B0[0], B0[1], B0[2], B0[3], B1[0], B1[1], B1[2], B1[3]}, A8 = {A0[0], A0[1], A0[2], A0[3], A1[0], A1[1], A1[2], A1[3]};
    asm volatile("v_mfma_f32_16x16x128_f8f6f4 %0, %1, %2, %0" : "+v"(c) : "v"(B8), "v"(A8));
    return c;
}
template <class S_> struct IsGather { template <class T> static char f(decltype(&T::rows)); template <class T> static int f(...); static constexpr bool v = sizeof(f<S_>(nullptr)) == 1; };
template <class Epi, class Sched, bool ALIGN_EPI, bool I8 = false, bool F8 = false>
__device__ __forceinline__ void gemm_phase(PG8_LAS unsigned char* lds, const Gemm g, const Sched& S, const Epi& E) {
    const int tid = threadIdx.x, wid = __builtin_amdgcn_readfirstlane(tid >> 6), lane = tid & 63, wr = wid >> 2, wc = wid & 3, fr = lane & 15, fq = lane >> 4;
    const int K = g.K, nt = K / BK;
    unsigned voffA[2], voffB[2];
#pragma unroll
    for (int i = 0; i < 2; ++i) { int R, C; stage_rc(tid * 16 + i * 8192, R, C); const int Rb = Epi::PERM ? ((R & ~31) + perm32(R & 31)) : R;
        voffA[i] = (unsigned)(R * g.lda + C) * 2u; voffB[i] = (unsigned)(Rb * g.ldb + C) * 2u; }
    const size_t kstep = (size_t)(BK * 2);
    const size_t hstepA = (size_t)HALF * g.lda * 2, hstepB = (size_t)HALF * g.ldb * 2;
    const unsigned ldsw = (unsigned)wid * 1024u;
    const int aoff = lds_byte(wr * 64 + fr, fq * 8), boff = lds_byte(wc * 32 + fr, fq * 8);
#define PG8_SA(b, h) (((b) * 2 + (h)) * HTB)
#define PG8_SB(b, h) ((4 + (b) * 2 + (h)) * HTB)
#define PG8_STAGE(bufoff, gbase, voff) do { _Pragma("unroll") for (int _i = 0; _i < 2; ++_i) \
        __builtin_amdgcn_global_load_lds((const unsigned*)((const char*)(gbase) + (voff)[_i]), (PG8_LAS unsigned*)(lds + (bufoff) + ldsw + _i * 8192), 16, 0, 0); } while (0)
#define PG8_STAGE_A(b, h, base, v0, v1) do { if constexpr (GA) { if ((h) == 0) PG8_STAGE(PG8_SA(b, h), base, v0); else PG8_STAGE(PG8_SA(b, h), base, v1); } \
        else PG8_STAGE(PG8_SA(b, h), (h) ? (base) + hstepA : (base), voffA); } while (0)
#define PG8_LDA(dst, b, h) do { _Pragma("unroll") for (int m = 0; m < 4; ++m) _Pragma("unroll") for (int k = 0; k < 2; ++k) dst[m][k] = *(const PG8_LAS bf16x8*)(lds + PG8_SA(b, h) + aoff + m * 2048 + k * 1024); } while (0)
#define PG8_LDB(dst, b, h) do { _Pragma("unroll") for (int n = 0; n < 2; ++n) _Pragma("unroll") for (int k = 0; k < 2; ++k) dst[n][k] = *(const PG8_LAS bf16x8*)(lds + PG8_SB(b, h) + boff + n * 2048 + k * 1024); } while (0)
#define PG8_MMA(ai, bj, At, Bt) do { __builtin_amdgcn_s_setprio(1); _Pragma("unroll") for (int m = 0; m < 4; ++m) _Pragma("unroll") for (int n = 0; n < 2; ++n) { \
        if constexpr (F8) acc[ai][bj][m][n] = mma16f8(Bt[n][0], Bt[n][1], At[m][0], At[m][1], acc[ai][bj][m][n]); \
        else { _Pragma("unroll") for (int k = 0; k < 2; ++k) acc[ai][bj][m][n] = mma16(Bt[n][k], At[m][k], acc[ai][bj][m][n]); } } __builtin_amdgcn_s_setprio(0); } while (0)
#define PG8_WAIT_V(n) asm volatile("s_waitcnt vmcnt(" #n ")" ::: "memory")
#define PG8_WAIT_L(n) asm volatile("s_waitcnt lgkmcnt(" #n ")" ::: "memory")
#define PG8_BAR __builtin_amdgcn_s_barrier()
#define PG8_SCHED __builtin_amdgcn_sched_barrier(0)
    Unit cur, nxt; int ui = 0;
    if (!S.next(0, cur)) return;
    constexpr bool GA = IsGather<Sched>::v;
    unsigned voffA1[2], nvA0[2], nvA1[2];
    int gR[2], gC[2];
    if constexpr (GA) {
#pragma unroll
        for (int i = 0; i < 2; ++i) { stage_rc(tid * 16 + i * 8192, gR[i], gC[i]);
            const int* rw = S.rows + (size_t)cur.pm * 256; voffA[i] = (unsigned)(rw[gR[i]] * g.lda + gC[i]) * 2u; voffA1[i] = (unsigned)(rw[128 + gR[i]] * g.lda + gC[i]) * 2u; nvA0[i] = voffA[i]; nvA1[i] = voffA1[i]; }
    }
    typedef typename AccSel<I8>::type acc_t;
    acc_t acc[2][2][4][2];
#pragma unroll
    for (int a = 0; a < 2; ++a)
#pragma unroll
        for (int b = 0; b < 2; ++b)
#pragma unroll
            for (int m = 0; m < 4; ++m)
#pragma unroll
                for (int n = 0; n < 2; ++n) acc[a][b][m][n] = (acc_t){0, 0, 0, 0};
    bf16x8 At[4][2], B0[2][2], B1[2][2];
    const char* cA = cur.A; const char* cB = cur.B;
    PG8_STAGE(PG8_SB(0, 0), cB, voffB); PG8_STAGE(PG8_SB(0, 1), cB + hstepB, voffB); PG8_STAGE_A(0, 0, cA, voffA, voffA1); PG8_STAGE_A(0, 1, cA, voffA, voffA1);
    if (wr == 1) PG8_BAR;
    PG8_WAIT_V(2); PG8_BAR;
    PG8_STAGE(PG8_SB(1, 0), cB + kstep, voffB); PG8_STAGE_A(1, 0, cA + kstep, voffA, voffA1); PG8_STAGE(PG8_SB(1, 1), cB + hstepB + kstep, voffB);
    PG8_WAIT_V(6); PG8_BAR;
    for (;;) {
        const bool has_next = S.next(ui + 1, nxt);
        const char* nA = has_next ? nxt.A : cA; const char* nB = has_next ? nxt.B : cB;
        if constexpr (GA) { if (has_next) { const int* rw = S.rows + (size_t)nxt.pm * 256;
#pragma unroll
            for (int i = 0; i < 2; ++i) { nvA0[i] = (unsigned)(rw[gR[i]] * g.lda + gC[i]) * 2u; nvA1[i] = (unsigned)(rw[128 + gR[i]] * g.lda + gC[i]) * 2u; } } }
        for (int t = 0; t < nt; t += 2) {
            const bool last = (t == nt - 2);
            const char* a1 = cA + (size_t)(t + 1) * kstep;
            const char* a2 = last ? nA : cA + (size_t)(t + 2) * kstep; const char* b2 = last ? nB : cB + (size_t)(t + 2) * kstep;
            const char* a3 = a2 + kstep; const char* b3 = b2 + kstep;
            unsigned w0[2], w1[2];
#pragma unroll
            for (int i = 0; i < 2; ++i) { w0[i] = (GA && last) ? nvA0[i] : voffA[i]; w1[i] = (GA && last) ? nvA1[i] : voffA1[i]; }
            PG8_LDB(B0, 0, 0); PG8_LDB(B1, 0, 1); PG8_SCHED; PG8_LDA(At, 0, 0); PG8_STAGE_A(1, 1, a1, voffA, voffA1);
            PG8_WAIT_V(8); PG8_WAIT_L(0); PG8_BAR; PG8_MMA(0, 0, At, B0); PG8_MMA(0, 1, At, B1); PG8_BAR; PG8_SCHED;
            PG8_LDA(At, 0, 1); PG8_STAGE(PG8_SB(0, 0), b2, voffB); PG8_STAGE(PG8_SB(0, 1), b2 + hstepB, voffB); PG8_STAGE_A(0, 0, a2, w0, w1);
            PG8_WAIT_V(8); PG8_WAIT_L(0); PG8_BAR; PG8_MMA(1, 0, At, B0); PG8_MMA(1, 1, At, B1); PG8_BAR; PG8_SCHED;
            PG8_LDB(B0, 1, 0); PG8_LDB(B1, 1, 1); PG8_SCHED; PG8_LDA(At, 1, 0); PG8_STAGE_A(0, 1, a2, w0, w1);
            PG8_WAIT_V(8); PG8_WAIT_L(0); PG8_BAR; PG8_MMA(0, 0, At, B0); PG8_MMA(0, 1, At, B1); PG8_BAR; PG8_SCHED;
            PG8_LDA(At, 1, 1); PG8_STAGE(PG8_SB(1, 0), b3, voffB); PG8_STAGE(PG8_SB(1, 1), b3 + hstepB, voffB); PG8_STAGE_A(1, 0, a3, w0, w1);
            PG8_WAIT_V(8); PG8_WAIT_L(0); PG8_BAR; PG8_MMA(1, 0, At, B0); PG8_MMA(1, 1, At, B1); PG8_BAR; PG8_SCHED;
        }
        if constexpr (ALIGN_EPI) { if (wr == 0) PG8_BAR; }
        if constexpr (F8) {
            asm volatile("s_nop 15\n\ts_nop 15" ::: "memory");
#pragma unroll
            for (int a = 0; a < 2; ++a)
#pragma unroll
                for (int b = 0; b < 2; ++b)
#pragma unroll
                    for (int m = 0; m < 4; ++m)
#pragma unroll
                        for (int n = 0; n < 2; ++n) asm volatile("" : "+v"(acc[a][b][m][n]));
        }
        E(acc, cur, wr, wc, fr, fq);
        if (!has_next) break;
#pragma unroll
        for (int a = 0; a < 2; ++a)
#pragma unroll
            for (int b = 0; b < 2; ++b)
#pragma unroll
                for (int m = 0; m < 4; ++m)
#pragma unroll
                    for (int n = 0; n < 2; ++n) acc[a][b][m][n] = (acc_t){0, 0, 0, 0};
        cur = nxt; cA = nA; cB = nB; ++ui;
        if constexpr (GA) {
#pragma unroll
            for (int i = 0; i < 2; ++i) { voffA[i] = nvA0[i]; voffA1[i] = nvA1[i]; } }
        if constexpr (ALIGN_EPI) { if (wr == 1) PG8_BAR; }
    }
    PG8_WAIT_V(0);
    if constexpr (!ALIGN_EPI) { if (wr == 0) PG8_BAR; }
    PG8_BAR;
#undef PG8_SA
#undef PG8_SB
#undef PG8_STAGE
#undef PG8_STAGE_A
#undef PG8_LDA
#undef PG8_LDB
#undef PG8_MMA
#undef PG8_WAIT_V
#undef PG8_WAIT_L
#undef PG8_BAR
#undef PG8_SCHED
}
}

namespace att {
constexpr int D = 128;
constexpr float THR = 8.f;
constexpr bool WSKIP = false;
constexpr float SCALE = 0.08838834764831845f;
constexpr int NW = 8, QBLK = 32, KVBLK = 64, QB = NW * QBLK;
constexpr int SHM_V = KVBLK * D * 2, SHM_K = KVBLK * D * 2;
constexpr int LDS_BYTES = 2 * SHM_V + 2 * SHM_K + NW * 64 * 4;
static_assert(D == 128, "geometry");

using bf16 = __hip_bfloat16;
typedef short bf16x8 __attribute__((ext_vector_type(8)));
typedef short s16x4 __attribute__((ext_vector_type(4)));
typedef float f32x16 __attribute__((ext_vector_type(16)));
typedef float f32x4 __attribute__((ext_vector_type(4)));
typedef unsigned u32x4 __attribute__((ext_vector_type(4)));
template <class A, class Bt> struct same_t { static constexpr bool v = false; };
template <class A> struct same_t<A, A> { static constexpr bool v = true; };

#define KSWZ(row, colB) ((row) * 256 + ((colB) ^ (((row) & 7) << 4)))
#define SBAR() __builtin_amdgcn_sched_barrier(0)
__device__ __forceinline__ int v_st(int k, int c) { const int kk = (k & ~0xC) | ((k & 4) << 1) | ((k & 8) >> 1); return ((kk >> 3) * 4 + (c >> 5)) * 512 + ((kk & 7) * 32 + (c & 31)) * 2; }
__device__ __forceinline__ int v_rd_base(int lane) { return ((lane & 3) << 3) | (((lane >> 2) & 3) << 6) | (((lane >> 4) & 1) << 5) | (((lane >> 5) & 1) << 8); }
constexpr int v_rd_off(int d0, int ks, int half) { return d0 * 512 + ks * 4096 + half * 2048; }
__device__ __forceinline__ int crow(int r, int hi) { return (r & 3) + 8 * (r >> 2) + 4 * hi; }
__device__ __forceinline__ unsigned cvtpk(float lo, float hi) {
    unsigned r; asm volatile("v_cvt_pk_bf16_f32 %0, %1, %2" : "=v"(r) : "v"(lo), "v"(hi)); return r;
}
__device__ __forceinline__ bf16x8 pack8(f32x4 a, f32x4 b) {
    u32x4 w = {cvtpk(a[0], a[1]), cvtpk(a[2], a[3]), cvtpk(b[0], b[1]), cvtpk(b[2], b[3])};
    return *reinterpret_cast<bf16x8*>(&w);
}
template <class T> __device__ __forceinline__ bf16x8 load8(const T* p) {
    if constexpr (same_t<T, float>::v) { return pack8(*(const f32x4*)p, *(const f32x4*)(p + 4)); }
    else { return *reinterpret_cast<const bf16x8*>(p); }
}
__device__ __forceinline__ void mask_tile(f32x16& p0, f32x16& p1, int dq, unsigned W) {
    const float NEG = -__builtin_inff();
#pragma unroll
    for (int r = 0; r < 16; ++r) {
        const int c = (r & 3) + 8 * (r >> 2);
        if ((unsigned)(dq - c) >= W) p0[r] = NEG;
        if ((unsigned)(dq - c - 32) >= W) p1[r] = NEG;
    }
}
__device__ __forceinline__ void partialSM(f32x16& p0, f32x16& p1, float& m_reg, float& mn, float& alpha) {
    float pmax = p0[0]; for (int r = 1; r < 16; ++r) pmax = fmaxf(pmax, p0[r]); for (int r = 0; r < 16; ++r) pmax = fmaxf(pmax, p1[r]);
    { auto rr = __builtin_amdgcn_permlane32_swap(__float_as_uint(pmax), __float_as_uint(pmax), false, false);
      pmax = fmaxf(__uint_as_float(rr[0]), __uint_as_float(rr[1])); }
    constexpr float C2 = 1.4426950408889634f * SCALE;
    if (__builtin_expect(__all((pmax - m_reg) * SCALE <= THR), 1)) { mn = m_reg; alpha = 1.f; }
    else { mn = fmaxf(m_reg, pmax); alpha = __builtin_amdgcn_exp2f((m_reg - mn) * C2); m_reg = mn; }
    const float mnL = -mn * C2;
    for (int r = 0; r < 16; ++r) p0[r] = fmaf(p0[r], C2, mnL); for (int r = 0; r < 16; ++r) p1[r] = fmaf(p1[r], C2, mnL);
    for (int r = 0; r < 16; ++r) p0[r] = __builtin_amdgcn_exp2f(p0[r]);
}
__device__ __forceinline__ void finishSM(f32x16& p0, f32x16& p1, float alpha, float& l_reg, bf16x8& pa0, bf16x8& pa1, bf16x8& pa2, bf16x8& pa3) {
    for (int r = 0; r < 16; ++r) p1[r] = __builtin_amdgcn_exp2f(p1[r]);
    float ps = 0; for (int r = 0; r < 16; ++r) ps += p0[r]; for (int r = 0; r < 16; ++r) ps += p1[r];
    { auto rr = __builtin_amdgcn_permlane32_swap(__float_as_uint(ps), __float_as_uint(ps), false, false);
      ps = __uint_as_float(rr[0]) + __uint_as_float(rr[1]); }
    l_reg = l_reg * alpha + ps;
#define PK4(P, B_, OUT) do { unsigned a0 = cvtpk(P[B_+0], P[B_+1]), a1 = cvtpk(P[B_+2], P[B_+3]);                          \
        unsigned b0 = cvtpk(P[B_+4], P[B_+5]), b1 = cvtpk(P[B_+6], P[B_+7]);                                             \
        auto r0 = __builtin_amdgcn_permlane32_swap(a0, b0, false, false); auto r1 = __builtin_amdgcn_permlane32_swap(a1, b1, false, false); \
        u32x4 w = {r0[0], r1[0], r0[1], r1[1]}; OUT = *reinterpret_cast<bf16x8*>(&w); } while (0)
    PK4(p0, 0, pa0); PK4(p0, 8, pa1); PK4(p1, 0, pa2); PK4(p1, 8, pa3);
#undef PK4
}
template <int KB, bool SK>
__device__ __forceinline__ void qkt(f32x16& p0, f32x16& p1, const char* K_lds, int r32, int hi, const bf16x8* qr, bool act) {
    if (SK && !act) { const float NEG = -__builtin_inff();
#pragma unroll
        for (int r = 0; r < 16; ++r) { p0[r] = NEG; p1[r] = NEG; } return; }
    p0 = f32x16{}; p1 = f32x16{};
    const char* kb[4];
#pragma unroll
    for (int dd = 0; dd < 4; ++dd) kb[dd] = K_lds + KB * SHM_K + KSWZ(r32, (dd * 16 + hi * 8) * 2);
#pragma unroll
    for (int d0 = 0; d0 < 8; ++d0) { const char* a = kb[d0 & 3] + (d0 >> 2) * 128;
        bf16x8 b0 = *reinterpret_cast<const bf16x8*>(a);
        bf16x8 b1 = *reinterpret_cast<const bf16x8*>(a + 32 * 256);
        p0 = __builtin_amdgcn_mfma_f32_32x32x16_bf16(b0, qr[d0], p0, 0, 0, 0);
        p1 = __builtin_amdgcn_mfma_f32_32x32x16_bf16(b1, qr[d0], p1, 0, 0, 0); }
}
template <int VB, bool SK>
__device__ __forceinline__ void pv_tile(f32x16* o, int vb0, bf16x8 pa0, bf16x8 pa1, bf16x8 pa2, bf16x8 pa3, bool act) {
    if (SK && !act) return;
#define TRRD(dst, off) asm volatile("ds_read_b64_tr_b16 %0, %1 offset:%2" : "=&v"(dst) : "v"(vb0), "i"(off) : "memory")
#define PV_D0(d0) do { s16x4 l0, l1, l2, l3, h0, h1, h2, h3; constexpr int b_ = VB * SHM_V + v_rd_off(d0, 0, 0);     \
        TRRD(l0, b_); TRRD(h0, b_ + 2048); TRRD(l1, b_ + 4096); TRRD(h1, b_ + 6144); TRRD(l2, b_ + 8192); TRRD(h2, b_ + 10240); TRRD(l3, b_ + 12288); TRRD(h3, b_ + 14336); \
        asm volatile("s_waitcnt lgkmcnt(0)" ::: "memory"); SBAR();                 \
        o[d0] = __builtin_amdgcn_mfma_f32_32x32x16_bf16(pa0, (bf16x8){l0[0], l0[1], l0[2], l0[3], h0[0], h0[1], h0[2], h0[3]}, o[d0], 0, 0, 0);   \
        o[d0] = __builtin_amdgcn_mfma_f32_32x32x16_bf16(pa1, (bf16x8){l1[0], l1[1], l1[2], l1[3], h1[0], h1[1], h1[2], h1[3]}, o[d0], 0, 0, 0);   \
        o[d0] = __builtin_amdgcn_mfma_f32_32x32x16_bf16(pa2, (bf16x8){l2[0], l2[1], l2[2], l2[3], h2[0], h2[1], h2[2], h2[3]}, o[d0], 0, 0, 0);   \
        o[d0] = __builtin_amdgcn_mfma_f32_32x32x16_bf16(pa3, (bf16x8){l3[0], l3[1], l3[2], l3[3], h3[0], h3[1], h3[2], h3[3]}, o[d0], 0, 0, 0); } while (0)
    PV_D0(0); PV_D0(1); PV_D0(2); PV_D0(3);
#undef PV_D0
#undef TRRD
}

template <class TIn, class TOut> struct BlockRef { const TIn* Q; const TIn* K; const TIn* V; TOut* O; int P0; };
template <class TIn> struct Seam {
    bf16x8 qr[8];
    bf16x8 st_v0, st_v1, st_k0, st_k1; f32x4 sf0, sf1, sf2, sf3;
    f32x4 tq[16];
};
__device__ __forceinline__ int swa_jlo(int P0, int W) { const int lowk = P0 - W + 1; return lowk > 0 ? lowk / KVBLK : 0; }
#define ROW(p, k0, rr) ((p) + (size_t)((k0) + (rr)) * D + sc)
#define VMW() asm volatile("s_waitcnt vmcnt(0)" ::: "memory")
#define VMWN(n) asm volatile("s_waitcnt vmcnt(%0)" :: "i"(n) : "memory")
#define SLOAD_H(Kp, Vp, k0) do { S.st_v0 = load8<TIn>(ROW(Vp, k0, sr)); S.st_v1 = load8<TIn>(ROW(Vp, k0, 32 + sr));              \
                         S.st_k0 = load8<TIn>(ROW(Kp, k0, sr)); S.st_k1 = load8<TIn>(ROW(Kp, k0, 32 + sr)); } while (0)
#define SWRITE_HK(bf) do { *(bf16x8*)(K_lds + (bf) * SHM_K + kws) = S.st_k0; *(bf16x8*)(K_lds + (bf) * SHM_K + kws + 32 * 256) = S.st_k1; } while (0)
#define SWRITE_HV(bf) do { *(bf16x8*)(V_lds + (bf) * SHM_V + vst0) = S.st_v0; *(bf16x8*)(V_lds + (bf) * SHM_V + vst1) = S.st_v1; } while (0)
#define SWRITE_H(bf) do { SWRITE_HV(bf); SWRITE_HK(bf); } while (0)
#define SLOAD_F(p, k0) do { S.sf0 = *(const f32x4*)ROW(p, k0, sr); S.sf1 = *(const f32x4*)(ROW(p, k0, sr) + 4);                \
                            S.sf2 = *(const f32x4*)ROW(p, k0, 32 + sr); S.sf3 = *(const f32x4*)(ROW(p, k0, 32 + sr) + 4); } while (0)
#define SWRITE_KF(bf) do { *(bf16x8*)(K_lds + (bf) * SHM_K + kws) = pack8(S.sf0, S.sf1); *(bf16x8*)(K_lds + (bf) * SHM_K + kws + 32 * 256) = pack8(S.sf2, S.sf3); } while (0)
#define SWRITE_VF(bf) do { *(bf16x8*)(V_lds + (bf) * SHM_V + vst0) = pack8(S.sf0, S.sf1); *(bf16x8*)(V_lds + (bf) * SHM_V + vst1) = pack8(S.sf2, S.sf3); } while (0)
template <class TIn, class TOut>
__device__ __forceinline__ void causal_swa_prime(const BlockRef<TIn, TOut>& cur, int W, char* lds, Seam<TIn>& S) {
    constexpr bool F32 = same_t<TIn, float>::v;
    const int tid = threadIdx.x, wid = __builtin_amdgcn_readfirstlane(tid >> 6), lane = tid & 63, r32 = lane & 31, hi = lane >> 5;
    const int sr = tid >> 4, sc = (tid & 15) * 8, kws = KSWZ(sr, sc * 2); char* K_lds = lds + 2 * SHM_V;
    const int kb0 = swa_jlo(cur.P0, W) * KVBLK;
    for (int d0 = 0; d0 < 8; ++d0) S.qr[d0] = load8<TIn>(cur.Q + (size_t)(wid * QBLK + r32) * D + d0 * 16 + hi * 8);
    if constexpr (F32) { SLOAD_F((const float*)cur.K, kb0); VMW(); SWRITE_KF(0); SBAR(); SLOAD_F((const float*)cur.V, kb0); }
    else { SLOAD_H(cur.K, cur.V, kb0); VMW(); SWRITE_HK(0); }
    __syncthreads();
}
template <class TIn, class TOut>
__device__ __forceinline__ void causal_swa_block(const BlockRef<TIn, TOut>& cur, const BlockRef<TIn, TOut>& nxt, int skv, int W, char* lds, Seam<TIn>& S) {
    constexpr bool F32 = same_t<TIn, float>::v;
    const int tid = threadIdx.x, wid = __builtin_amdgcn_readfirstlane(tid >> 6), lane = tid & 63, r32 = lane & 31, hi = lane >> 5;
    const int j_lo = swa_jlo(cur.P0, W);
    int j_hi = (cur.P0 + QB - 1) / KVBLK + 1; if (j_hi > skv / KVBLK) j_hi = skv / KVBLK;
    const int NT = j_hi - j_lo;
    const int kbn = swa_jlo(nxt.P0, W) * KVBLK;
    const int qlo = cur.P0 + wid * QBLK, qm = qlo + r32 - 4 * hi;
    char* V_lds = lds; char* K_lds = lds + 2 * SHM_V;
    float* ws = (float*)(lds + 2 * SHM_V + 2 * SHM_K) + wid * 64; float* li_l = ws, * al_l = ws + 32;
    float m_reg = -1e30f, l_reg = 0; f32x16 o[4] = {};
    const int sr = tid >> 4, sc = (tid & 15) * 8, vst0 = v_st(sr, sc), vst1 = v_st(32 + sr, sc), kws = KSWZ(sr, sc * 2);
    const int vb0 = (int)(uintptr_t)V_lds + v_rd_base(lane);
    const TIn* Kh = cur.K; const TIn* Vh = cur.V;
#define RESC(a) do { if (__any((a) < 1.f)) { if (hi == 0) al_l[r32] = (a); asm volatile("s_waitcnt lgkmcnt(0)" ::: "memory");              \
                     for (int d_ = 0; d_ < 4; ++d_) for (int r = 0; r < 16; ++r) o[d_][r] *= al_l[crow(r, hi)]; } } while (0)
#define KBASE(t) ((j_lo + (t)) * KVBLK)
#define ACT(t) (KBASE(t) <= qlo + QBLK - 1 && KBASE(t) + KVBLK - 1 >= qlo - W + 1)
#define MASKT(P0_, P1_, t) do { const int kb_ = KBASE(t); if ((!SK || ACT(t)) && (kb_ + KVBLK - 1 > qlo || kb_ <= qlo + QBLK - 1 - W)) mask_tile(P0_, P1_, qm - kb_, (unsigned)W); } while (0)
    constexpr int NQL = F32 ? 16 : 8;
    constexpr bool SK = WSKIP && !F32;
#define SEAM_K0() do { VMWN(NQL); if constexpr (F32) { SWRITE_KF(0); SBAR(); SLOAD_F((const float*)nxt.V, kbn); } else { SWRITE_HK(0); } SBAR(); } while (0)
    f32x16 pA0, pA1, pB0, pB1; float mnA, mnB, alA, alB; bf16x8 pa0, pa1, pa2, pa3;
    if constexpr (F32) { VMW(); SWRITE_VF(0); SBAR(); } else { SWRITE_HV(0); SBAR(); }
    if (NT > 1) { if constexpr (F32) SLOAD_F((const float*)Kh, KBASE(1)); else SLOAD_H(Kh, Vh, KBASE(1)); }
    SBAR(); qkt<0, SK>(pA0, pA1, K_lds, r32, hi, S.qr, ACT(0));
    if constexpr (F32) { if (NT > 1) { VMW(); SWRITE_KF(1); SBAR(); SLOAD_F((const float*)Vh, KBASE(1)); } }
    MASKT(pA0, pA1, 0); partialSM(pA0, pA1, m_reg, mnA, alA);
    if (NT > 1) { VMW(); if constexpr (F32) { SWRITE_VF(1); SBAR(); if (NT > 2) SLOAD_F((const float*)Kh, KBASE(2)); } else SWRITE_H(1); }
    __syncthreads();
#define HALF_STEP(PX0, PX1, mnX, alX, PY0, PY1, alY, t, KB, VB, SB) do {                                                      \
        SBAR(); qkt<KB, SK>(PX0, PX1, K_lds, r32, hi, S.qr, ACT(t));                                             \
        finishSM(PY0, PY1, alY, l_reg, pa0, pa1, pa2, pa3); SBAR();                                                           \
        if ((t) + 1 < NT) { if constexpr (F32) { VMW(); SWRITE_KF(SB); SBAR(); SLOAD_F((const float*)Vh, KBASE((t) + 1)); }  \
                            else { SLOAD_H(Kh, Vh, KBASE((t) + 1)); } SBAR(); }                                               \
        pv_tile<VB, SK>(o, vb0, pa0, pa1, pa2, pa3, ACT((t) - 1)); MASKT(PX0, PX1, (t)); partialSM(PX0, PX1, m_reg, mnX, alX);                                        \
        __syncthreads();                                                                                                      \
        if ((t) + 1 < NT) { VMW(); if constexpr (F32) { SWRITE_VF(SB); SBAR(); if ((t) + 2 < NT) SLOAD_F((const float*)Kh, KBASE((t) + 2)); } \
                            else { SWRITE_H(SB); } }                                                                          \
        RESC(alX); __syncthreads(); } while (0)
    for (int t = 1; t + 1 < NT; t += 2) {
        HALF_STEP(pB0, pB1, mnB, alB, pA0, pA1, alA, t, 1, 0, 0);
        HALF_STEP(pA0, pA1, mnA, alA, pB0, pB1, alB, t + 1, 0, 1, 1);
    }
    const bool even = (NT & 1) == 0;
    if (even) { SBAR(); qkt<1, SK>(pB0, pB1, K_lds, r32, hi, S.qr, ACT(NT - 1)); SBAR(); }
#define QROW(e) (nxt.Q + (size_t)(wid * QBLK + r32) * D + ((e) >> 1) * 16 + hi * 8 + ((e) & 1) * 4)
    if constexpr (F32) { SLOAD_F((const float*)nxt.K, kbn); SBAR();
#pragma unroll
        for (int e = 0; e < 8; ++e) S.tq[e] = *(const f32x4*)QROW(e); }
    else { SLOAD_H(nxt.K, nxt.V, kbn); SBAR();
#pragma unroll
        for (int d0 = 0; d0 < 8; ++d0) S.qr[d0] = load8<TIn>(nxt.Q + (size_t)(wid * QBLK + r32) * D + d0 * 16 + hi * 8); }
    SBAR();
    finishSM(pA0, pA1, alA, l_reg, pa0, pa1, pa2, pa3); SBAR();
    if constexpr (F32) {
#pragma unroll
        for (int e = 8; e < 16; ++e) S.tq[e] = *(const f32x4*)QROW(e); SBAR(); }
#undef QROW
    pv_tile<0, SK>(o, vb0, pa0, pa1, pa2, pa3, ACT(even ? NT - 2 : NT - 1));
    if (even) { MASKT(pB0, pB1, NT - 1); partialSM(pB0, pB1, m_reg, mnB, alB); __syncthreads(); RESC(alB);
        finishSM(pB0, pB1, alB, l_reg, pa0, pa1, pa2, pa3); SBAR(); pv_tile<1, SK>(o, vb0, pa0, pa1, pa2, pa3, ACT(NT - 1)); }
    SBAR(); SEAM_K0();
    if (hi == 0) li_l[r32] = l_reg; asm volatile("s_waitcnt lgkmcnt(0)" ::: "memory");
    float rli[16];
#pragma unroll
    for (int r = 0; r < 16; ++r) rli[r] = __builtin_amdgcn_rcpf(li_l[crow(r, hi)]);
    TOut* Ow = cur.O + (size_t)(wid * QBLK) * D;
#pragma unroll
    for (int r = 0; r < 16; ++r) { const int orow = crow(r, hi);
#pragma unroll
        for (int d0 = 0; d0 < 4; ++d0) { const float v = o[d0][r] * rli[r];
            if constexpr (same_t<TOut, float>::v) { Ow[(size_t)orow * D + d0 * 32 + r32] = v; }
            else { const float vn = __shfl_xor(v, 1);
                   if ((r32 & 1) == 0) *(unsigned*)(Ow + (size_t)orow * D + d0 * 32 + r32) = cvtpk(v, vn); } } }
    if constexpr (F32) {
#pragma unroll
        for (int d0 = 0; d0 < 8; ++d0) S.qr[d0] = pack8(S.tq[2 * d0], S.tq[2 * d0 + 1]); }
    __syncthreads();
#undef RESC
#undef KBASE
#undef ACT
#undef MASKT
#undef SEAM_K0
#undef HALF_STEP
}
#undef ROW
#undef VMW
#undef VMWN
#undef SLOAD_H
#undef SWRITE_HK
#undef SWRITE_HV
#undef SWRITE_H
#undef SLOAD_F
#undef SWRITE_KF
#undef SWRITE_VF

}

namespace att2 {
typedef unsigned short bf16_t;
using att::bf16x8; using att::s16x4; using att::f32x16; using att::f32x4; using att::u32x4; using att::cvtpk; using att::crow; using att::v_rd_base;
constexpr int OFF_K = 0  , OFF_V = 49152  , OFF_ML = 147456, OFF_AL = 149504, LDS_END = 150528;
constexpr float SCALE = 0.08838834764831845f, THR = 1.2f, THR16 = 8.f, C2 = 1.4426950408889634f * SCALE, PSH = 7.0f;
__device__ __forceinline__ int v_st256(int k, int c) { const int kk = (k & ~0xC) | ((k & 4) << 1) | ((k & 8) >> 1); return ((kk >> 3) * 8 + (c >> 5)) * 512 + ((kk & 7) * 32 + (c & 31)) * 2; }
#define A2_TRRD(dst, addr, off) asm volatile("ds_read_b64_tr_b16 %0, %1 offset:%2" : "=&v"(dst) : "v"(addr), "i"(off) : "memory")
#define A2_PK4(P, B_, OUT) do { unsigned a0_ = cvtpk(P[B_+0], P[B_+1]), a1_ = cvtpk(P[B_+2], P[B_+3]); unsigned b0_ = cvtpk(P[B_+4], P[B_+5]), b1_ = cvtpk(P[B_+6], P[B_+7]);  \
        auto r0_ = __builtin_amdgcn_permlane32_swap(a0_, b0_, false, false); auto r1_ = __builtin_amdgcn_permlane32_swap(a1_, b1_, false, false); \
        u32x4 w_ = {r0_[0], r1_[0], r0_[1], r1_[1]}; OUT = *reinterpret_cast<bf16x8*>(&w_); } while (0)

__device__ __forceinline__ void attn_block_b16(const bf16_t* __restrict__ Qg, const bf16_t* __restrict__ Kg, const bf16_t* __restrict__ Vg, bf16_t* __restrict__ Og, int qb, char* lds) {
    int tid = threadIdx.x; asm volatile("" : "+v"(tid));
    const int wid = __builtin_amdgcn_readfirstlane(tid >> 6), lane = tid & 63, r32 = lane & 31, hi = lane >> 5;
    const int P0 = qb * 256, NT = 4 * qb + 4, qlo = P0 + 32 * wid, qm = qlo + r32 - 4 * hi, NTW = (qlo >> 6) + 1;
    char* K_lds = lds + OFF_K; char* V_lds = lds + OFF_V;
    float* Ll = (float*)(lds + OFF_ML) + wid * 32; float* al_l = (float*)(lds + OFF_AL) + wid * 32;
    typedef __attribute__((address_space(3))) unsigned lds_u32;
    const int krow = lane >> 4, kslot = lane & 15;
    unsigned koff[2];
#pragma unroll
    for (int i = 0; i < 2; ++i) { const int r = 8 * wid + 4 * i + krow; koff[i] = (unsigned)(r * 256 + ((kslot ^ (r & 7)) << 4)); }
    unsigned voff[4];
#pragma unroll
    for (int i = 0; i < 4; ++i) { const int q = 64 * i + lane, stl = q >> 5, kk = 8 * wid + ((q & 31) >> 2), jj = q & 3;
        const int k = (kk & ~0xC) | ((kk & 4) << 1) | ((kk & 8) >> 1); voff[i] = (unsigned)(k * 512 + (stl * 32 + jj * 8) * 2); }
    const lds_u32* kdst = (const lds_u32*)((__attribute__((address_space(3))) char*)K_lds + wid * 2048);
    const lds_u32* vdst = (const lds_u32*)((__attribute__((address_space(3))) char*)V_lds + wid * 4096);
#define A2_DMAK(i) __builtin_amdgcn_global_load_lds((const unsigned*)(kgn + koff[i]), (lds_u32*)((__attribute__((address_space(3))) char*)kdst + bn2 * 16384 + (i) * 1024), 16, 0, 0)
#define A2_DMAV(i) __builtin_amdgcn_global_load_lds((const unsigned*)(vgn + voff[i]), (lds_u32*)((__attribute__((address_space(3))) char*)vdst + bn2 * 32768 + (i) * 1024), 16, 0, 0)
#define A2_DMA(k0, bf) do { const char* kg_ = (const char*)(Kg + (size_t)(k0) * 128); const char* vg_ = (const char*)(Vg + (size_t)(k0) * 256);                       \
        _Pragma("unroll") for (int i = 0; i < 2; ++i) __builtin_amdgcn_global_load_lds((const unsigned*)(kg_ + koff[i]), (lds_u32*)((__attribute__((address_space(3))) char*)kdst + (bf) * 16384 + i * 1024), 16, 0, 0); \
        _Pragma("unroll") for (int i = 0; i < 4; ++i) __builtin_amdgcn_global_load_lds((const unsigned*)(vg_ + voff[i]), (lds_u32*)((__attribute__((address_space(3))) char*)vdst + (bf) * 32768 + i * 1024), 16, 0, 0); } while (0)
    bf16x8 qf[8];
#pragma unroll
    for (int d0 = 0; d0 < 8; ++d0) qf[d0] = *(const bf16x8*)(Qg + (size_t)(qlo + r32) * 128 + d0 * 16 + hi * 8);
#define A2_BAR(n) do { asm volatile("s_waitcnt vmcnt(" #n ")" ::: "memory"); asm volatile("s_waitcnt lgkmcnt(0)" ::: "memory"); __builtin_amdgcn_s_barrier(); asm volatile("" ::: "memory"); } while (0)
    A2_DMA(0, 0); A2_DMA(64, 1);
    A2_BAR(6);
    float m_reg = -1e30f, l_reg = 0.f;
    f32x16 o[8];
#pragma unroll
    for (int d = 0; d < 8; ++d) o[d] = f32x16{};
    const int vrd0 = (int)(uintptr_t)V_lds + v_rd_base(lane);
    int buf = 0;
    int t = 0;
    for (; t < NTW; ++t) {
        const int kb = t * 64; const int bn2 = buf == 0 ? 2 : buf - 1;
        const bool more = t + 2 < NT;
        const char* kgn = (const char*)(Kg + (size_t)(kb + 128) * 128); const char* vgn = (const char*)(Vg + (size_t)(kb + 128) * 256);
        __builtin_amdgcn_sched_barrier(0);
        {
        bf16x8 pa0, pa1, pa2, pa3;
        const bool mset = m_reg > -1e29f; const float a0 = mset ? -m_reg : 0.f;
        f32x16 p0, p1;
#pragma unroll
        for (int r = 0; r < 16; ++r) { p0[r] = a0; p1[r] = a0; }
        {
            const int kp = (int)(uintptr_t)K_lds + buf * 16384;
            const int kad0 = kp + KSWZ(r32, 0 + hi * 16), kad1 = kp + KSWZ(r32, 32 + hi * 16), kad2 = kp + KSWZ(r32, 64 + hi * 16), kad3 = kp + KSWZ(r32, 96 + hi * 16);
            bf16x8 ka, kb_, kc;
#define A2_KRD(AD, OFF, X0) asm volatile("ds_read_b128 %0, %1 offset:%2" : "=&v"(X0) : "v"(AD), "i"(OFF) : "memory")
#define A2_KMM(P, d0, X0) do { P = __builtin_amdgcn_mfma_f32_32x32x16_bf16(X0, qf[d0], P, 0, 0, 0); __builtin_amdgcn_sched_barrier(0); } while (0)
#define A2_KLW(n) do { asm volatile("s_waitcnt lgkmcnt(" #n ")" ::: "memory"); __builtin_amdgcn_sched_barrier(0); } while (0)
            A2_KRD(kad0, 0, ka); A2_KRD(kad1, 0, kb_); A2_KRD(kad2, 0, kc);
            A2_KLW(2); A2_KMM(p0, 0, ka); A2_KRD(kad3, 0, ka);
            A2_KLW(2); A2_KMM(p0, 1, kb_); A2_KRD(kad0, 128, kb_);
            A2_KLW(2); A2_KMM(p0, 2, kc); A2_KRD(kad1, 128, kc);
            A2_KLW(2); A2_KMM(p0, 3, ka); A2_KRD(kad2, 128, ka);
            A2_KLW(2); A2_KMM(p0, 4, kb_); A2_KRD(kad3, 128, kb_);
            A2_KLW(2); A2_KMM(p0, 5, kc); A2_KRD(kad0, 8192, kc);
            A2_KLW(2); A2_KMM(p0, 6, ka); A2_KRD(kad1, 8192, ka);
            A2_KLW(2); A2_KMM(p0, 7, kb_); A2_KRD(kad2, 8192, kb_);
            A2_KLW(2); A2_KMM(p1, 0, kc); A2_KRD(kad3, 8192, kc);
            A2_KLW(2); A2_KMM(p1, 1, ka); A2_KRD(kad0, 8320, ka);
            A2_KLW(2); A2_KMM(p1, 2, kb_); A2_KRD(kad1, 8320, kb_);
            A2_KLW(2); A2_KMM(p1, 3, kc); A2_KRD(kad2, 8320, kc);
            A2_KLW(2); A2_KMM(p1, 4, ka); A2_KRD(kad3, 8320, ka);
            A2_KLW(2); A2_KMM(p1, 5, kb_);
            A2_KLW(1); A2_KMM(p1, 6, kc);
            A2_KLW(0); A2_KMM(p1, 7, ka);
#undef A2_KRD
#undef A2_KMM
#undef A2_KLW
        }
        if (kb + 63 > qlo) {
            const int dq = qm - kb; const float NEG = -__builtin_inff();
#pragma unroll
            for (int r = 0; r < 16; ++r) { const int c = (r & 3) + 8 * (r >> 2); if (dq - c < 0) p0[r] = NEG; if (dq - c - 32 < 0) p1[r] = NEG; }
        }
        {
            float pmax = fmaxf(fmaxf(fmaxf(p0[0], p0[1]), fmaxf(p0[2], p0[3])), fmaxf(fmaxf(p0[4], p0[5]), fmaxf(p0[6], p0[7])));
            pmax = fmaxf(pmax, fmaxf(fmaxf(fmaxf(p0[8], p0[9]), fmaxf(p0[10], p0[11])), fmaxf(fmaxf(p0[12], p0[13]), fmaxf(p0[14], p0[15]))));
            float pmx1 = fmaxf(fmaxf(fmaxf(p1[0], p1[1]), fmaxf(p1[2], p1[3])), fmaxf(fmaxf(p1[4], p1[5]), fmaxf(p1[6], p1[7])));
            pmx1 = fmaxf(pmx1, fmaxf(fmaxf(fmaxf(p1[8], p1[9]), fmaxf(p1[10], p1[11])), fmaxf(fmaxf(p1[12], p1[13]), fmaxf(p1[14], p1[15]))));
            pmax = fmaxf(pmax, pmx1);
            { auto rr = __builtin_amdgcn_permlane32_swap(__float_as_uint(pmax), __float_as_uint(pmax), false, false); pmax = fmaxf(__uint_as_float(rr[0]), __uint_as_float(rr[1])); }
            float alpha = 1.f;
            if (!__builtin_expect(__all(mset && pmax <= THR16 * 1.4426950408889634f), 1)) {
                const float mn = fmaxf(m_reg, pmax - a0), dl = -a0 - mn; alpha = __builtin_amdgcn_exp2f(m_reg - mn); m_reg = mn;
#pragma unroll
                for (int r = 0; r < 16; ++r) { p0[r] += dl; p1[r] += dl; } }
#pragma unroll
            for (int r = 0; r < 16; ++r) { p0[r] = __builtin_amdgcn_exp2f(p0[r]); p1[r] = __builtin_amdgcn_exp2f(p1[r]); }
            if (__any(alpha < 1.f)) {
                if (hi == 0) al_l[r32] = alpha;
                asm volatile("s_waitcnt lgkmcnt(0)" ::: "memory");
#pragma unroll
                for (int r = 0; r < 16; ++r) { const float ar = (al_l + 4 * hi)[(r & 3) + 8 * (r >> 2)];
#pragma unroll
                    for (int d = 0; d < 8; ++d) o[d][r] *= ar; }
            }
            float ps = ((p0[0] + p0[1]) + (p0[2] + p0[3])) + ((p0[4] + p0[5]) + (p0[6] + p0[7]));
            ps += ((p0[8] + p0[9]) + (p0[10] + p0[11])) + ((p0[12] + p0[13]) + (p0[14] + p0[15]));
            float ps1 = ((p1[0] + p1[1]) + (p1[2] + p1[3])) + ((p1[4] + p1[5]) + (p1[6] + p1[7]));
            ps1 += ((p1[8] + p1[9]) + (p1[10] + p1[11])) + ((p1[12] + p1[13]) + (p1[14] + p1[15]));
            ps += ps1;
            { auto rr = __builtin_amdgcn_permlane32_swap(__float_as_uint(ps), __float_as_uint(ps), false, false); ps = __uint_as_float(rr[0]) + __uint_as_float(rr[1]); }
            l_reg = l_reg * alpha + ps;
            A2_PK4(p0, 0, pa0); A2_PK4(p0, 8, pa1); A2_PK4(p1, 0, pa2); A2_PK4(p1, 8, pa3);
        }
        {
            const int vb = vrd0 + buf * 32768;
            s16x4 a0, a1, a2, a3, b0, b1, b2, b3, c0, c1, c2, c3;
#define A2_RD(h, d0, L0, H0, L1, H1) do { A2_TRRD(L0, vb, (h) * 16384 + (d0) * 512); A2_TRRD(H0, vb, (h) * 16384 + (d0) * 512 + 4096); A2_TRRD(L1, vb, (h) * 16384 + (d0) * 512 + 8192); A2_TRRD(H1, vb, (h) * 16384 + (d0) * 512 + 12288); } while (0)
#define A2_MM(PA, PB, d0, L0, H0, L1, H1) do { o[d0] = __builtin_amdgcn_mfma_f32_32x32x16_bf16(PA, (bf16x8){L0[0], L0[1], L0[2], L0[3], H0[0], H0[1], H0[2], H0[3]}, o[d0], 0, 0, 0);   \
                                               o[d0] = __builtin_amdgcn_mfma_f32_32x32x16_bf16(PB, (bf16x8){L1[0], L1[1], L1[2], L1[3], H1[0], H1[1], H1[2], H1[3]}, o[d0], 0, 0, 0); } while (0)
#define A2_LW(n) do { asm volatile("s_waitcnt lgkmcnt(" #n ")" ::: "memory"); __builtin_amdgcn_sched_barrier(0); } while (0)
#define A2_SB __builtin_amdgcn_sched_barrier(0)
            A2_RD(0, 0, a0, a1, a2, a3); A2_RD(0, 1, b0, b1, b2, b3);
            A2_RD(0, 2, c0, c1, c2, c3); A2_LW(8); A2_MM(pa0, pa1, 0, a0, a1, a2, a3); if (more) A2_DMAK(0); A2_SB;
            A2_RD(0, 3, a0, a1, a2, a3); A2_LW(8); A2_MM(pa0, pa1, 1, b0, b1, b2, b3); if (more) A2_DMAK(1); A2_SB;
            A2_RD(0, 4, b0, b1, b2, b3); A2_LW(8); A2_MM(pa0, pa1, 2, c0, c1, c2, c3); if (more) A2_DMAV(0); A2_SB;
            A2_RD(0, 5, c0, c1, c2, c3); A2_LW(8); A2_MM(pa0, pa1, 3, a0, a1, a2, a3); if (more) A2_DMAV(1); A2_SB;
            A2_RD(0, 6, a0, a1, a2, a3); A2_LW(8); A2_MM(pa0, pa1, 4, b0, b1, b2, b3); if (more) A2_DMAV(2); A2_SB;
            A2_RD(0, 7, b0, b1, b2, b3); A2_LW(8); A2_MM(pa0, pa1, 5, c0, c1, c2, c3); if (more) A2_DMAV(3); A2_SB;
            A2_RD(1, 0, c0, c1, c2, c3); A2_LW(8); A2_MM(pa0, pa1, 6, a0, a1, a2, a3); A2_SB;
            A2_RD(1, 1, a0, a1, a2, a3); A2_LW(8); A2_MM(pa0, pa1, 7, b0, b1, b2, b3); A2_SB;
            A2_RD(1, 2, b0, b1, b2, b3); A2_LW(8); A2_MM(pa2, pa3, 0, c0, c1, c2, c3); A2_SB;
            A2_RD(1, 3, c0, c1, c2, c3); A2_LW(8); A2_MM(pa2, pa3, 1, a0, a1, a2, a3); A2_SB;
            A2_RD(1, 4, a0, a1, a2, a3); A2_LW(8); A2_MM(pa2, pa3, 2, b0, b1, b2, b3); A2_SB;
            A2_RD(1, 5, b0, b1, b2, b3); A2_LW(8); A2_MM(pa2, pa3, 3, c0, c1, c2, c3); A2_SB;
            A2_RD(1, 6, c0, c1, c2, c3); A2_LW(8); A2_MM(pa2, pa3, 4, a0, a1, a2, a3); A2_SB;
            A2_RD(1, 7, a0, a1, a2, a3); A2_LW(8); A2_MM(pa2, pa3, 5, b0, b1, b2, b3); A2_SB;
            A2_LW(4); A2_MM(pa2, pa3, 6, c0, c1, c2, c3); A2_SB;
            A2_LW(0); A2_MM(pa2, pa3, 7, a0, a1, a2, a3);
#undef A2_RD
#undef A2_MM
#undef A2_LW
#undef A2_SB
        }
        }
        __builtin_amdgcn_sched_barrier(0);
        if (t + 2 < NT) A2_BAR(6); else A2_BAR(0);
        buf = buf == 2 ? 0 : buf + 1;
    }
    for (; t < NT; ++t) {
        const int kb = t * 64; const int bn2 = buf == 0 ? 2 : buf - 1; const bool more = t + 2 < NT;
        const char* kgn = (const char*)(Kg + (size_t)(kb + 128) * 128); const char* vgn = (const char*)(Vg + (size_t)(kb + 128) * 256);
        if (more) { A2_DMAK(0); A2_DMAK(1); A2_DMAV(0); A2_DMAV(1); A2_DMAV(2); A2_DMAV(3); }
        if (t + 2 < NT) A2_BAR(6); else A2_BAR(0);
        buf = buf == 2 ? 0 : buf + 1;
    }
    if (hi == 0) Ll[r32] = l_reg;
    asm volatile("s_waitcnt lgkmcnt(0)" ::: "memory");
    int tid2 = threadIdx.x; asm volatile("" : "+v"(tid2));
    const int e32 = tid2 & 31, ehi = (tid2 >> 5) & 1;
    float f[16];
#pragma unroll
    for (int r = 0; r < 16; ++r) f[r] = __builtin_amdgcn_rcpf((Ll + 4 * ehi)[(r & 3) + 8 * (r >> 2)]);
    {
        char* ob = (char*)(Og + (size_t)(qlo + 4 * ehi) * 256 + e32);
#pragma unroll
        for (int d0 = 0; d0 < 8; ++d0)
#pragma unroll
            for (int r = 0; r < 16; ++r) { const int rc = (r & 3) + 8 * (r >> 2); const float v = o[d0][r] * f[r], vn = __shfl_xor(v, 1);
                if ((e32 & 1) == 0) *(unsigned*)(ob + (rc * 256 + 32 * d0) * 2) = cvtpk(v, vn); }
    }
    __syncthreads();
#undef A2_DMA
#undef A2_DMAK
#undef A2_DMAV
#undef A2_BAR
}
typedef int i32x8 __attribute__((ext_vector_type(8)));
typedef int i32x4_ __attribute__((ext_vector_type(4)));
__device__ __forceinline__ void attn_block(const unsigned char* __restrict__ Q8, const unsigned char* __restrict__ K8, int jsh, const unsigned char* __restrict__ V8, float vinv, bf16_t* __restrict__ Og, int qb, char* lds) {
    int tid = threadIdx.x; asm volatile("" : "+v"(tid));
    const int wid = __builtin_amdgcn_readfirstlane(tid >> 6), lane = tid & 63, r32 = lane & 31, hi = lane >> 5;
    const int P0 = qb * 256, NT = 4 * qb + 4, qlo = P0 + 32 * wid, qm = qlo + r32 - 4 * hi, NTW = (qlo >> 6) + 1;
    char* K_lds = lds + OFF_K; char* V_lds = lds + OFF_V;
    float* Ll = (float*)(lds + OFF_ML) + wid * 32; float* al_l = (float*)(lds + OFF_AL) + wid * 32;
    typedef __attribute__((address_space(3))) unsigned lds_u32;
    unsigned koff;
    { const int q = wid * 64 + lane, r = q >> 3, sl = q & 7; koff = (unsigned)(r * 128 + ((sl ^ ((r >> 1) & 7)) << 4)); }
    unsigned voff[2];
#pragma unroll
    for (int i = 0; i < 2; ++i) { const int q = (2 * wid + i) * 64 + lane, dv = q >> 2, sl = q & 3; voff[i] = (unsigned)(dv * 64 + ((sl ^ ((dv >> 2) & 3)) << 4)); }
    const lds_u32* kdst = (const lds_u32*)((__attribute__((address_space(3))) char*)K_lds + wid * 1024);
    const lds_u32* vdst = (const lds_u32*)((__attribute__((address_space(3))) char*)V_lds + wid * 2048);
#define A2_DMAK() __builtin_amdgcn_global_load_lds((const unsigned*)(kgn + koff), (lds_u32*)((__attribute__((address_space(3))) char*)kdst + bn2 * 8192), 16, 0, 0)
#define A2_DMAV(i) __builtin_amdgcn_global_load_lds((const unsigned*)(vgn + voff[i]), (lds_u32*)((__attribute__((address_space(3))) char*)vdst + bn2 * 16384 + (i) * 1024), 16, 0, 0)
#define A2_DMA(tt, bf) do { const char* kg_ = (const char*)(K8 + (size_t)(tt) * 8192); const char* vg_ = (const char*)(V8 + (size_t)(tt) * 16384);                       \
        __builtin_amdgcn_global_load_lds((const unsigned*)(kg_ + koff), (lds_u32*)((__attribute__((address_space(3))) char*)kdst + (bf) * 8192), 16, 0, 0); \
        _Pragma("unroll") for (int i = 0; i < 2; ++i) __builtin_amdgcn_global_load_lds((const unsigned*)(vg_ + voff[i]), (lds_u32*)((__attribute__((address_space(3))) char*)vdst + (bf) * 16384 + i * 1024), 16, 0, 0); } while (0)
    i32x8 qf0, qf1;
    { const i32x4_* qp = (const i32x4_*)(Q8 + (size_t)(qlo + r32) * 128 + hi * 32); const i32x4_ a = qp[0], b = qp[1], c_ = qp[4], d = qp[5];
      qf0 = (i32x8){a[0], a[1], a[2], a[3], b[0], b[1], b[2], b[3]}; qf1 = (i32x8){c_[0], c_[1], c_[2], c_[3], d[0], d[1], d[2], d[3]}; }
    const int scq = (127 - jsh) & 0xff;
#define A2_BAR(n) do { asm volatile("s_waitcnt vmcnt(" #n ")" ::: "memory"); asm volatile("s_waitcnt lgkmcnt(0)" ::: "memory"); __builtin_amdgcn_s_barrier(); asm volatile("" ::: "memory"); } while (0)
    A2_DMA(0, 0); A2_DMA(1, 1);
    A2_BAR(3);
    float m_reg = -1e30f, l_reg = 0.f;
    f32x16 o[8];
#pragma unroll
    for (int d = 0; d < 8; ++d) o[d] = f32x16{};
    const int vrd0 = (int)(uintptr_t)V_lds + r32 * 64 + (((2 * hi) ^ ((r32 >> 2) & 3)) << 4);
    const int sc1 = 0x7f7f7f7f;
    int buf = 0;
    int t = 0;
    for (; t < NTW; ++t) {
        const int kb = t * 64; const int bn2 = buf == 0 ? 2 : buf - 1;
        const bool more = t + 2 < NT;
        const char* kgn = (const char*)(K8 + (size_t)(t + 2) * 8192); const char* vgn = (const char*)(V8 + (size_t)(t + 2) * 16384);
        __builtin_amdgcn_sched_barrier(0);
        {
        i32x8 pf;
        const bool mset = m_reg > -1e29f; const float a0 = mset ? PSH - m_reg : 0.f;
        f32x16 p0, p1;
#pragma unroll
        for (int r = 0; r < 16; ++r) { p0[r] = a0; p1[r] = a0; }
        {
            const int ka_ = (int)(uintptr_t)K_lds + buf * 8192 + r32 * 128 + (((2 * hi) ^ ((r32 >> 1) & 7)) << 4);
            const int kb1 = ka_ ^ 16, kc0 = ka_ ^ 64, kc1 = ka_ ^ 80;
            i32x4_ x0, x1, y0, y1, z0, z1, w0, w1;
            asm volatile("ds_read_b128 %0, %1" : "=&v"(x0) : "v"(ka_) : "memory"); asm volatile("ds_read_b128 %0, %1" : "=&v"(x1) : "v"(kb1) : "memory");
            asm volatile("ds_read_b128 %0, %1" : "=&v"(y0) : "v"(kc0) : "memory"); asm volatile("ds_read_b128 %0, %1" : "=&v"(y1) : "v"(kc1) : "memory");
            asm volatile("ds_read_b128 %0, %1 offset:4096" : "=&v"(z0) : "v"(ka_) : "memory"); asm volatile("ds_read_b128 %0, %1 offset:4096" : "=&v"(z1) : "v"(kb1) : "memory");
            asm volatile("ds_read_b128 %0, %1 offset:4096" : "=&v"(w0) : "v"(kc0) : "memory"); asm volatile("ds_read_b128 %0, %1 offset:4096" : "=&v"(w1) : "v"(kc1) : "memory");
            asm volatile("s_waitcnt lgkmcnt(6)" ::: "memory"); __builtin_amdgcn_sched_barrier(0);
            p0 = __builtin_amdgcn_mfma_scale_f32_32x32x64_f8f6f4((i32x8){x0[0], x0[1], x0[2], x0[3], x1[0], x1[1], x1[2], x1[3]}, qf0, p0, 0, 0, 0, scq, 0, sc1); __builtin_amdgcn_sched_barrier(0);
            asm volatile("s_waitcnt lgkmcnt(2)" ::: "memory"); __builtin_amdgcn_sched_barrier(0);
            p1 = __builtin_amdgcn_mfma_scale_f32_32x32x64_f8f6f4((i32x8){z0[0], z0[1], z0[2], z0[3], z1[0], z1[1], z1[2], z1[3]}, qf0, p1, 0, 0, 0, scq, 0, sc1); __builtin_amdgcn_sched_barrier(0);
            p0 = __builtin_amdgcn_mfma_scale_f32_32x32x64_f8f6f4((i32x8){y0[0], y0[1], y0[2], y0[3], y1[0], y1[1], y1[2], y1[3]}, qf1, p0, 0, 0, 0, scq, 0, sc1); __builtin_amdgcn_sched_barrier(0);
            asm volatile("s_waitcnt lgkmcnt(0)" ::: "memory"); __builtin_amdgcn_sched_barrier(0);
            p1 = __builtin_amdgcn_mfma_scale_f32_32x32x64_f8f6f4((i32x8){w0[0], w0[1], w0[2], w0[3], w1[0], w1[1], w1[2], w1[3]}, qf1, p1, 0, 0, 0, scq, 0, sc1); asm volatile("" : "+v"(p0), "+v"(p1)); __builtin_amdgcn_sched_barrier(0);
        }
        if (kb + 63 > qlo) {
            const int dq = qm - kb; const float NEG = -__builtin_inff();
#pragma unroll
            for (int r = 0; r < 16; ++r) { const int c = (r & 3) + 8 * (r >> 2); if (dq - c < 0) p0[r] = NEG; if (dq - c - 32 < 0) p1[r] = NEG; }
        }
        {
            float pmax = fmaxf(fmaxf(fmaxf(p0[0], p0[1]), fmaxf(p0[2], p0[3])), fmaxf(fmaxf(p0[4], p0[5]), fmaxf(p0[6], p0[7])));
            pmax = fmaxf(pmax, fmaxf(fmaxf(fmaxf(p0[8], p0[9]), fmaxf(p0[10], p0[11])), fmaxf(fmaxf(p0[12], p0[13]), fmaxf(p0[14], p0[15]))));
            float pmx1 = fmaxf(fmaxf(fmaxf(p1[0], p1[1]), fmaxf(p1[2], p1[3])), fmaxf(fmaxf(p1[4], p1[5]), fmaxf(p1[6], p1[7])));
            pmx1 = fmaxf(pmx1, fmaxf(fmaxf(fmaxf(p1[8], p1[9]), fmaxf(p1[10], p1[11])), fmaxf(fmaxf(p1[12], p1[13]), fmaxf(p1[14], p1[15]))));
            pmax = fmaxf(pmax, pmx1);
            { auto rr = __builtin_amdgcn_permlane32_swap(__float_as_uint(pmax), __float_as_uint(pmax), false, false); pmax = fmaxf(__uint_as_float(rr[0]), __uint_as_float(rr[1])); }
            float alpha = 1.f;
            if (!__builtin_expect(__all(mset && pmax <= PSH + THR * 1.4426950408889634f), 1)) {
                const float mn = fmaxf(m_reg, pmax - a0), dl = (PSH - mn) - a0; alpha = __builtin_amdgcn_exp2f(m_reg - mn); m_reg = mn;
#pragma unroll
                for (int r = 0; r < 16; ++r) { p0[r] += dl; p1[r] += dl; } }
#pragma unroll
            for (int r = 0; r < 16; ++r) { p0[r] = __builtin_amdgcn_exp2f(p0[r]); p1[r] = __builtin_amdgcn_exp2f(p1[r]); }
            if (__any(alpha < 1.f)) {
                if (hi == 0) al_l[r32] = alpha;
                asm volatile("s_waitcnt lgkmcnt(0)" ::: "memory");
#pragma unroll
                for (int r = 0; r < 16; ++r) { const float ar = (al_l + 4 * hi)[(r & 3) + 8 * (r >> 2)];
#pragma unroll
                    for (int d = 0; d < 8; ++d) o[d][r] *= ar; }
            }
            float ps = ((p0[0] + p0[1]) + (p0[2] + p0[3])) + ((p0[4] + p0[5]) + (p0[6] + p0[7]));
            ps += ((p0[8] + p0[9]) + (p0[10] + p0[11])) + ((p0[12] + p0[13]) + (p0[14] + p0[15]));
            float ps1 = ((p1[0] + p1[1]) + (p1[2] + p1[3])) + ((p1[4] + p1[5]) + (p1[6] + p1[7]));
            ps1 += ((p1[8] + p1[9]) + (p1[10] + p1[11])) + ((p1[12] + p1[13]) + (p1[14] + p1[15]));
            ps += ps1;
            { auto rr = __builtin_amdgcn_permlane32_swap(__float_as_uint(ps), __float_as_uint(ps), false, false); ps = __uint_as_float(rr[0]) + __uint_as_float(rr[1]); }
            l_reg = l_reg * alpha + ps;
#pragma unroll
            for (int i = 0; i < 4; ++i) { int w = 0; w = __builtin_amdgcn_cvt_pk_fp8_f32(p0[4 * i], p0[4 * i + 1], w, false); w = __builtin_amdgcn_cvt_pk_fp8_f32(p0[4 * i + 2], p0[4 * i + 3], w, true); pf[i] = w;
                                          int u = 0; u = __builtin_amdgcn_cvt_pk_fp8_f32(p1[4 * i], p1[4 * i + 1], u, false); u = __builtin_amdgcn_cvt_pk_fp8_f32(p1[4 * i + 2], p1[4 * i + 3], u, true); pf[4 + i] = u; }
            asm volatile("" : "+v"(pf)); __builtin_amdgcn_sched_barrier(0);
        }
        {
            const int va = vrd0 + buf * 16384, vx = va ^ 16;
            i32x4_ a0, a1, b0, b1, c0, c1;
#define A2_RD(d0, X0, X1) do { asm volatile("ds_read_b128 %0, %1 offset:%2" : "=&v"(X0) : "v"(va), "i"((d0) * 2048) : "memory"); asm volatile("ds_read_b128 %0, %1 offset:%2" : "=&v"(X1) : "v"(vx), "i"((d0) * 2048) : "memory"); } while (0)
#define A2_MM(d0, X0, X1) do { o[d0] = __builtin_amdgcn_mfma_scale_f32_32x32x64_f8f6f4(pf, (i32x8){X0[0], X0[1], X0[2], X0[3], X1[0], X1[1], X1[2], X1[3]}, o[d0], 0, 0, 0, sc1, 0, sc1); asm volatile("" : "+v"(o[d0])); } while (0)
#define A2_LW(n) do { asm volatile("s_waitcnt lgkmcnt(" #n ")" ::: "memory"); __builtin_amdgcn_sched_barrier(0); } while (0)
#define A2_SB __builtin_amdgcn_sched_barrier(0)
            A2_RD(0, a0, a1); A2_RD(1, b0, b1);
            A2_RD(2, c0, c1); A2_LW(4); A2_MM(0, a0, a1); if (more) A2_DMAK(); A2_SB;
            A2_RD(3, a0, a1); A2_LW(4); A2_MM(1, b0, b1); A2_SB;
            A2_RD(4, b0, b1); A2_LW(4); A2_MM(2, c0, c1); if (more) A2_DMAV(0); A2_SB;
            A2_RD(5, c0, c1); A2_LW(4); A2_MM(3, a0, a1); if (more) A2_DMAV(1); A2_SB;
            A2_RD(6, a0, a1); A2_LW(4); A2_MM(4, b0, b1); A2_SB;
            A2_RD(7, b0, b1); A2_LW(4); A2_MM(5, c0, c1); A2_SB;
            A2_LW(2); A2_MM(6, a0, a1); A2_SB;
            A2_LW(0); A2_MM(7, b0, b1);
#undef A2_RD
#undef A2_MM
#undef A2_LW
#undef A2_SB
        }
        }
        __builtin_amdgcn_sched_barrier(0);
        if (t + 2 < NT) A2_BAR(3); else A2_BAR(0);
        buf = buf == 2 ? 0 : buf + 1;
    }
    for (; t < NT; ++t) {
        const int kb = t * 64; const int bn2 = buf == 0 ? 2 : buf - 1; const bool more = t + 2 < NT;
        const char* kgn = (const char*)(K8 + (size_t)(t + 2) * 8192); const char* vgn = (const char*)(V8 + (size_t)(t + 2) * 16384);
        if (more) { A2_DMAK(); A2_DMAV(0); A2_DMAV(1); }
        if (t + 2 < NT) A2_BAR(3); else A2_BAR(0);
        buf = buf == 2 ? 0 : buf + 1;
    }
    if (hi == 0) Ll[r32] = l_reg;
    asm volatile("s_waitcnt lgkmcnt(0)" ::: "memory");
    int tid2 = threadIdx.x; asm volatile("" : "+v"(tid2));
    const int e32 = tid2 & 31, ehi = (tid2 >> 5) & 1;
    float f[16];
#pragma unroll
    for (int r = 0; r < 16; ++r) f[r] = vinv * __builtin_amdgcn_rcpf((Ll + 4 * ehi)[(r & 3) + 8 * (r >> 2)]);
    {
        char* ob = (char*)(Og + (size_t)(qlo + 4 * ehi) * 256 + e32);
#pragma unroll
        for (int d0 = 0; d0 < 8; ++d0)
#pragma unroll
            for (int r = 0; r < 16; ++r) { const int rc = (r & 3) + 8 * (r >> 2); const float v = o[d0][r] * f[r], vn = __shfl_xor(v, 1);
                if ((e32 & 1) == 0) *(unsigned*)(ob + (rc * 256 + 32 * d0) * 2) = cvtpk(v, vn); }
    }
    __syncthreads();
#undef A2_DMA
#undef A2_DMAK
#undef A2_DMAV
#undef A2_BAR
}
#undef A2_TRRD
#undef A2_PK4
}

constexpr int S_ = 16384, DM = 2048, NIN = 5120, AW = 1024, RW = 1024, NMEM = 256, NE = 32, TOPK = 4, DFF = 2048;
constexpr int NWAVES = 8, NTHREADS = 512;
constexpr float EPS_ = 1e-6f, DA_EPS_ = 1e-5f, LAMBDA_INIT = 0.2f;
constexpr int MPAD_TILES = 288;
#ifndef MK_N_LAUNCHES
#define MK_N_LAUNCHES 1
#endif
constexpr int N_PHASES = 16;
#ifndef MK_NCV
#define MK_NCV 0
#endif
constexpr int NCV = MK_NCV;

constexpr size_t MiB = 1u << 20;
constexpr size_t WS_CTL = 0, CTL_ZERO_BYTES = 1 * MiB;
constexpr size_t WS_SMALL = 1 * MiB;
constexpr size_t WS_LPART = WS_SMALL + 0 * MiB;
constexpr size_t WS_ACH = WS_SMALL + 1 * MiB;
constexpr size_t WS_HCH = WS_SMALL + 2 * MiB;
constexpr size_t WS_CARRY = WS_SMALL + 3 * MiB;
constexpr size_t WS_TOPE = WS_SMALL + 4 * MiB;
constexpr size_t WS_TOPG = WS_TOPE + 256 * 1024;
constexpr size_t WS_POSOF = WS_TOPG + 256 * 1024;
constexpr size_t WS_TCNT = WS_POSOF + 256 * 1024;
constexpr size_t WS_ROWGATE = WS_SMALL + 5 * MiB;
constexpr size_t WS_TILEEXP = WS_ROWGATE + 512 * 1024;
constexpr size_t WS_NRT = WS_TILEEXP + 4096;
constexpr size_t WS_WRGT = WS_SMALL + 6 * MiB;
constexpr size_t WS_MEMN = WS_SMALL + 7 * MiB;
constexpr size_t WS_KM = WS_SMALL + 8 * MiB;
constexpr size_t WS_VT = WS_SMALL + 9 * MiB;
constexpr size_t WS_SBGU = WS_SMALL + 10 * MiB;
constexpr size_t WS_SBDN = WS_SMALL + 10 * MiB + 512 * 1024;
constexpr size_t WS_SBIN = WS_SMALL + 16 * MiB;
constexpr size_t WS_SBOUT = WS_SMALL + 18 * MiB;
constexpr size_t WS_MIXSCALE = WS_SMALL + 19 * MiB;
constexpr size_t WS_SBCQ = WS_SMALL + 20 * MiB, WS_SBCO = WS_SMALL + 21 * MiB;
constexpr size_t WS_SRCTOK = WS_SMALL + 23 * MiB;
constexpr size_t WS_INSCALE = WS_SMALL + 17 * MiB;
constexpr size_t WS_ROWSCALE = WS_SMALL + 11 * MiB;
constexpr size_t WS_TOKSCALE = WS_SMALL + 12 * MiB;
constexpr size_t WS_SSQ = WS_SMALL + 13 * MiB;
constexpr size_t WS_WIN = 32 * MiB, WS_WOUT = 52 * MiB, WS_WCQ = 60 * MiB, WS_WCKV = 68 * MiB, WS_WCO = 84 * MiB;
constexpr size_t WS_WGU = 128 * MiB, WS_WDN = 640 * MiB;
constexpr size_t WS_XN = 896 * MiB;
constexpr size_t WS_Q = 960 * MiB, WS_K = 992 * MiB, WS_V = 1024 * MiB;
constexpr size_t WS_XR = 1056 * MiB, WS_XG = 1088 * MiB;
constexpr size_t WS_AO = 1120 * MiB;
constexpr size_t WS_HL = 1184 * MiB, WS_ACUM = 1248 * MiB;
constexpr size_t WS_MIX = 1312 * MiB;
constexpr size_t WS_H = 1376 * MiB;
constexpr size_t WS_QC = 1504 * MiB;
constexpr size_t WS_PC = 1568 * MiB;
constexpr size_t WS_OC = 1600 * MiB;
constexpr size_t WS_XS = 1664 * MiB, WS_ACT = 1952 * MiB, WS_YB = 2240 * MiB;
constexpr float ACT_QSCALE = 16.0f / 127.0f;
constexpr size_t WS_END = 2528 * MiB;
constexpr int CW_VMAX = 12288;
constexpr int CW_BAR = 4096;

constexpr int SCR_BYTES = 159744;
constexpr int MISC_OFF = SCR_BYTES;
constexpr int LDS_BYTES = 163840;

#define GAS __attribute__((address_space(1)))
#define LAS __attribute__((address_space(3)))
typedef unsigned short bf16_t;
typedef unsigned u32x4 __attribute__((ext_vector_type(4)));
typedef unsigned u32x2 __attribute__((ext_vector_type(2)));
typedef float f32x4 __attribute__((ext_vector_type(4)));
typedef short bf16x8 __attribute__((ext_vector_type(8)));
#define LDS_WAIT() asm volatile("s_waitcnt lgkmcnt(0)" ::: "memory")
#define VM_WAIT() asm volatile("s_waitcnt vmcnt(0)" ::: "memory")
__device__ __forceinline__ unsigned pk2(float lo, float hi) { return pg8::cvt_pk_bf16(lo, hi); }
__device__ __forceinline__ float bflo(unsigned w) { return __uint_as_float(w << 16); }
__device__ __forceinline__ float bfhi(unsigned w) { return __uint_as_float(w & 0xffff0000u); }
__device__ __forceinline__ f32x4 ld_bf16x4(const bf16_t* p) { const u32x2 w = *(const u32x2*)p; return (f32x4){bflo(w.x), bfhi(w.x), bflo(w.y), bfhi(w.y)}; }
__device__ __forceinline__ void st_bf16x4(bf16_t* p, f32x4 v) { u32x2 w; w.x = pk2(v[0], v[1]); w.y = pk2(v[2], v[3]); *(u32x2*)p = w; }
__device__ __forceinline__ float bf1(bf16_t h) { return __uint_as_float((unsigned)h << 16); }

#define XB_TMO      128
#define XB_XCNT(j)  (256  + 64 * (j))
#define XB_XSUB(j)  (1280 + 64 * (j))
#define XB_XGEN(j)  (2304 + 64 * (j))
#define XB_TOP      3328
#define XB_TOPGEN   3392
#define XCD_BAR_WORDS 3456
#define XB_SPIN_CAP (1u << 18)

__device__ __forceinline__ unsigned xb_ld(unsigned* p)              { return __hip_atomic_load(p, __ATOMIC_RELAXED, __HIP_MEMORY_SCOPE_AGENT); }
__device__ __forceinline__ unsigned xb_add(unsigned* p, unsigned v) { return __hip_atomic_fetch_add(p, v, __ATOMIC_RELAXED, __HIP_MEMORY_SCOPE_AGENT); }
__device__ __forceinline__ unsigned xb_xcc_id() { return (unsigned)__builtin_amdgcn_s_getreg((3 << 11) | 20) & 0xFu; }
#define XB_SPIN(cond, bar) do { unsigned _sp = 0; while (cond) { __builtin_amdgcn_s_sleep(1); \
    if ((++_sp & 255u) == 0u) { if (xb_ld(&(bar)[XB_TMO])) break; if (_sp > XB_SPIN_CAP) { atomicAdd(&(bar)[XB_TMO], 1u); break; } } } } while (0)

struct XcdBarrier {
    unsigned* bar; unsigned x;
    volatile LAS unsigned* st;
};
__device__ __forceinline__ XcdBarrier xcd_barrier_post(unsigned* bar, volatile LAS unsigned* st) {
    XcdBarrier b; b.bar = bar; b.x = xb_xcc_id(); b.st = st;
    if (threadIdx.x == 0) (void)xb_add(&bar[XB_XCNT(b.x)], 1u);
    return b;
}
__device__ __forceinline__ void xcd_barrier_complete(unsigned* bar, unsigned x, unsigned& nloc, unsigned& nx) {
    const unsigned G = gridDim.x * gridDim.y * gridDim.z;
    unsigned sum, cnt, mine, sp = 0u;
    for (;;) {
        sum = 0u; cnt = 0u; mine = 0u;
#pragma unroll
        for (unsigned j = 0; j < 16; ++j) { const unsigned c = xb_ld(&bar[XB_XCNT(j)]); sum += c; cnt += (c > 0u) ? 1u : 0u; mine = (j == x) ? c : mine; }
        if (sum == G) break;
        __builtin_amdgcn_s_sleep(1);
        if ((++sp & 255u) == 0u) { if (xb_ld(&bar[XB_TMO])) break; if (sp > XB_SPIN_CAP) { atomicAdd(&bar[XB_TMO], 1u); break; } }
    }
    nloc = mine > 0u ? mine : 1u; nx = cnt > 0u ? cnt : 1u;
}
__device__ __forceinline__ void xcd_barrier(const XcdBarrier& b) {
    asm volatile("s_waitcnt vmcnt(0)" ::: "memory");
    __syncthreads();
    if (threadIdx.x == 0) {
        unsigned* bar = b.bar;
        __builtin_amdgcn_s_waitcnt(0);
        unsigned nloc = b.st[0], nx = b.st[1];
        if (nloc == 0u) { xcd_barrier_complete(bar, b.x, nloc, nx); b.st[0] = nloc; b.st[1] = nx; }
        const unsigned old = xb_add(&bar[XB_XSUB(b.x)], 1u);
        const unsigned gen = old / nloc;
        if (old + 1u == (gen + 1u) * nloc) {
            __builtin_amdgcn_fence(__ATOMIC_RELEASE, "agent");
            asm volatile("s_waitcnt vmcnt(0)" ::: "memory");
            const unsigned og = xb_add(&bar[XB_TOP], 1u);
            const unsigned tg = og / nx;
            if (og + 1u == (tg + 1u) * nx) xb_add(&bar[XB_TOPGEN], 1u);
            else XB_SPIN(xb_ld(&bar[XB_TOPGEN]) == tg, bar);
            __builtin_amdgcn_fence(__ATOMIC_ACQUIRE, "agent");
            xb_add(&bar[XB_XGEN(b.x)], 1u);
            asm volatile("s_waitcnt vmcnt(0)" ::: "memory");
        } else {
            XB_SPIN(xb_ld(&bar[XB_XGEN(b.x)]) == gen, bar);
            __builtin_amdgcn_fence(__ATOMIC_ACQUIRE, "agent");
            asm volatile("s_waitcnt vmcnt(0)" ::: "memory");
        }
    }
    __syncthreads();
}

__device__ __forceinline__ float wave_sum(float v) {
#pragma unroll
    for (int o = 1; o < 64; o <<= 1) v += __shfl_xor(v, o);
    return v;
}
__device__ __forceinline__ float sigmoidf_(float x) { return __builtin_amdgcn_rcpf(1.0f + __builtin_amdgcn_exp2f(-1.4426950408889634f * x)); }
__device__ __forceinline__ float gelu_tanh(float x) { const float u = 0.7978845608028654f * (x + 0.044715f * x * x * x); return 0.5f * x * (1.0f + tanhf(u)); }

__device__ __forceinline__ void p0_transpose_item(const float* W, int K, int N, bf16_t* WT, int k0, int n0, int drow0, LAS float* scr, int lane, const float* kscale = nullptr) {
#pragma unroll 8
    for (int i = 0; i < 32; ++i) { const int kk = 2 * i + (lane >> 5); float wv = W[(size_t)(k0 + kk) * N + n0 + (lane & 31)]; if (kscale) wv *= kscale[k0 + kk]; scr[kk * 33 + (lane & 31)] = wv; }
    LDS_WAIT(); asm volatile("" ::: "memory");
    const int c = lane & 7;
#pragma unroll
    for (int j = 0; j < 4; ++j) { const int n = (lane >> 3) + 8 * j; const LAS float* s = scr + (8 * c) * 33 + n;
        u32x4 o; o.x = pk2(s[0 * 33], s[1 * 33]); o.y = pk2(s[2 * 33], s[3 * 33]); o.z = pk2(s[4 * 33], s[5 * 33]); o.w = pk2(s[6 * 33], s[7 * 33]);
        *(u32x4*)(WT + (size_t)(drow0 + n) * K + k0 + 8 * c) = o; }
    LDS_WAIT(); asm volatile("" ::: "memory");
}
__device__ __forceinline__ void rms_row_bf16(const float* xrow, const float* g, bf16_t* orow, int lane) {
    const f32x4* xr = (const f32x4*)xrow + lane; const f32x4* gr = (const f32x4*)g + lane;
    f32x4 v[8]; float s = 0.f;
#pragma unroll
    for (int j = 0; j < 8; ++j) { v[j] = xr[64 * j]; s += (v[j].x * v[j].x + v[j].y * v[j].y) + (v[j].z * v[j].z + v[j].w * v[j].w); }
    const float r = rsqrtf(wave_sum(s) * (1.f / 2048.f) + EPS_);
    u32x2* o8 = (u32x2*)orow + lane;
#pragma unroll
    for (int j = 0; j < 8; ++j) { const f32x4 gg = gr[64 * j]; u32x2 o; o.x = pk2(v[j].x * r * gg.x, v[j].y * r * gg.y); o.y = pk2(v[j].z * r * gg.z, v[j].w * r * gg.w); o8[64 * j] = o; }
}

__device__ __forceinline__ void rms_row_i8(f32x4 (&v)[8], const float* g, signed char* orow, float* scale_out, int lane) {
    const f32x4* gr = (const f32x4*)g + lane;
    float s = 0.f;
#pragma unroll
    for (int j = 0; j < 8; ++j) s += (v[j].x * v[j].x + v[j].y * v[j].y) + (v[j].z * v[j].z + v[j].w * v[j].w);
    const float r = rsqrtf(wave_sum(s) * (1.f / 2048.f) + 1e-6f);
    float am = 0.f;
#pragma unroll
    for (int j = 0; j < 8; ++j) { const f32x4 gg = gr[64 * j]; v[j].x *= r * gg.x; v[j].y *= r * gg.y; v[j].z *= r * gg.z; v[j].w *= r * gg.w;
        am = fmaxf(fmaxf(am, fmaxf(fabsf(v[j].x), fabsf(v[j].y))), fmaxf(fabsf(v[j].z), fabsf(v[j].w))); }
#pragma unroll
    for (int o = 32; o > 0; o >>= 1) am = fmaxf(am, __shfl_xor(am, o));
    const float inv = am > 0.f ? 127.0f / am : 0.f;
    unsigned* o4 = (unsigned*)orow + lane;
#pragma unroll
    for (int j = 0; j < 8; ++j) {
        const unsigned f0 = __float_as_uint(fmaf(v[j].x, inv, 12582912.0f)), f1 = __float_as_uint(fmaf(v[j].y, inv, 12582912.0f)), f2 = __float_as_uint(fmaf(v[j].z, inv, 12582912.0f)), f3 = __float_as_uint(fmaf(v[j].w, inv, 12582912.0f));
        o4[64 * j] = __builtin_amdgcn_perm(__builtin_amdgcn_perm(f3, f2, 0x0c0c0400u), __builtin_amdgcn_perm(f1, f0, 0x0c0c0400u), 0x05040100u); }
    if (lane == 0) *scale_out = am > 0.f ? am * (1.0f / 127.0f) : 1.0f;
}

struct Args { const float* in[31]; float* out; unsigned char* ws; int ph_lo, ph_hi; };
typedef const __attribute__((address_space(4))) Args CArgs;
__device__ __forceinline__ CArgs* kargs() { CArgs* p = (CArgs*)__builtin_amdgcn_kernarg_segment_ptr(); asm volatile("" : "+s"(p)); return p; }
__device__ __forceinline__ int lane_id() { int t = threadIdx.x; asm volatile("" : "+v"(t)); return t & 63; }
__device__ __forceinline__ int wave_id() { return __builtin_amdgcn_readfirstlane(threadIdx.x >> 6); }
enum { I_X = 0, I_MEM, I_NORM_MIX_G, I_W_IN, I_CONV_W, I_CONV_B, I_W_RG_A, I_B_RG_A, I_W_RG_X, I_B_RG_X, I_RG_LAMBDA, I_REC_NORM_G, I_LQ1, I_LK1, I_LQ2, I_LK2, I_SUBLN_G, I_W_OUT,
       I_NORM_CROSS_G, I_NORM_MEM_G, I_W_CQ, I_W_CKV, I_W_CO, I_NORM_FFN_G, I_W_ROUTER, I_B_ROUTER, I_W_GU, I_B_GU, I_W_DN, I_B_DN, I_NORM_FINAL_G };

__device__ __forceinline__ void convert_expert_strips(unsigned char* ws, LAS unsigned char* lds, int first, int stride) {
    asm volatile("" : "+s"(first), "+s"(stride));
    CArgs& a = *kargs(); const int wave = wave_id(), lane = lane_id();
    LAS float* CM = (LAS float*)(lds + 8 * 16384);
    const int cg = lane & 7, kl = lane >> 3, kbase = 256 * wave + 32 * kl;
    constexpr int NST_GU = 32 * 128, NST_DN = 32 * 64, NST = NST_GU + NST_DN;
    const float* wgu = a.in[I_W_GU]; const float* wdn = a.in[I_W_DN];
    unsigned H[4][16];
    f32x4 v[32];
#define CS_DECODE(st) const bool g_ = (st) < NST_GU; const int s2_ = g_ ? (st) : (st) - NST_GU; const int e_ = g_ ? (s2_ >> 7) : (s2_ >> 6), nb_ = g_ ? (s2_ & 127) : (s2_ & 63), n0_ = 32 * nb_, N_ = g_ ? 4096 : 2048
#define CS_LOAD(st) do { CS_DECODE(st); const float* p_ = (g_ ? wgu : wdn) + ((size_t)e_ * 2048 + kbase) * N_ + n0_ + 4 * cg;                                       \
        _Pragma("unroll") for (int i = 0; i < 32; ++i) v[i] = *(const f32x4*)(p_ + (size_t)i * N_); } while (0)
#define CS_PACK(par) do { f32x4 m_ = {0.f, 0.f, 0.f, 0.f};                                                                                                             \
        _Pragma("unroll") for (int i = 0; i < 32; ++i) { m_[0] = fmaxf(m_[0], fabsf(v[i][0])); m_[1] = fmaxf(m_[1], fabsf(v[i][1])); m_[2] = fmaxf(m_[2], fabsf(v[i][2])); m_[3] = fmaxf(m_[3], fabsf(v[i][3])); } \
        _Pragma("unroll") for (int c = 0; c < 4; ++c) { m_[c] = fmaxf(m_[c], __shfl_xor(m_[c], 8)); m_[c] = fmaxf(m_[c], __shfl_xor(m_[c], 16)); m_[c] = fmaxf(m_[c], __shfl_xor(m_[c], 32)); } \
        if (kl == 0) *(LAS f32x4*)(CM + (par) * 256 + wave * 32 + 4 * cg) = m_;                                                                                       \
        _Pragma("unroll") for (int c = 0; c < 4; ++c) _Pragma("unroll") for (int i = 0; i < 16; ++i) H[c][i] = pk2(v[2 * i][c], v[2 * i + 1][c]); } while (0)
#define CS_STORE(st, par) do { CS_DECODE(st); (void)n0_;                                                                                                              \
        const int j_ = n0_ & 2047, up_ = n0_ >> 11, drow0_ = (g_ ? 256 * (j_ >> 7) + 128 * up_ + (j_ & 127) : n0_) + 4 * cg;                                       \
        signed char* W8_ = (signed char*)(ws + (g_ ? WS_WGU : WS_WDN)); float* SB_ = (float*)(ws + (g_ ? WS_SBGU : WS_SBDN));                                        \
        f32x4 cm_ = *(const LAS f32x4*)(CM + (par) * 256 + 4 * cg);                                                                                                   \
        _Pragma("unroll") for (int w = 1; w < 8; ++w) { const f32x4 o_ = *(const LAS f32x4*)(CM + (par) * 256 + w * 32 + 4 * cg); cm_[0] = fmaxf(cm_[0], o_[0]); cm_[1] = fmaxf(cm_[1], o_[1]); cm_[2] = fmaxf(cm_[2], o_[2]); cm_[3] = fmaxf(cm_[3], o_[3]); } \
        _Pragma("unroll") for (int c = 0; c < 4; ++c) { const float inv_ = cm_[c] > 0.f ? 127.0f / cm_[c] : 0.f;                                                         \
            u32x4* dst_ = (u32x4*)(W8_ + ((size_t)e_ * N_ + drow0_ + c) * 2048 + kbase);                                                                              \
            _Pragma("unroll") for (int q = 0; q < 2; ++q) { u32x4 o_;                                                                                                 \
                _Pragma("unroll") for (int d = 0; d < 4; ++d) { const unsigned h0_ = H[c][8 * q + 2 * d], h1_ = H[c][8 * q + 2 * d + 1];                                \
                    const unsigned f0_ = __float_as_uint(fmaf(bflo(h0_), inv_, 12582912.0f)), f1_ = __float_as_uint(fmaf(bfhi(h0_), inv_, 12582912.0f));                \
                    const unsigned f2_ = __float_as_uint(fmaf(bflo(h1_), inv_, 12582912.0f)), f3_ = __float_as_uint(fmaf(bfhi(h1_), inv_, 12582912.0f));                \
                    o_[d] = __builtin_amdgcn_perm(__builtin_amdgcn_perm(f3_, f2_, 0x0c0c0400u), __builtin_amdgcn_perm(f1_, f0_, 0x0c0c0400u), 0x05040100u); }           \
                dst_[q] = o_; }                                                                                                                                       \
            if (wave == 0 && kl == 0) SB_[(size_t)e_ * N_ + drow0_ + c] = cm_[c] > 0.f ? cm_[c] * (1.0f / 127.0f) : 1.0f; } } while (0)
    int st = first, par = 0;
    if (st < NST) { CS_LOAD(st); CS_PACK(0); }
    while (st < NST) {
        const int sn = st + stride;
        if (sn < NST) CS_LOAD(sn);
        __builtin_amdgcn_sched_barrier(0);
        __syncthreads();
        CS_STORE(st, par);
        __builtin_amdgcn_sched_barrier(0);
        if (sn < NST) CS_PACK(par ^ 1);
        st = sn; par ^= 1;
    }
    __syncthreads();
#undef CS_DECODE
#undef CS_LOAD
#undef CS_PACK
#undef CS_STORE
}

template <bool F8 = false>
__device__ __forceinline__ void convert_strips_i8(const float* win, int N, signed char* dst8, float* sbo, LAS unsigned char* lds, int first, int stride, const float* kscale = nullptr) {
    const int wave = wave_id(), lane = lane_id();
    LAS float* CM = (LAS float*)(lds + 8 * 16384);
    const int cg = lane & 7, kl = lane >> 3, kbase = 256 * wave + 32 * kl;
    for (int st = first; st < N / 32; st += stride) {
        const int n0 = 32 * st; const float* p_ = win + (size_t)kbase * N + n0 + 4 * cg;
        f32x4 v[32]; f32x4 m_ = {0.f, 0.f, 0.f, 0.f};
#pragma unroll
        for (int i = 0; i < 32; ++i) v[i] = *(const f32x4*)(p_ + (size_t)i * N);
        if (kscale) {
#pragma unroll
            for (int i = 0; i < 32; ++i) v[i] *= kscale[kbase + i]; }
#pragma unroll
        for (int i = 0; i < 32; ++i) { m_[0] = fmaxf(m_[0], fabsf(v[i][0])); m_[1] = fmaxf(m_[1], fabsf(v[i][1])); m_[2] = fmaxf(m_[2], fabsf(v[i][2])); m_[3] = fmaxf(m_[3], fabsf(v[i][3])); }
#pragma unroll
        for (int c = 0; c < 4; ++c) { m_[c] = fmaxf(m_[c], __shfl_xor(m_[c], 8)); m_[c] = fmaxf(m_[c], __shfl_xor(m_[c], 16)); m_[c] = fmaxf(m_[c], __shfl_xor(m_[c], 32)); }
        if (kl == 0) *(LAS f32x4*)(CM + wave * 32 + 4 * cg) = m_;
        __syncthreads();
        f32x4 cm_ = *(const LAS f32x4*)(CM + 4 * cg);
#pragma unroll
        for (int w = 1; w < 8; ++w) { const f32x4 o_ = *(const LAS f32x4*)(CM + w * 32 + 4 * cg); cm_[0] = fmaxf(cm_[0], o_[0]); cm_[1] = fmaxf(cm_[1], o_[1]); cm_[2] = fmaxf(cm_[2], o_[2]); cm_[3] = fmaxf(cm_[3], o_[3]); }
#pragma unroll
        for (int c = 0; c < 4; ++c) { constexpr float QMAX = F8 ? 240.0f : 127.0f; const float inv_ = cm_[c] > 0.f ? QMAX / cm_[c] : 0.f;
            u32x4* dst_ = (u32x4*)(dst8 + (size_t)(n0 + 4 * cg + c) * 2048 + kbase);
#pragma unroll
            for (int q = 0; q < 2; ++q) { u32x4 o_;
#pragma unroll
                for (int d = 0; d < 4; ++d) { const int i0 = 16 * q + 4 * d;
                    if constexpr (F8) { unsigned w_ = 0; w_ = __builtin_amdgcn_cvt_pk_fp8_f32(v[i0][c] * inv_, v[i0 + 1][c] * inv_, w_, false); w_ = __builtin_amdgcn_cvt_pk_fp8_f32(v[i0 + 2][c] * inv_, v[i0 + 3][c] * inv_, w_, true); o_[d] = w_; continue; }
                    const unsigned f0_ = __float_as_uint(fmaf(v[i0][c], inv_, 12582912.0f)), f1_ = __float_as_uint(fmaf(v[i0 + 1][c], inv_, 12582912.0f));
                    const unsigned f2_ = __float_as_uint(fmaf(v[i0 + 2][c], inv_, 12582912.0f)), f3_ = __float_as_uint(fmaf(v[i0 + 3][c], inv_, 12582912.0f));
                    o_[d] = __builtin_amdgcn_perm(__builtin_amdgcn_perm(f3_, f2_, 0x0c0c0400u), __builtin_amdgcn_perm(f1_, f0_, 0x0c0c0400u), 0x05040100u); }
                dst_[q] = o_; }
            if (wave == 0 && kl == 0) sbo[n0 + 4 * cg + c] = cm_[c] > 0.f ? cm_[c] * (1.0f / QMAX) : 1.0f; }
        __syncthreads();
    }
}

__device__ __forceinline__ void convert_late_weights(unsigned char* ws, LAS unsigned char* lds, int G);
__device__ __forceinline__ void p0_prologue(unsigned char* ws, LAS unsigned char* lds, int G) {
    CArgs& a = *kargs(); const int wave = wave_id(), lane = lane_id();
    LAS float* scr = (LAS float*)(lds + wave * 16384);
    const int gw = blockIdx.x * NWAVES + wave, NGW = G * NWAVES;
    constexpr int I_IN = 32 * 160, I_SQ = 32 * 64, I_KV = 32 * 128, I_GU = 32 * 32 * 128, I_DN = 32 * 32 * 64, I_RG = 128;
    constexpr int NITEMS = I_IN + 3 * I_SQ + I_KV + I_GU + I_DN + I_RG;
    const bool late_here = (G != 256);
    if (late_here) convert_expert_strips(ws, lds, blockIdx.x, G);
    if (late_here) convert_late_weights(ws, lds, G);
    convert_strips_i8(a.in[I_W_IN], 5120, (signed char*)(ws + WS_WIN), (float*)(ws + WS_SBIN), lds, blockIdx.x, G);
    for (int it = gw + I_GU + I_DN; it < NITEMS; it += NGW) {
        int r = it - I_GU - I_DN;
        if (r < I_IN) continue; r -= I_IN;
        if (r < I_SQ) continue; r -= I_SQ;
        if (r < I_SQ) continue; r -= I_SQ;
        if (r < I_KV) { const int kb = r >> 7, nb = r & 127; p0_transpose_item(a.in[I_W_CKV], 2048, 4096, (bf16_t*)(ws + WS_WCKV), 64 * kb, 32 * nb, 32 * nb, scr, lane); continue; } r -= I_KV;
        if (r < I_SQ) continue; r -= I_SQ;
        { const int mat = r >> 6, n = (r >> 3) & 7, sub = r & 7, kb = sub >> 2, nb = sub & 3;
          p0_transpose_item((mat ? a.in[I_W_RG_X] : a.in[I_W_RG_A]) + n * 16384, 128, 128, (bf16_t*)(ws + WS_WRGT) + (mat * 8 + n) * 16384, 64 * kb, 32 * nb, 32 * nb, scr, lane); }
    }
    for (int m = gw; m < S_; m += 2 * NGW) { const int m1 = m + NGW; const bool two = m1 < S_;
        f32x4 va[8], vb[8]; const f32x4* xa = (const f32x4*)(a.in[I_X] + (size_t)m * DM) + lane; const f32x4* xb = (const f32x4*)(a.in[I_X] + (size_t)(two ? m1 : m) * DM) + lane;
#pragma unroll
        for (int j = 0; j < 8; ++j) { va[j] = xa[64 * j]; vb[j] = xb[64 * j]; }
        rms_row_i8(va, a.in[I_NORM_MIX_G], (signed char*)(ws + WS_XN) + (size_t)m * DM, (float*)(ws + WS_INSCALE) + m, lane);
        if (two) rms_row_i8(vb, a.in[I_NORM_MIX_G], (signed char*)(ws + WS_XN) + (size_t)m1 * DM, (float*)(ws + WS_INSCALE) + m1, lane); }
    for (int m = gw; m < NMEM; m += NGW) rms_row_bf16(a.in[I_MEM] + (size_t)m * DM, a.in[I_NORM_MEM_G], (bf16_t*)(ws + WS_MEMN) + (size_t)m * DM, lane);
}

__device__ __forceinline__ void store_bf16_tile(const f32x4 (&acc)[2][2][4][2], bf16_t* b0, bf16_t* b1, size_t pitch, float sc, int wr, int wc, int fr, int fq, float sc0 = 1.f) {
    const int r0 = wr * 64 + fr, cc = wc * 32 + 8 * fq;
#pragma unroll
    for (int ai = 0; ai < 2; ++ai)
#pragma unroll
        for (int m = 0; m < 4; ++m) { const size_t ro = (size_t)(r0 + ai * 128 + m * 16) * pitch + cc;
#pragma unroll
            for (int bj = 0; bj < 2; ++bj) { const float sb = bj ? sc : sc * sc0; const f32x4 v0 = acc[ai][bj][m][0] * sb, v1 = acc[ai][bj][m][1] * sb;
                u32x4 w; w.x = pk2(v0[0], v0[1]); w.y = pk2(v0[2], v0[3]); w.z = pk2(v1[0], v1[1]); w.w = pk2(v1[2], v1[3]);
                *(u32x4*)((bj ? b1 : b0) + ro) = w; } }
}
struct EpiInProj {
    static constexpr bool PERM = true;
    bf16_t *Q, *XR; unsigned* vmax;
    __device__ __forceinline__ void operator()(const f32x4 (&acc)[2][2][4][2], const pg8::Unit& u, int wr, int wc, int fr, int fq) const {
        const int pn = u.pn; bf16_t *b0, *b1; size_t pitch;
        if (pn < 12) {
            float m = 0.f;
#pragma unroll
            for (int ai = 0; ai < 2; ++ai)
#pragma unroll
                for (int bj = 0; bj < 2; ++bj)
#pragma unroll
                    for (int mm = 0; mm < 4; ++mm)
#pragma unroll
                        for (int n = 0; n < 2; ++n) { if (bj == 0 && pn < 8) continue; const f32x4 v = acc[ai][bj][mm][n]; m = fmaxf(fmaxf(m, fmaxf(fabsf(v[0]), fabsf(v[1]))), fmaxf(fabsf(v[2]), fabsf(v[3]))); }
#pragma unroll
            for (int o = 32; o > 0; o >>= 1) m = fmaxf(m, __shfl_xor(m, o));
            if ((threadIdx.x & 63) == 0) atomicMax(vmax + (pn < 8 ? 4 + 4 * (pn >> 2) : 0) + (pn & 3), __float_as_uint(m * 1.00390625f));
        }
        if (pn < 8) { bf16_t* T = Q + (size_t)(pn >> 2) * ((WS_K - WS_Q) / 2); const int hh = pn & 3; pitch = 128;
            b0 = T + ((size_t)(hh * 2 + 0) * S_ + (size_t)u.pm * 256) * 128; b1 = T + ((size_t)(hh * 2 + 1) * S_ + (size_t)u.pm * 256) * 128; }
        else if (pn < 12) { bf16_t* T = Q + (size_t)2 * ((WS_K - WS_Q) / 2); const int hh = pn & 3; pitch = 256;
            b0 = T + ((size_t)hh * S_ + (size_t)u.pm * 256) * 256; b1 = b0 + 128; }
        else { bf16_t* T = XR + (size_t)((pn - 12) >> 2) * ((WS_XG - WS_XR) / 2) + (pn & 3) * 256; pitch = 1024; b0 = T + (size_t)u.pm * 256 * 1024; b1 = b0 + 128; }
        store_bf16_tile(acc, b0, b1, pitch, 1.f, wr, wc, fr, fq, pn < 4 ? 0.12751743f   : 1.f);
    }
};
struct EpiInProjI8 {
    static constexpr bool PERM = true;
    EpiInProj base; const float* rowscale; const float* colscale;
    __device__ __forceinline__ void operator()(const pg8::i32x4 (&acc)[2][2][4][2], const pg8::Unit& u, int wr, int wc, int fr, int fq) const {
        f32x4 f[2][2][4][2];
        const float* rs = rowscale + (size_t)u.pm * 256 + wr * 64 + fr; const float* cs = colscale + (size_t)u.pn * 256 + wc * 32 + 8 * fq;
        f32x4 c4[2][2];
#pragma unroll
        for (int bj = 0; bj < 2; ++bj)
#pragma unroll
            for (int n = 0; n < 2; ++n) c4[bj][n] = *(const f32x4*)(cs + 128 * bj + 4 * n);
#pragma unroll
        for (int ai = 0; ai < 2; ++ai)
#pragma unroll
            for (int m = 0; m < 4; ++m) { const float r = rs[ai * 128 + m * 16];
#pragma unroll
                for (int bj = 0; bj < 2; ++bj)
#pragma unroll
                    for (int n = 0; n < 2; ++n) { const pg8::i32x4 a = acc[ai][bj][m][n]; const f32x4 c = c4[bj][n];
                        f[ai][bj][m][n] = (f32x4){(float)a[0] * (r * c[0]), (float)a[1] * (r * c[1]), (float)a[2] * (r * c[2]), (float)a[3] * (r * c[3])}; } }
        base(f, u, wr, wc, fr, fq);
    }
};
struct EpiSmall {
    static constexpr bool PERM = true;
    bf16_t *KM, *VT;
    __device__ __forceinline__ void operator()(const f32x4 (&acc)[2][2][4][2], const pg8::Unit& u, int wr, int wc, int fr, int fq) const {
        if (u.e == 0) { bf16_t* b0 = KM + u.pn * 256; store_bf16_tile(acc, b0, b0 + 128, 2048, 1.f, wr, wc, fr, fq); }
        else { bf16_t* b0 = VT + (size_t)u.pm * 256 * 256; store_bf16_tile(acc, b0, b0 + 128, 256, 1.f, wr, wc, fr, fq); }
    }
};
struct SmallOrder {
    const char* memn; const char* wckv; int c;
    __device__ __forceinline__ bool next(int i, pg8::Unit& u) const {
        if (i > 0 || c >= 16) return false;
        const int idx = c & 7; u.e = c >> 3;
        if (u.e == 0) { u.pm = 0; u.pn = idx; u.A = memn; u.B = wckv + (size_t)idx * 256 * 2048 * 2; }
        else { u.pm = idx; u.pn = 0; u.A = wckv + (size_t)(2048 + idx * 256) * 2048 * 2; u.B = memn; }
        return true;
    }
};
struct EpiBf16Plain {
    static constexpr bool PERM = true;
    bf16_t* O; int ldc;
    __device__ __forceinline__ void operator()(const f32x4 (&acc)[2][2][4][2], const pg8::Unit& u, int wr, int wc, int fr, int fq) const {
        bf16_t* b0 = O + (size_t)u.pm * 256 * ldc + u.pn * 256; store_bf16_tile(acc, b0, b0 + 128, (size_t)ldc, 1.f, wr, wc, fr, fq);
    }
};
struct EpiResF32 {
    static constexpr bool PERM = false;
    const bf16_t* res; bf16_t* out; const float* cs; float mul;
    __device__ __forceinline__ void operator()(const f32x4 (&acc)[2][2][4][2], const pg8::Unit& u, int wr, int wc, int fr, int fq) const {
        const int row0 = u.pm * 256 + wr * 64 + fr, col0 = u.pn * 256 + wc * 32 + 4 * fq;
#pragma unroll
        for (int ai = 0; ai < 2; ++ai)
#pragma unroll
            for (int m = 0; m < 4; ++m) { const size_t ro = (size_t)(row0 + ai * 128 + m * 16) * DM + col0;
#pragma unroll
                for (int bj = 0; bj < 2; ++bj)
#pragma unroll
                    for (int n = 0; n < 2; ++n) { const size_t p = ro + bj * 128 + 16 * n; const f32x4 r = ld_bf16x4(res + p); const f32x4 c4 = *(const f32x4*)(cs + col0 + bj * 128 + 16 * n) * mul; st_bf16x4(out + p, r + acc[ai][bj][m][n] * c4); } }
    }
};
struct EpiResNormF32 {
    static constexpr bool PERM = false;
    const float* res; bf16_t* out; unsigned char* HB; float* SSQ;
    __device__ __forceinline__ void operator()(const f32x4 (&acc)[2][2][4][2], const pg8::Unit& u, int wr, int wc, int fr, int fq) const {
        const int row0 = u.pm * 256 + wr * 64 + fr, col0 = u.pn * 256 + wc * 32 + 4 * fq;
#pragma unroll
        for (int ai = 0; ai < 2; ++ai)
#pragma unroll
            for (int m = 0; m < 4; ++m) { const int row = row0 + ai * 128 + m * 16; const size_t ro = (size_t)row * DM + col0; float ss = 0.f;
#pragma unroll
                for (int bj = 0; bj < 2; ++bj)
#pragma unroll
                    for (int n = 0; n < 2; ++n) { const size_t p = ro + bj * 128 + 16 * n; const f32x4 v = *(const f32x4*)(res + p) + acc[ai][bj][m][n]; st_bf16x4(out + p, v);
                        { const f32x4 q = {__builtin_amdgcn_fmed3f(v[0], -448.f, 448.f), __builtin_amdgcn_fmed3f(v[1], -448.f, 448.f), __builtin_amdgcn_fmed3f(v[2], -448.f, 448.f), __builtin_amdgcn_fmed3f(v[3], -448.f, 448.f)};
                          unsigned hb = 0; hb = __builtin_amdgcn_cvt_pk_fp8_f32(q[0], q[1], hb, false); hb = __builtin_amdgcn_cvt_pk_fp8_f32(q[2], q[3], hb, true); *(unsigned*)(HB + p) = hb; } ss += (v[0] * v[0] + v[1] * v[1]) + (v[2] * v[2] + v[3] * v[3]); }
                ss += __shfl_xor(ss, 16); ss += __shfl_xor(ss, 32);
                if (fq == 0) SSQ[(size_t)row * 32 + u.pn * 4 + wc] = ss; }
    }
};
struct EpiResNormI8 {
    static constexpr bool PERM = false;
    EpiResNormF32 base; const float* rowscale; const float* colscale;
    __device__ __forceinline__ void operator()(const pg8::i32x4 (&acc)[2][2][4][2], const pg8::Unit& u, int wr, int wc, int fr, int fq) const {
        f32x4 f[2][2][4][2];
        const float* rs = rowscale + (size_t)u.pm * 256 + wr * 64 + fr; const float* cs = colscale + (size_t)u.pn * 256 + wc * 32 + 4 * fq;
        f32x4 c4[2][2];
#pragma unroll
        for (int bj = 0; bj < 2; ++bj)
#pragma unroll
            for (int n = 0; n < 2; ++n) c4[bj][n] = *(const f32x4*)(cs + 128 * bj + 16 * n);
#pragma unroll
        for (int ai = 0; ai < 2; ++ai)
#pragma unroll
            for (int m = 0; m < 4; ++m) { const float r = rs[ai * 128 + m * 16];
#pragma unroll
                for (int bj = 0; bj < 2; ++bj)
#pragma unroll
                    for (int n = 0; n < 2; ++n) { const pg8::i32x4 a = acc[ai][bj][m][n]; const f32x4 c = c4[bj][n];
                        f[ai][bj][m][n] = (f32x4){(float)a[0] * (r * c[0]), (float)a[1] * (r * c[1]), (float)a[2] * (r * c[2]), (float)a[3] * (r * c[3])}; } }
        base(f, u, wr, wc, fr, fq);
    }
};
struct EpiBf16RowScale {
    static constexpr bool PERM = true;
    bf16_t* O; int ldc; const LAS float* rl; const float* cs;
    __device__ __forceinline__ void operator()(const f32x4 (&acc)[2][2][4][2], const pg8::Unit& u, int wr, int wc, int fr, int fq) const {
        bf16_t* b0 = O + (size_t)u.pm * 256 * ldc + u.pn * 256; const int r0 = wr * 64 + fr, cc = wc * 32 + 8 * fq;
#pragma unroll
        for (int ai = 0; ai < 2; ++ai)
#pragma unroll
            for (int m = 0; m < 4; ++m) { const int r = r0 + ai * 128 + m * 16; const float sc = rl[u.e * 256 + r]; const size_t ro = (size_t)r * ldc + cc;
#pragma unroll
                for (int bj = 0; bj < 2; ++bj) { const f32x4 c0 = *(const f32x4*)(cs + u.pn * 256 + bj * 128 + cc), c1 = *(const f32x4*)(cs + u.pn * 256 + bj * 128 + cc + 4); const f32x4 v0 = acc[ai][bj][m][0] * sc * c0, v1 = acc[ai][bj][m][1] * sc * c1;
                    u32x4 w; w.x = pk2(v0[0], v0[1]); w.y = pk2(v0[2], v0[3]); w.z = pk2(v1[0], v1[1]); w.w = pk2(v1[2], v1[3]);
                    *(u32x4*)(b0 + ro + bj * 128) = w; } }
    }
};
struct HeadOrderS {
    const char* QC; const char* KM; int G, c;
    __device__ __forceinline__ bool next(int i, pg8::Unit& u) const {
        const int L = i * G + c; if (L >= 256) return false;
        u.e = L & 3; u.pm = L >> 2; u.pn = 0; u.A = QC + ((size_t)u.pm * 256 * 2048 + u.e * 512) * 2; u.B = KM + (size_t)u.e * 512 * 2; return true;
    }
};
struct EpiScore {
    static constexpr bool PERM = true;
    bf16_t* PC; float* LPART;
    __device__ __forceinline__ void operator()(const f32x4 (&acc)[2][2][4][2], const pg8::Unit& u, int wr, int wc, int fr, int fq) const {
        constexpr float C2 = 1.4426950408889634f * 0.044194173824159216f;
        const int r0 = u.pm * 256 + wr * 64 + fr, cc = u.e * 256 + wc * 32 + 8 * fq;
#pragma unroll
        for (int ai = 0; ai < 2; ++ai)
#pragma unroll
            for (int m = 0; m < 4; ++m) { const int row = r0 + ai * 128 + m * 16; float ps = 0.f;
#pragma unroll
                for (int bj = 0; bj < 2; ++bj) { f32x4 v0 = acc[ai][bj][m][0], v1 = acc[ai][bj][m][1];
#pragma unroll
                    for (int i = 0; i < 4; ++i) { v0[i] = __builtin_amdgcn_exp2f(v0[i] * C2); v1[i] = __builtin_amdgcn_exp2f(v1[i] * C2); }
                    u32x4 w; w.x = pk2(v0[0], v0[1]); w.y = pk2(v0[2], v0[3]); w.z = pk2(v1[0], v1[1]); w.w = pk2(v1[2], v1[3]);
                    ps += (bflo(w.x) + bfhi(w.x)) + (bflo(w.y) + bfhi(w.y)) + (bflo(w.z) + bfhi(w.z)) + (bflo(w.w) + bfhi(w.w));
                    *(u32x4*)(PC + (size_t)row * 1024 + cc + bj * 128) = w; }
                ps += __shfl_xor(ps, 16); ps += __shfl_xor(ps, 32);
                if (fq == 0) LPART[((size_t)row * 4 + u.e) * 4 + wc] = ps; }
    }
};
struct HeadOrderO {
    const char* PC; const char* VT; int G, c;
    __device__ __forceinline__ bool next(int i, pg8::Unit& u) const {
        int L = i * G + c; if (L >= 512) return false;
        if (G == 256) L = 8 * (c >> 2) + 4 * i + (c & 3);
        u.e = L & 3; u.pn = (L >> 2) & 1; u.pm = L >> 3; u.A = PC + ((size_t)u.pm * 256 * 1024 + u.e * 256) * 2; u.B = VT + ((size_t)(u.e * 512 + u.pn * 256) * 256) * 2; return true;
    }
};
struct EpiCrossO {
    static constexpr bool PERM = true;
    unsigned char* OC; const float* LPART;
    __device__ __forceinline__ void operator()(const f32x4 (&acc)[2][2][4][2], const pg8::Unit& u, int wr, int wc, int fr, int fq) const {
        const int r0 = u.pm * 256 + wr * 64 + fr, cc = u.e * 512 + u.pn * 256 + wc * 32 + 8 * fq;
#pragma unroll
        for (int ai = 0; ai < 2; ++ai)
#pragma unroll
            for (int m = 0; m < 4; ++m) { const int row = r0 + ai * 128 + m * 16; const f32x4 lp = *(const f32x4*)(LPART + ((size_t)row * 4 + u.e) * 4);
                const float inv = 16.0f * __builtin_amdgcn_rcpf((lp[0] + lp[1]) + (lp[2] + lp[3]));
#pragma unroll
                for (int bj = 0; bj < 2; ++bj) { f32x4 v0 = acc[ai][bj][m][0] * inv, v1 = acc[ai][bj][m][1] * inv;
#pragma unroll
                    for (int i = 0; i < 4; ++i) { v0[i] = __builtin_amdgcn_fmed3f(v0[i], -448.f, 448.f); v1[i] = __builtin_amdgcn_fmed3f(v1[i], -448.f, 448.f); }
                    u32x2 w; w.x = 0; w.y = 0;
                    w.x = __builtin_amdgcn_cvt_pk_fp8_f32(v0[0], v0[1], w.x, false); w.x = __builtin_amdgcn_cvt_pk_fp8_f32(v0[2], v0[3], w.x, true);
                    w.y = __builtin_amdgcn_cvt_pk_fp8_f32(v1[0], v1[1], w.y, false); w.y = __builtin_amdgcn_cvt_pk_fp8_f32(v1[2], v1[3], w.y, true);
                    *(u32x2*)(OC + (size_t)row * 2048 + cc + bj * 128) = w; } }
    }
};
struct GroupOrder {
    const char* A; const char* W; const int* texp; size_t wstride, tstride; int nrt, NT, G, c;
    __device__ __forceinline__ bool next(int i, pg8::Unit& u) const {
        const int L = i * G + c; if (L >= nrt * NT) return false;
        const int rt = L / NT; u.pm = rt; u.pn = L - rt * NT; u.e = texp[rt];
        u.A = A + (size_t)rt * tstride; u.B = W + (size_t)u.e * wstride + (size_t)u.pn * tstride; return true;
    }
};
struct GroupOrderG {
    const char* A; const char* W; const int* texp; const int* rows; size_t wstride, tstride; int nrt, NT, G, c;
    __device__ __forceinline__ bool next(int i, pg8::Unit& u) const {
        const int L = i * G + c; if (L >= nrt * NT) return false;
        const int rt = L / NT; u.pm = rt; u.pn = L - rt * NT; u.e = texp[rt];
        u.A = A; u.B = W + (size_t)u.e * wstride + (size_t)u.pn * tstride; return true;
    }
};
struct EpiGateUp {
    static constexpr bool PERM = true;
    bf16_t* ACT; const float* bgu;
    __device__ __forceinline__ void operator()(const f32x4 (&acc)[2][2][4][2], const pg8::Unit& u, int wr, int wc, int fr, int fq) const {
        const int r0 = u.pm * 256 + wr * 64 + fr, j0 = u.pn * 128 + wc * 32 + 8 * fq;
        const float* bg = bgu + (size_t)u.e * 4096 + j0; float g8[8], u8[8];
#pragma unroll
        for (int i = 0; i < 8; ++i) { g8[i] = bg[i]; u8[i] = bg[2048 + i]; }
#pragma unroll
        for (int ai = 0; ai < 2; ++ai)
#pragma unroll
            for (int m = 0; m < 4; ++m) { const int row = r0 + ai * 128 + m * 16; float o[8];
#pragma unroll
                for (int i = 0; i < 8; ++i) { float gt = acc[ai][0][m][i >> 2][i & 3] + g8[i], up = acc[ai][1][m][i >> 2][i & 3] + u8[i];
                    gt = fminf(gt, 7.0f); up = fminf(fmaxf(up, -7.0f), 7.0f);
                    o[i] = (up + 1.0f) * gt * sigmoidf_(1.702f * gt); }
                u32x4 w; w.x = pk2(o[0], o[1]); w.y = pk2(o[2], o[3]); w.z = pk2(o[4], o[5]); w.w = pk2(o[6], o[7]);
                *(u32x4*)(ACT + (size_t)row * 2048 + j0) = w; }
    }
};
struct EpiGateUpI8 {
    static constexpr bool PERM = true;
    signed char* ACT; const float* bgu; const float* rowscale; const float* sb;
    __device__ __forceinline__ void operator()(const pg8::i32x4 (&acc)[2][2][4][2], const pg8::Unit& u, int wr, int wc, int fr, int fq) const {
        const int r0 = u.pm * 256 + wr * 64 + fr, cw = wc * 32 + 8 * fq, j0 = u.pn * 128 + cw;
        const float* bg = bgu + (size_t)u.e * 4096 + j0; const float* sp = sb + (size_t)u.e * 4096 + u.pn * 256 + cw; float g8[8], u8[8], sg8[8], su8[8];
#pragma unroll
        for (int i = 0; i < 8; ++i) { g8[i] = bg[i]; u8[i] = bg[2048 + i]; sg8[i] = sp[i]; su8[i] = sp[128 + i]; }
#pragma unroll
        for (int ai = 0; ai < 2; ++ai)
#pragma unroll
            for (int m = 0; m < 4; ++m) { const int row = r0 + ai * 128 + m * 16; const float rs = rowscale[row]; float o[8];
#pragma unroll
                for (int i = 0; i < 8; ++i) { float gt = (float)acc[ai][0][m][i >> 2][i & 3] * (rs * sg8[i]) + g8[i], up = (float)acc[ai][1][m][i >> 2][i & 3] * (rs * su8[i]) + u8[i];
                    gt = fminf(gt, 7.0f); up = fminf(fmaxf(up, -7.0f), 7.0f);
                    o[i] = (up + 1.0f) * gt * sigmoidf_(1.702f * gt); }
                unsigned q[8];
#pragma unroll
                for (int i = 0; i < 8; ++i) q[i] = (unsigned)(int)rintf(fminf(fmaxf(o[i] * (1.0f / ACT_QSCALE), -127.0f), 127.0f)) & 0xffu;
                u32x2 w; w.x = q[0] | (q[1] << 8) | (q[2] << 16) | (q[3] << 24); w.y = q[4] | (q[5] << 8) | (q[6] << 16) | (q[7] << 24);
                *(u32x2*)(ACT + (size_t)row * 2048 + j0) = w; }
    }
};
constexpr float YB_SCALE = 32.0f;
struct EpiDown {
    static constexpr bool PERM = true;
    unsigned char* YB; const float* bdn; const float* rowgate; const float* sb;
    __device__ __forceinline__ void operator()(const pg8::i32x4 (&acc)[2][2][4][2], const pg8::Unit& u, int wr, int wc, int fr, int fq) const {
        const int r0 = u.pm * 256 + wr * 64 + fr, c0 = u.pn * 256 + wc * 32 + 8 * fq;
        float b8[2][8], s8[2][8];
#pragma unroll
        for (int bj = 0; bj < 2; ++bj)
#pragma unroll
            for (int i = 0; i < 8; ++i) { b8[bj][i] = bdn[(size_t)u.e * 2048 + c0 + bj * 128 + i] * YB_SCALE; s8[bj][i] = sb[(size_t)u.e * 2048 + c0 + bj * 128 + i] * (ACT_QSCALE * YB_SCALE); }
#pragma unroll
        for (int ai = 0; ai < 2; ++ai)
#pragma unroll
            for (int m = 0; m < 4; ++m) { const int row = r0 + ai * 128 + m * 16; const float g = rowgate[row];
#pragma unroll
                for (int bj = 0; bj < 2; ++bj) { float o[8];
#pragma unroll
                    for (int i = 0; i < 8; ++i) o[i] = __builtin_amdgcn_fmed3f(((float)acc[ai][bj][m][i >> 2][i & 3] * s8[bj][i] + b8[bj][i]) * g, -448.0f, 448.0f);
                    u32x2 w; w.x = 0; w.y = 0;
                    w.x = __builtin_amdgcn_cvt_pk_fp8_f32(o[0], o[1], w.x, false); w.x = __builtin_amdgcn_cvt_pk_fp8_f32(o[2], o[3], w.x, true);
                    w.y = __builtin_amdgcn_cvt_pk_fp8_f32(o[4], o[5], w.y, false); w.y = __builtin_amdgcn_cvt_pk_fp8_f32(o[6], o[7], w.y, true);
                    *(u32x2*)(YB + (size_t)row * 2048 + c0 + bj * 128) = w; } }
    }
};
__device__ __forceinline__ void rg_local(unsigned char* ws, LAS unsigned char* lds, int ubeg, int ustride) {
    CArgs& a = *kargs();
    const int tid = threadIdx.x, wave = __builtin_amdgcn_readfirstlane(tid >> 6), lane = tid & 63, fr = lane & 15, fq = lane >> 4;
    LAS bf16_t* XCB = (LAS bf16_t*)lds;
    LAS float* XCF = (LAS float*)(lds + 17408);
    LAS float* AF = (LAS float*)(lds + 17408 + 32768);
    LAS float* BF = (LAS float*)(lds + 17408 + 65536);
    LAS float* QA = (LAS float*)(lds + 17408 + 98304);
    LAS float* QH = QA + 512;
    const bf16_t* XR = (const bf16_t*)(ws + WS_XR); const bf16_t* WRGT = (const bf16_t*)(ws + WS_WRGT);
    bf16_t* HL = (bf16_t*)(ws + WS_HL); bf16_t* ACUM = (bf16_t*)(ws + WS_ACUM); float* ACH = (float*)(ws + WS_ACH); float* HCH = (float*)(ws + WS_HCH);
    int n_cur = -1; f32x4 w0, w1, w2, w3, bb; float ba = 0.f, bx = 0.f, sp8 = 0.f; bf16x8 br[4], bi[4];
    const int c4 = (tid & 31) * 4, tg = tid >> 5, d0 = 16 * wave;
    u32x2 xr[7];
#define RG_LOADX(uu) do { const int t0_ = 64 * ((uu) >> 3), ch_ = 128 * ((uu) & 7) + c4;                                                              \
        _Pragma("unroll") for (int i = 0; i < 7; ++i) { const int tt = t0_ + 4 * tg - 3 + i; xr[i] = tt >= 0 ? *(const u32x2*)(XR + (size_t)tt * 1024 + ch_) : (u32x2){0u, 0u}; } } while (0)
    if (ubeg < 2048) RG_LOADX(ubeg);
    for (int u = ubeg; u < 2048; u += ustride) {
        const int j = u >> 3, n = u & 7, t0 = 64 * j, cb = 128 * n;
        if (n != n_cur) { n_cur = n; const int ch = cb + c4;
            w0 = *(const f32x4*)(a.in[I_CONV_W] + ch); w1 = *(const f32x4*)(a.in[I_CONV_W] + 1024 + ch); w2 = *(const f32x4*)(a.in[I_CONV_W] + 2048 + ch); w3 = *(const f32x4*)(a.in[I_CONV_W] + 3072 + ch);
            bb = *(const f32x4*)(a.in[I_CONV_B] + ch);
            const int chd = cb + d0 + fr; ba = a.in[I_B_RG_A][chd]; bx = a.in[I_B_RG_X][chd]; sp8 = 8.0f * log1pf(__expf(-a.in[I_RG_LAMBDA][chd]));
#pragma unroll
            for (int s = 0; s < 4; ++s) { br[s] = *(const bf16x8*)(WRGT + ((size_t)(0 * 8 + n) * 128 + d0 + fr) * 128 + 32 * s + 8 * fq); bi[s] = *(const bf16x8*)(WRGT + ((size_t)(1 * 8 + n) * 128 + d0 + fr) * 128 + 32 * s + 8 * fq); } }
        {
            f32x4 x[7];
#pragma unroll
            for (int i = 0; i < 7; ++i) x[i] = (f32x4){bflo(xr[i].x), bfhi(xr[i].x), bflo(xr[i].y), bfhi(xr[i].y)};
#pragma unroll
            for (int i = 0; i < 4; ++i) { const f32x4 xc = bb + w0 * x[i] + w1 * x[i + 1] + w2 * x[i + 2] + w3 * x[i + 3]; const int t = 4 * tg + i;
                *(LAS f32x4*)(XCF + t * 128 + c4) = xc; u32x2 pk; pk.x = pk2(xc[0], xc[1]); pk.y = pk2(xc[2], xc[3]); *(LAS u32x2*)(XCB + t * 136 + c4) = pk; }
            if (u + ustride < 2048) RG_LOADX(u + ustride);
        }
        __syncthreads();
        {
            f32x4 ar[4], ai[4];
#pragma unroll
            for (int m = 0; m < 4; ++m) { ar[m] = (f32x4){0.f, 0.f, 0.f, 0.f}; ai[m] = (f32x4){0.f, 0.f, 0.f, 0.f}; }
#pragma unroll
            for (int s = 0; s < 4; ++s) {
#pragma unroll
                for (int m = 0; m < 4; ++m) { const bf16x8 af = *(const LAS bf16x8*)(XCB + (16 * m + fr) * 136 + 32 * s + 8 * fq);
                    ar[m] = __builtin_amdgcn_mfma_f32_16x16x32_bf16(af, br[s], ar[m], 0, 0, 0); ai[m] = __builtin_amdgcn_mfma_f32_16x16x32_bf16(af, bi[s], ai[m], 0, 0, 0); }
            }
            const int d = d0 + fr;
#pragma unroll
            for (int m = 0; m < 4; ++m)
#pragma unroll
                for (int r = 0; r < 4; ++r) { const int t = 16 * m + 4 * fq + r;
                    const float rg = sigmoidf_(ar[m][r] + ba), ig = sigmoidf_(ai[m][r] + bx), la = -sp8 * rg, y = -2.0f * la;
                    const float em = (y > 0.5f) ? -expm1f(-y) : y * (1.0f + y * (-0.5f + y * (0.16666667f + y * (-0.041666668f + y * (0.0083333338f + y * -0.0013888889f)))));
                    AF[t * 128 + d] = __expf(la); BF[t * 128 + d] = sqrtf(em) * (ig * XCF[t * 128 + d]); }
        }
        __syncthreads();
        {
            const int c = tid & 127, q = tid >> 7; float hv[16], pv[16]; float h = 0.f, P = 1.f;
#pragma unroll
            for (int i = 0; i < 16; ++i) { const float av = AF[(16 * q + i) * 128 + c]; h = av * h + BF[(16 * q + i) * 128 + c]; P *= av; hv[i] = h; pv[i] = P; }
            QA[q * 128 + c] = P; QH[q * 128 + c] = h;
            __syncthreads();
            float hin = 0.f, pin = 1.f;
            for (int qq = 0; qq < q; ++qq) { const float qa = QA[qq * 128 + c]; hin = qa * hin + QH[qq * 128 + c]; pin *= qa; }
#pragma unroll
            for (int i = 0; i < 16; ++i) { const float hh = hv[i] + pv[i] * hin, pp = pv[i] * pin;
                BF[(16 * q + i) * 128 + c] = hh; AF[(16 * q + i) * 128 + c] = pp;
                if (q == 3 && i == 15) { ACH[(size_t)j * 1024 + cb + c] = pp; HCH[(size_t)j * 1024 + cb + c] = hh; } }
        }
        __syncthreads();
        {
            const int c4 = (tid & 31) * 4, r = tid >> 5;
#pragma unroll
            for (int p = 0; p < 4; ++p) { const int t = r + 16 * p; const size_t g = (size_t)(t0 + t) * 1024 + cb + c4;
                const f32x4 hh = *(const LAS f32x4*)(BF + t * 128 + c4), pp = *(const LAS f32x4*)(AF + t * 128 + c4);
                u32x2 o; o.x = pk2(hh[0], hh[1]); o.y = pk2(hh[2], hh[3]); *(u32x2*)(HL + g) = o;
                o.x = pk2(pp[0], pp[1]); o.y = pk2(pp[2], pp[3]); *(u32x2*)(ACUM + g) = o; }
        }
        __syncthreads();
    }
}

#undef RG_LOADX
__device__ __forceinline__ void carry_scan(unsigned char* ws, LAS unsigned char* lds, int G) {
    const int tid = threadIdx.x, wave = __builtin_amdgcn_readfirstlane(tid >> 6), lane = tid & 63;
    const float* ACH = (const float*)(ws + WS_ACH); const float* HCH = (const float*)(ws + WS_HCH); float* CARRY = (float*)(ws + WS_CARRY);
    LAS f32x4* WTA = (LAS f32x4*)lds; LAS f32x4* WTH = (LAS f32x4*)(lds + 64);
    for (int cg = blockIdx.x; cg < 256; cg += G) {
        f32x4 A4 = {1.f, 1.f, 1.f, 1.f}, H4 = {0.f, 0.f, 0.f, 0.f};
        if (tid < 256) { A4 = *(const f32x4*)(ACH + (size_t)tid * 1024 + 4 * cg); H4 = *(const f32x4*)(HCH + (size_t)tid * 1024 + 4 * cg); }
#pragma unroll
        for (int off = 1; off < 64; off <<= 1) {
            f32x4 pa, ph;
#pragma unroll
            for (int i = 0; i < 4; ++i) { pa[i] = __shfl_up(A4[i], off); ph[i] = __shfl_up(H4[i], off); }
            if (lane >= off) { H4 = A4 * ph + H4; A4 = A4 * pa; }
        }
        if (tid < 256 && lane == 63) { WTA[wave] = A4; WTH[wave] = H4; }
        __syncthreads();
        if (tid < 256) {
            f32x4 ph = {0.f, 0.f, 0.f, 0.f};
            for (int w = 0; w < wave; ++w) { const f32x4 ta = WTA[w], th = WTH[w]; ph = ta * ph + th; }
            const f32x4 hinc = A4 * ph + H4;
            if (tid + 1 < 256) *(f32x4*)(CARRY + (size_t)(tid + 1) * 1024 + 4 * cg) = hinc;
            if (tid == 0) *(f32x4*)(CARRY + 4 * cg) = (f32x4){0.f, 0.f, 0.f, 0.f};
        }
        __syncthreads();
    }
}

__device__ __forceinline__ void convert_late_weights(unsigned char* ws, LAS unsigned char* lds, int G) {
    CArgs& a = *kargs(); const int wave = wave_id(), lane = lane_id();
    LAS float* scr = (LAS float*)(lds + wave * 16384);
    const int gw = blockIdx.x * NWAVES + wave, NGW = G * NWAVES;
    convert_strips_i8(a.in[I_W_OUT], 2048, (signed char*)(ws + WS_WOUT), (float*)(ws + WS_SBOUT), lds, blockIdx.x, G);
    convert_strips_i8<true>(a.in[I_W_CQ], 2048, (signed char*)(ws + WS_WCQ), (float*)(ws + WS_SBCQ), lds, ((int)blockIdx.x + G - 64) % G, G, a.in[I_NORM_CROSS_G]);
    convert_strips_i8<true>(a.in[I_W_CO], 2048, (signed char*)(ws + WS_WCO), (float*)(ws + WS_SBCO), lds, ((int)blockIdx.x + G - 128) % G, G);
    __syncthreads();
}
constexpr size_t WS_VT8 = WS_ACT;
__device__ __forceinline__ float v_fp8_scale(const unsigned char* ws, int head) { const float am = __uint_as_float(((const unsigned*)(ws + WS_CTL))[CW_VMAX + head]); return am > 0.f ? 240.0f / am : 1.0f; }
constexpr size_t WS_Q8 = WS_VT8 + 16 * MiB, WS_K8 = WS_VT8 + 24 * MiB;
__device__ __forceinline__ float fp8_amax_scale(const unsigned char* ws, int word) { const float am = __uint_as_float(((const unsigned*)(ws + WS_CTL))[CW_VMAX + word]); return am > 0.f ? 240.0f / am : 1.0f; }
__device__ __forceinline__ int qk_fp8_shift(const unsigned char* ws, int head) { int e; (void)frexpf(fp8_amax_scale(ws, 4 + head) * fp8_amax_scale(ws, 8 + head) * (1.0f / 0.12751743f), &e); return e - 1; }
__device__ __forceinline__ float qk_fp8_scale(const unsigned char* ws, int which, int head) {
    const float sk = fp8_amax_scale(ws, 8 + head); if (which) return sk;
    return 0.12751743f * ldexpf(1.0f, qk_fp8_shift(ws, head)) / sk; }
__device__ __forceinline__ void convert_v_fp8(unsigned char* ws, LAS unsigned char* lds, int G) {
    const int wave = wave_id(), lane = lane_id();
    for (int i = blockIdx.x * NTHREADS + threadIdx.x; i < 2 * 4 * S_ * 16; i += G * NTHREADS) {
        const int which = i >> 20, head = (i >> 18) & 3, rem = i & ((1 << 18) - 1);
        const float sc = qk_fp8_scale(ws, which, head);
        const u32x4 w = *(const u32x4*)((const bf16_t*)(ws + (which ? WS_K : WS_Q)) + (size_t)(2 * head + 1) * S_ * 128 + (size_t)rem * 8);
        unsigned b0 = 0, b1 = 0;
        b0 = __builtin_amdgcn_cvt_pk_fp8_f32(bflo(w.x) * sc, bfhi(w.x) * sc, b0, false); b0 = __builtin_amdgcn_cvt_pk_fp8_f32(bflo(w.y) * sc, bfhi(w.y) * sc, b0, true);
        b1 = __builtin_amdgcn_cvt_pk_fp8_f32(bflo(w.z) * sc, bfhi(w.z) * sc, b1, false); b1 = __builtin_amdgcn_cvt_pk_fp8_f32(bflo(w.w) * sc, bfhi(w.w) * sc, b1, true);
        u32x2 o; o.x = b0; o.y = b1;
        *(u32x2*)(ws + (which ? WS_K8 : WS_Q8) + (size_t)head * S_ * 128 + (size_t)rem * 8) = o;
    }
    LAS unsigned char* T = lds + wave * 8192;
    for (int job = blockIdx.x * NWAVES + wave; job < 2048; job += G * NWAVES) {
        const int head = job >> 9, tile = (job >> 1) & 255, half = job & 1;
        const float vs = v_fp8_scale(ws, head);
        const bf16_t* src = (const bf16_t*)(ws + WS_V) + ((size_t)head * S_ + (size_t)tile * 64) * 256 + half * 128;
#pragma unroll 4
        for (int i = 0; i < 16; ++i) { const int idx = i * 64 + lane, key = idx >> 4, ch = idx & 15;
            const u32x4 w = *(const u32x4*)(src + (size_t)key * 256 + ch * 8);
            const int kp = key & 31, pos = ((kp >> 2) & 1) * 32 + (key >> 5) * 16 + (kp & 3) + 4 * (kp >> 3);
            unsigned b0 = 0, b1 = 0;
            b0 = __builtin_amdgcn_cvt_pk_fp8_f32(bflo(w.x) * vs, bfhi(w.x) * vs, b0, false); b0 = __builtin_amdgcn_cvt_pk_fp8_f32(bflo(w.y) * vs, bfhi(w.y) * vs, b0, true);
            b1 = __builtin_amdgcn_cvt_pk_fp8_f32(bflo(w.z) * vs, bfhi(w.z) * vs, b1, false); b1 = __builtin_amdgcn_cvt_pk_fp8_f32(bflo(w.w) * vs, bfhi(w.w) * vs, b1, true);
            LAS unsigned char* d = T + (ch * 8) * 64 + pos;
            d[0 * 64] = (unsigned char)b0; d[1 * 64] = (unsigned char)(b0 >> 8); d[2 * 64] = (unsigned char)(b0 >> 16); d[3 * 64] = (unsigned char)(b0 >> 24);
            d[4 * 64] = (unsigned char)b1; d[5 * 64] = (unsigned char)(b1 >> 8); d[6 * 64] = (unsigned char)(b1 >> 16); d[7 * 64] = (unsigned char)(b1 >> 24); }
        LDS_WAIT(); asm volatile("" ::: "memory");
        unsigned char* dst = ws + WS_VT8 + (((size_t)head * 256 + tile) * 256 + half * 128) * 64;
#pragma unroll
        for (int i = 0; i < 8; ++i) { const int idx = i * 64 + lane; *(u32x4*)(dst + (size_t)idx * 16) = *(const LAS u32x4*)(T + idx * 16); }
        LDS_WAIT(); asm volatile("" ::: "memory");
    }
    __syncthreads();
}

constexpr int CW_ATTQ = 8192;
__device__ __forceinline__ void attn_phase(unsigned char* ws, char* lds, volatile LAS unsigned* MISC, int G) {
    const int c = blockIdx.x, hp = (c & 7) >> 1;
    unsigned* qctr = (unsigned*)(ws + WS_CTL) + CW_ATTQ + 64 * hp;
    if (G != 256) {
        for (int L = c; L < 512; L += G) { const int u = L & 7;
            if ((u & 1) == 0) att2::attn_block_b16((const bf16_t*)(ws + WS_Q) + (size_t)u * S_ * 128, (const bf16_t*)(ws + WS_K) + (size_t)u * S_ * 128, (const bf16_t*)(ws + WS_V) + (size_t)(u >> 1) * S_ * 256,
                                                   (bf16_t*)(ws + WS_AO) + (size_t)u * S_ * 256, L >> 3, lds);
            else att2::attn_block(ws + WS_Q8 + (size_t)(u >> 1) * S_ * 128, ws + WS_K8 + (size_t)(u >> 1) * S_ * 128, qk_fp8_shift(ws, u >> 1), ws + WS_VT8 + (size_t)(u >> 1) * 256 * 16384, 1.0f / v_fp8_scale(ws, u >> 1),
                                  (bf16_t*)(ws + WS_AO) + (size_t)u * S_ * 256, L >> 3, lds); }
        return; }
    const int cohort = (c >> 3) & 3; int ndone = 0; bool strips_done = false;
    for (;;) {
        if (!strips_done && ndone == cohort) { convert_expert_strips(ws, (LAS unsigned char*)lds, c, 256); convert_late_weights(ws, (LAS unsigned char*)lds, G); strips_done = true; }
        if (threadIdx.x == 0) MISC[16] = __hip_atomic_fetch_add(qctr, 1u, __ATOMIC_RELAXED, __HIP_MEMORY_SCOPE_AGENT);
        __syncthreads();
        const unsigned idx = MISC[16];
        __syncthreads();
        if (idx >= 128u) break;
        {
            unsigned char* w2 = kargs()->ws; const int u = (((int)blockIdx.x & 7) & ~1) | (int)(idx & 1u), qb = 63 - (int)(idx >> 1);
            if ((idx & 1u) == 0) att2::attn_block_b16((const bf16_t*)(w2 + WS_Q) + (size_t)u * S_ * 128, (const bf16_t*)(w2 + WS_K) + (size_t)u * S_ * 128, (const bf16_t*)(w2 + WS_V) + (size_t)(u >> 1) * S_ * 256,
                                                      (bf16_t*)(w2 + WS_AO) + (size_t)u * S_ * 256, qb, lds);
            else att2::attn_block(w2 + WS_Q8 + (size_t)(u >> 1) * S_ * 128, w2 + WS_K8 + (size_t)(u >> 1) * S_ * 128, qk_fp8_shift(w2, u >> 1), w2 + WS_VT8 + (size_t)(u >> 1) * 256 * 16384,
                                  1.0f / v_fp8_scale(w2, u >> 1), (bf16_t*)(w2 + WS_AO) + (size_t)u * S_ * 256, qb, lds); }
        ++ndone;
    }
    if (!strips_done) { convert_expert_strips(ws, (LAS unsigned char*)lds, c, 256); convert_late_weights(ws, (LAS unsigned char*)lds, G); }
}

__device__ __forceinline__ void post_mix(unsigned char* ws, int G) {
    CArgs& a = *kargs(); const int wave = wave_id(), lane = lane_id();
    const int gw = blockIdx.x * NWAVES + wave, NGW = G * NWAVES;
    float s1 = 0.f, s2 = 0.f;
    for (int i = lane; i < 128; i += 64) { s1 += a.in[I_LQ1][i] * a.in[I_LK1][i]; s2 += a.in[I_LQ2][i] * a.in[I_LK2][i]; }
    const float lam = __expf(wave_sum(s1)) - __expf(wave_sum(s2)) + LAMBDA_INIT;
    const bf16_t* AO = (const bf16_t*)(ws + WS_AO); const bf16_t* XG = (const bf16_t*)(ws + WS_XG);
    const bf16_t* HL = (const bf16_t*)(ws + WS_HL); const bf16_t* ACUM = (const bf16_t*)(ws + WS_ACUM); const float* CARRY = (const float*)(ws + WS_CARRY);
    const int d = 4 * lane;
    const f32x4 sg = *(const f32x4*)(a.in[I_SUBLN_G] + d);
    signed char* MIX8 = (signed char*)(ws + WS_MIX); float* MIXSCALE = (float*)(ws + WS_MIXSCALE);
    struct RowIn { u32x2 o0[4], o1[4], hl[4], ac[4], xg[4]; f32x4 cr[4]; };
    f32x4 rg[4];
#pragma unroll
    for (int j = 0; j < 4; ++j) rg[j] = *(const f32x4*)(a.in[I_REC_NORM_G] + 4 * lane + 256 * j);
    auto load_row = [&](int t, RowIn& R) {
#pragma unroll
        for (int hh = 0; hh < 4; ++hh) { R.o0[hh] = *(const u32x2*)(AO + ((size_t)(hh * 2 + 0) * S_ + t) * 256 + d); R.o1[hh] = *(const u32x2*)(AO + ((size_t)(hh * 2 + 1) * S_ + t) * 256 + d); }
        const int chunk = t >> 6;
#pragma unroll
        for (int j = 0; j < 4; ++j) { const int c = 4 * lane + 256 * j;
            R.hl[j] = *(const u32x2*)(HL + (size_t)t * 1024 + c); R.ac[j] = *(const u32x2*)(ACUM + (size_t)t * 1024 + c); R.xg[j] = *(const u32x2*)(XG + (size_t)t * 1024 + c); R.cr[j] = *(const f32x4*)(CARRY + (size_t)chunk * 1024 + c); }
    };
    auto finish_row = [&](int t, const RowIn& R) {
        f32x4 av[4]; float am = 0.f;
#pragma unroll
        for (int hh = 0; hh < 4; ++hh) { const u32x2 o0 = R.o0[hh], o1 = R.o1[hh];
            f32x4 v; v[0] = bflo(o0.x) - lam * bflo(o1.x); v[1] = bfhi(o0.x) - lam * bfhi(o1.x); v[2] = bflo(o0.y) - lam * bflo(o1.y); v[3] = bfhi(o0.y) - lam * bfhi(o1.y);
            const float ss = wave_sum((v[0] * v[0] + v[1] * v[1]) + (v[2] * v[2] + v[3] * v[3]));
            const float r = rsqrtf(ss * (1.f / 256.f) + DA_EPS_) * (1.0f - LAMBDA_INIT);
            av[hh] = (f32x4){v[0] * r * sg[0], v[1] * r * sg[1], v[2] * r * sg[2], v[3] * r * sg[3]};
            am = fmaxf(fmaxf(am, fmaxf(fabsf(av[hh][0]), fabsf(av[hh][1]))), fmaxf(fabsf(av[hh][2]), fabsf(av[hh][3]))); }
        f32x4 y[4]; float ss = 0.f;
#pragma unroll
        for (int j = 0; j < 4; ++j) { const u32x2 hl2 = R.hl[j], ac2 = R.ac[j], xg = R.xg[j]; const f32x4 cr = R.cr[j];
            const f32x4 hl = {bflo(hl2.x), bfhi(hl2.x), bflo(hl2.y), bfhi(hl2.y)}, ac = {bflo(ac2.x), bfhi(ac2.x), bflo(ac2.y), bfhi(ac2.y)};
            const f32x4 h = hl + ac * cr;
            y[j][0] = h[0] * gelu_tanh(bflo(xg.x)); y[j][1] = h[1] * gelu_tanh(bfhi(xg.x)); y[j][2] = h[2] * gelu_tanh(bflo(xg.y)); y[j][3] = h[3] * gelu_tanh(bfhi(xg.y));
            ss += (y[j][0] * y[j][0] + y[j][1] * y[j][1]) + (y[j][2] * y[j][2] + y[j][3] * y[j][3]); }
        const float r = rsqrtf(wave_sum(ss) * (1.f / 1024.f) + EPS_);
#pragma unroll
        for (int j = 0; j < 4; ++j) { const f32x4 g = rg[j];
            y[j] = (f32x4){y[j][0] * r * g[0], y[j][1] * r * g[1], y[j][2] * r * g[2], y[j][3] * r * g[3]};
            am = fmaxf(fmaxf(am, fmaxf(fabsf(y[j][0]), fabsf(y[j][1]))), fmaxf(fabsf(y[j][2]), fabsf(y[j][3]))); }
#pragma unroll
        for (int o = 32; o > 0; o >>= 1) am = fmaxf(am, __shfl_xor(am, o));
        const float inv = am > 0.f ? 127.0f / am : 0.f;
#define PM_Q8(V) __builtin_amdgcn_perm(__builtin_amdgcn_perm(__float_as_uint(fmaf(V[3], inv, 12582912.0f)), __float_as_uint(fmaf(V[2], inv, 12582912.0f)), 0x0c0c0400u), \
                                       __builtin_amdgcn_perm(__float_as_uint(fmaf(V[1], inv, 12582912.0f)), __float_as_uint(fmaf(V[0], inv, 12582912.0f)), 0x0c0c0400u), 0x05040100u)
#pragma unroll
        for (int hh = 0; hh < 4; ++hh) *(unsigned*)(MIX8 + (size_t)t * DM + hh * 256 + d) = PM_Q8(av[hh]);
#pragma unroll
        for (int j = 0; j < 4; ++j) *(unsigned*)(MIX8 + (size_t)t * DM + 1024 + 4 * lane + 256 * j) = PM_Q8(y[j]);
#undef PM_Q8
        if (lane == 0) MIXSCALE[t] = am > 0.f ? am * (1.0f / 127.0f) : 1.0f;
    };
    for (int t0 = gw; t0 < S_; t0 += 2 * NGW) {
        const int t1 = t0 + NGW; const bool two = t1 < S_;
        RowIn A, B; load_row(t0, A); load_row(two ? t1 : t0, B);
        finish_row(t0, A); if (two) finish_row(t1, B);
    }
}

__device__ __forceinline__ void ffn_norm_router(unsigned char* ws, LAS unsigned char* lds, int G) {
    CArgs& a = *kargs();
    const int tid = threadIdx.x, wave = __builtin_amdgcn_readfirstlane(tid >> 6), lane = tid & 63, fr = lane & 15, fq = lane >> 4;
    LAS float* XF = (LAS float*)lds;
    LAS float* PL = (LAS float*)lds;
    LAS float* LG = (LAS float*)(lds + 16384);
    LAS int* CNT = (LAS int*)(lds + 16384 + 2048);
    const bf16_t* H = (const bf16_t*)(ws + WS_H); signed char* XQ = (signed char*)(ws + WS_XN); float* TOKSCALE = (float*)(ws + WS_TOKSCALE); const float* WR = a.in[I_W_ROUTER];
    int* TOPE = (int*)(ws + WS_TOPE); float* TOPG = (float*)(ws + WS_TOPG); int* TCNT = (int*)(ws + WS_TCNT);
    for (int tile = blockIdx.x; tile < 1024; tile += G) {
        u32x2 raw[2][8];
#pragma unroll
        for (int rr = 0; rr < 2; ++rr) { const bf16_t* xr = H + ((size_t)tile * 16 + wave * 2 + rr) * DM + 4 * lane;
#pragma unroll
            for (int j = 0; j < 8; ++j) raw[rr][j] = *(const u32x2*)(xr + 256 * j); }
#pragma unroll
        for (int rr = 0; rr < 2; ++rr) { const int row = wave * 2 + rr; const size_t t = (size_t)tile * 16 + row;
            const f32x4* gr = (const f32x4*)a.in[I_NORM_FFN_G] + lane;
            f32x4 v[8]; float s = 0.f;
#pragma unroll
            for (int j = 0; j < 8; ++j) { const u32x2 w = raw[rr][j]; v[j] = (f32x4){bflo(w.x), bfhi(w.x), bflo(w.y), bfhi(w.y)}; s += (v[j].x * v[j].x + v[j].y * v[j].y) + (v[j].z * v[j].z + v[j].w * v[j].w); }
            const float r = rsqrtf(wave_sum(s) * (1.f / 2048.f) + EPS_);
            float am = 0.f;
#pragma unroll
            for (int j = 0; j < 8; ++j) { const f32x4 gg = gr[64 * j]; v[j] = (f32x4){v[j].x * r * gg.x, v[j].y * r * gg.y, v[j].z * r * gg.z, v[j].w * r * gg.w};
                am = fmaxf(fmaxf(am, fmaxf(fabsf(v[j].x), fabsf(v[j].y))), fmaxf(fabsf(v[j].z), fabsf(v[j].w)));
                *(LAS f32x4*)(XF + row * 2052 + 4 * lane + 256 * j) = v[j]; }
#pragma unroll
            for (int o = 1; o < 64; o <<= 1) am = fmaxf(am, __shfl_xor(am, o));
            const float inv = am > 0.f ? 127.0f / am : 0.f;
            unsigned* o4 = (unsigned*)(XQ + t * DM) + lane;
#pragma unroll
            for (int j = 0; j < 8; ++j) { const int q0 = (int)rintf(v[j].x * inv), q1 = (int)rintf(v[j].y * inv), q2 = (int)rintf(v[j].z * inv), q3 = (int)rintf(v[j].w * inv);
                o4[64 * j] = ((unsigned)q0 & 0xffu) | (((unsigned)q1 & 0xffu) << 8) | (((unsigned)q2 & 0xffu) << 16) | (((unsigned)q3 & 0xffu) << 24); }
            if (lane == 0) TOKSCALE[t] = am > 0.f ? am * (1.0f / 127.0f) : 1.0f;
        }
        __syncthreads();
        f32x4 c0 = {0.f, 0.f, 0.f, 0.f}, c1 = {0.f, 0.f, 0.f, 0.f};
#pragma unroll 8
        for (int s = 0; s < 64; ++s) { const int k = 256 * wave + 4 * s + fq;
            const float af = XF[fr * 2052 + k], b0 = WR[(size_t)k * 32 + fr], b1 = WR[(size_t)k * 32 + 16 + fr];
            c0 = __builtin_amdgcn_mfma_f32_16x16x4f32(af, b0, c0, 0, 0, 0); c1 = __builtin_amdgcn_mfma_f32_16x16x4f32(af, b1, c1, 0, 0, 0); }
        __syncthreads();
#pragma unroll
        for (int r = 0; r < 4; ++r) { PL[(wave * 16 + fq * 4 + r) * 32 + fr] = c0[r]; PL[(wave * 16 + fq * 4 + r) * 32 + 16 + fr] = c1[r]; }
        if (tid < 32) CNT[tid] = 0;
        __syncthreads();
        { const int row = tid >> 5, e = tid & 31; float lg = a.in[I_B_ROUTER][e];
#pragma unroll
          for (int w = 0; w < 8; ++w) lg += PL[(w * 16 + row) * 32 + e];
          __syncthreads();
          LG[row * 32 + e] = lg; }
        __syncthreads();
        if (tid < 16) { const int row = tid; const size_t t = (size_t)tile * 16 + row; unsigned mask = 0u; float tv[4]; int te[4];
            for (int k = 0; k < 4; ++k) { float best = -__builtin_inff(); int bi = 0;
                for (int e = 0; e < 32; ++e) { const float x = LG[row * 32 + e]; if (!((mask >> e) & 1u) && x > best) { best = x; bi = e; } }
                mask |= 1u << bi; tv[k] = best; te[k] = bi; }
            float ex[4], sum = 0.f;
            for (int k = 0; k < 4; ++k) { ex[k] = __expf(tv[k] - tv[0]); sum += ex[k]; }
            const float inv = 1.0f / sum;
            for (int k = 0; k < 4; ++k) { TOPE[t * 4 + k] = te[k]; TOPG[t * 4 + k] = ex[k] * inv; __hip_atomic_fetch_add(&CNT[te[k]], 1, __ATOMIC_RELAXED, __HIP_MEMORY_SCOPE_WORKGROUP); }
        }
        __syncthreads();
        if (tid < 32) TCNT[tile * 32 + tid] = CNT[tid];
        __syncthreads();
    }
}

__device__ __forceinline__ void moe_route(unsigned char* ws, LAS unsigned char* lds, int G) {
    const int tid = threadIdx.x, wave = __builtin_amdgcn_readfirstlane(tid >> 6), lane = tid & 63;
    LAS int* TC = (LAS int*)lds;
    LAS int* PS = (LAS int*)(lds + 131072);
    LAS int* PPRE = (LAS int*)(lds + 133120);
    LAS int* TOT = (LAS int*)(lds + 135168);
    LAS int* PADSTART = (LAS int*)(lds + 135296);
    LAS int* SELPOS = (LAS int*)(lds + 135552);
    LAS int* SELTOK = (LAS int*)(lds + 135808);
    const int* TCNT = (const int*)(ws + WS_TCNT); const int* TOPE = (const int*)(ws + WS_TOPE); const float* TOPG = (const float*)(ws + WS_TOPG);
    int* POSOF = (int*)(ws + WS_POSOF); float* ROWGATE = (float*)(ws + WS_ROWGATE); int* TILEEXP = (int*)(ws + WS_TILEEXP); int* NRT = (int*)(ws + WS_NRT);
    int* SRCTOK = (int*)(ws + WS_SRCTOK); const float* TOKSCALE = (const float*)(ws + WS_TOKSCALE); float* ROWSCALE = (float*)(ws + WS_ROWSCALE);
    for (int i = tid; i < 8192; i += NTHREADS) *(LAS u32x4*)(TC + 4 * i) = *(const u32x4*)(TCNT + 4 * i);
    __syncthreads();
    { const int e = tid & 31, part = tid >> 5; int run = 0;
      for (int i = 0; i < 64; ++i) { const int idx = (part * 64 + i) * 32 + e; const int v = TC[idx]; TC[idx] = run; run += v; }
      PS[part * 32 + e] = run; }
    __syncthreads();
    if (tid < 32) { int run = 0; for (int p = 0; p < 16; ++p) { PPRE[p * 32 + tid] = run; run += PS[p * 32 + tid]; } TOT[tid] = run; }
    __syncthreads();
    if (tid == 0) { int run = 0;
        for (int e = 0; e < 32; ++e) { PADSTART[e] = run; const int pad = (TOT[e] + 255) & ~255;
            if (blockIdx.x == 0) for (int rt = run >> 8; rt < (run + pad) >> 8; ++rt) TILEEXP[rt] = e;
            run += pad; }
        PADSTART[32] = run; if (blockIdx.x == 0) NRT[0] = run >> 8; }
    __syncthreads();
    if (blockIdx.x == 0) for (int e = 0; e < 32; ++e) for (int p = PADSTART[e] + TOT[e] + tid; p < PADSTART[e + 1]; p += NTHREADS) SRCTOK[p] = 0;
    const int slot = wave & 3, half = wave >> 2;
    for (int it = 0; half == 0; ++it) {
        const int tile = blockIdx.x + (4 * it + slot) * G; if (tile >= 1024) break;
        const int m = lane, row = m >> 2, k = m & 3; const size_t t = (size_t)tile * 16 + row;
        const int e = TOPE[t * 4 + k]; const float g = TOPG[t * 4 + k]; int rank = 0;
        for (int mm = 0; mm < 64; ++mm) { const int em = __shfl(e, mm); rank += (mm < m && em == e) ? 1 : 0; }
        const int pos = PADSTART[e] + PPRE[(tile >> 6) * 32 + e] + TC[tile * 32 + e] + rank;
        if (half == 0) { ROWGATE[pos] = g; ROWSCALE[pos] = TOKSCALE[t]; POSOF[t * 4 + k] = pos; SRCTOK[pos] = (int)t; }
    }
}

__device__ __forceinline__ void final_combine(unsigned char* ws, int G) {
    CArgs& a = *kargs(); const int wave = wave_id(), lane = lane_id();
    const int gw = blockIdx.x * NWAVES + wave, NGW = G * NWAVES;
    const bf16_t* H = (const bf16_t*)(ws + WS_H); const unsigned char* YB = (const unsigned char*)(ws + WS_YB); const int* POSOF = (const int*)(ws + WS_POSOF);
    f32x4 gg[8];
#pragma unroll
    for (int j = 0; j < 8; ++j) gg[j] = ((const f32x4*)a.in[I_NORM_FINAL_G] + lane)[64 * j];
    for (int t0 = gw; t0 < S_; t0 += 2 * NGW) {
        const int t1 = t0 + NGW; const bool two = t1 < S_; const int tb = two ? t1 : t0;
        int pa[4], pb[4];
#pragma unroll
        for (int k = 0; k < 4; ++k) { pa[k] = POSOF[(size_t)t0 * 4 + k]; pb[k] = POSOF[(size_t)tb * 4 + k]; }
        f32x4 va[8], vb[8];
        { const bf16_t* xa = H + (size_t)t0 * DM + 4 * lane; const bf16_t* xb = H + (size_t)tb * DM + 4 * lane;
#pragma unroll
          for (int j = 0; j < 8; ++j) { va[j] = ld_bf16x4(xa + 256 * j); vb[j] = ld_bf16x4(xb + 256 * j); } }
        unsigned ya[4][8], yb[4][8];
#pragma unroll
        for (int k = 0; k < 4; ++k) { const unsigned* ra = (const unsigned*)(YB + (size_t)pa[k] * DM) + lane; const unsigned* rb = (const unsigned*)(YB + (size_t)pb[k] * DM) + lane;
#pragma unroll
            for (int j = 0; j < 8; ++j) { ya[k][j] = ra[64 * j]; yb[k][j] = rb[64 * j]; } }
#define FC_FINISH(V, Y, T) do {                                                                                                                         \
        _Pragma("unroll") for (int k = 0; k < 4; ++k) _Pragma("unroll") for (int j = 0; j < 8; ++j) { const unsigned y = Y[k][j];                        \
            const auto lo = __builtin_amdgcn_cvt_pk_f32_fp8(y, false), hi = __builtin_amdgcn_cvt_pk_f32_fp8(y, true);                                    \
            V[j].x += lo[0] * (1.0f / YB_SCALE); V[j].y += lo[1] * (1.0f / YB_SCALE); V[j].z += hi[0] * (1.0f / YB_SCALE); V[j].w += hi[1] * (1.0f / YB_SCALE); } \
        float s = 0.f;                                                                                                                                   \
        _Pragma("unroll") for (int j = 0; j < 8; ++j) s += (V[j].x * V[j].x + V[j].y * V[j].y) + (V[j].z * V[j].z + V[j].w * V[j].w);                   \
        const float r = rsqrtf(wave_sum(s) * (1.f / 2048.f) + EPS_);                                                                                    \
        f32x4* o = (f32x4*)(a.out + (size_t)(T) * DM) + lane;                                                                                           \
        _Pragma("unroll") for (int j = 0; j < 8; ++j) o[64 * j] = (f32x4){V[j].x * r * gg[j].x, V[j].y * r * gg[j].y, V[j].z * r * gg[j].z, V[j].w * r * gg[j].w}; } while (0)
        FC_FINISH(va, ya, t0);
        if (two) FC_FINISH(vb, yb, t1);
#undef FC_FINISH
    }
}

__global__ void __launch_bounds__(NTHREADS, 2) fwd_kernel(Args args) {
    extern __shared__ __attribute__((aligned(16))) unsigned char lds_raw[];
    LAS unsigned char* lds = (LAS unsigned char*)lds_raw;
    volatile LAS unsigned* MISC = (volatile LAS unsigned*)(lds + MISC_OFF);
    const int tid = threadIdx.x;
    const int G = gridDim.x, c = blockIdx.x;
    CArgs* ka = kargs();
    unsigned char* ws = ka->ws;
    unsigned* ctl = (unsigned*)(ws + WS_CTL);
    for (int u = tid; u < 64; u += NTHREADS) MISC[u] = 0u;
    __syncthreads();
    const int lo = ka->ph_lo, hi = ka->ph_hi;
    const bool multi = (hi - lo) > 1;
    XcdBarrier bar; bar.bar = ctl + CW_BAR; bar.x = 0; bar.st = nullptr;
    if (multi) bar = xcd_barrier_post(ctl + CW_BAR, MISC + 8);
#define IN(k) (lo <= (k) && (k) < hi)
#define SEAM(k) do { if (IN(k) && IN((k) + 1)) xcd_barrier(bar); } while (0)

    if (IN(0)) { p0_prologue(ws, lds, G); }
    SEAM(0);
    if (IN(1)) {
        pg8::Gemm g{DM / 2, DM / 2, DM / 2}; pg8::DenseOrder O; O.init(ws + WS_XN, ws + WS_WIN, S_, NIN, DM / 2, DM / 2, G, c);
        EpiInProjI8 E{EpiInProj{(bf16_t*)(ws + WS_Q), (bf16_t*)(ws + WS_XR), ctl + CW_VMAX}, (const float*)(ws + WS_INSCALE), (const float*)(ws + WS_SBIN)};
        pg8::gemm_phase<EpiInProjI8, pg8::DenseOrder, true, true>(lds, g, O, E);
    }
    SEAM(1);
    if (IN(2)) { rg_local(ws, lds, c, G); __syncthreads(); convert_v_fp8(ws, lds, G); }
    SEAM(2);
    if (IN(3)) {
        carry_scan(ws, lds, G);
        if (c < 16) {
            pg8::Gemm g{DM, DM, DM}; SmallOrder O{(const char*)(ws + WS_MEMN), (const char*)(ws + WS_WCKV), c};
            EpiSmall E{(bf16_t*)(ws + WS_KM), (bf16_t*)(ws + WS_VT)};
            pg8::gemm_phase<EpiSmall, SmallOrder, true>(lds, g, O, E); }
        attn_phase(ws, (char*)lds_raw, MISC, G);
    }
    SEAM(3);
    if (IN(4)) { post_mix(ws, G); }
    SEAM(4);
    if (IN(5)) {
        pg8::Gemm g{DM / 2, DM / 2, DM / 2}; pg8::DenseOrder O; O.init(ws + WS_MIX, ws + WS_WOUT, S_, DM, DM / 2, DM / 2, G, c);
        EpiResNormI8 E{EpiResNormF32{kargs()->in[I_X], (bf16_t*)(ws + WS_H), (unsigned char*)(ws + WS_XN), (float*)(ws + WS_SSQ)}, (const float*)(ws + WS_MIXSCALE), (const float*)(ws + WS_SBOUT)};
        pg8::gemm_phase<EpiResNormI8, pg8::DenseOrder, true, true>(lds, g, O, E);
    }
    SEAM(5);
    if (IN(7)) {
        pg8::Gemm g{DM / 2, DM / 2, DM / 2}; pg8::DenseOrder O; O.init(ws + WS_XN, ws + WS_WCQ, S_, DM, DM / 2, DM / 2, G, c);
        LAS float* RL = (LAS float*)(lds + 131072);
        { const float* SSQ = (const float*)(ws + WS_SSQ);
          for (int it = tid; it < 8 * 256; it += NTHREADS) { const int ui = it >> 8, row = it & 255; pg8::Unit u;
              if (O.next(ui, u)) { const f32x4* p = (const f32x4*)(SSQ + (size_t)(u.pm * 256 + row) * 32); f32x4 a4 = p[0];
#pragma unroll
                  for (int j = 1; j < 8; ++j) a4 += p[j];
                  RL[it] = rsqrtf(((a4[0] + a4[1]) + (a4[2] + a4[3])) * (1.f / 2048.f) + EPS_); } }
          __syncthreads(); }
        EpiBf16RowScale E{(bf16_t*)(ws + WS_QC), DM, RL, (const float*)(ws + WS_SBCQ)};
        pg8::gemm_phase<EpiBf16RowScale, pg8::DenseOrder, true, false, true>(lds, g, O, E);
    }
    SEAM(7);
    if (IN(8)) {
        pg8::Gemm g{512, DM, DM}; HeadOrderS O{(const char*)(ws + WS_QC), (const char*)(ws + WS_KM), G, c};
        EpiScore E{(bf16_t*)(ws + WS_PC), (float*)(ws + WS_LPART)};
        pg8::gemm_phase<EpiScore, HeadOrderS, true>(lds, g, O, E);
    }
    if (G != 256) SEAM(8);
    if (IN(9)) {
        pg8::Gemm g{256, 1024, 256}; HeadOrderO O{(const char*)(ws + WS_PC), (const char*)(ws + WS_VT), G, c};
        EpiCrossO E{(unsigned char*)(ws + WS_OC), (const float*)(ws + WS_LPART)};
        pg8::gemm_phase<EpiCrossO, HeadOrderO, true>(lds, g, O, E);
    }
    SEAM(9);
    if (IN(10)) {
        pg8::Gemm g{DM / 2, DM / 2, DM / 2}; pg8::DenseOrder O; O.init(ws + WS_OC, ws + WS_WCO, S_, DM, DM / 2, DM / 2, G, c);
        EpiResF32 E{(const bf16_t*)(ws + WS_H), (bf16_t*)(ws + WS_H), (const float*)(ws + WS_SBCO), 1.0f / 16.0f};
        pg8::gemm_phase<EpiResF32, pg8::DenseOrder, true, false, true>(lds, g, O, E);
    }
    SEAM(10);
    if (IN(11)) { ffn_norm_router(ws, lds, G); }
    SEAM(11);
    if (IN(12)) { moe_route(ws, lds, G); }
    SEAM(12);
    if (IN(13)) {
        pg8::Gemm g{DM / 2, DM / 2, DM / 2}; GroupOrderG O{(const char*)(ws + WS_XN), (const char*)(ws + WS_WGU), (const int*)(ws + WS_TILEEXP), (const int*)(ws + WS_SRCTOK), (size_t)4096 * 2048, (size_t)256 * 2048, *(const int*)(ws + WS_NRT), 16, G, c};
        EpiGateUpI8 E{(signed char*)(ws + WS_ACT), kargs()->in[I_B_GU], (const float*)(ws + WS_ROWSCALE), (const float*)(ws + WS_SBGU)};
        pg8::gemm_phase<EpiGateUpI8, GroupOrderG, true, true>(lds, g, O, E);
    }
    SEAM(13);
    if (IN(14)) {
        pg8::Gemm g{DM / 2, DM / 2, DM / 2}; GroupOrder O{(const char*)(ws + WS_ACT), (const char*)(ws + WS_WDN), (const int*)(ws + WS_TILEEXP), (size_t)2048 * 2048, (size_t)256 * 2048, *(const int*)(ws + WS_NRT), 8, G, c};
        EpiDown E{(unsigned char*)(ws + WS_YB), kargs()->in[I_B_DN], (const float*)(ws + WS_ROWGATE), (const float*)(ws + WS_SBDN)};
        pg8::gemm_phase<EpiDown, GroupOrder, true, true>(lds, g, O, E);
    }
    SEAM(14);
    if (IN(15)) { final_combine(ws, G); }
#undef IN
#undef SEAM
}

extern "C" void kernel_launch(void* const* d_in, const int* in_sizes, int n_in, void* d_out, int out_size, void* d_ws, size_t ws_size, hipStream_t stream) {
    static int grid = 0;
    if (grid == 0) {
        if (n_in != 31 || out_size != S_ * DM || ws_size < WS_END) { fprintf(stderr, "kernel_launch: unexpected shapes (n_in %d, out %d, ws %zu); nothing launched\n", n_in, out_size, ws_size); grid = -1; return; }
        int dev = 0, cus = 0, per_cu = 0;
        if (hipGetDevice(&dev) != hipSuccess || hipDeviceGetAttribute(&cus, hipDeviceAttributeMultiprocessorCount, dev) != hipSuccess) { grid = -1; return; }
        if (hipFuncSetAttribute((const void*)fwd_kernel, hipFuncAttributeMaxDynamicSharedMemorySize, LDS_BYTES) != hipSuccess) { fprintf(stderr, "kernel_launch: hipFuncSetAttribute failed\n"); grid = -1; return; }
        if (hipOccupancyMaxActiveBlocksPerMultiprocessor(&per_cu, (const void*)fwd_kernel, NTHREADS, LDS_BYTES) != hipSuccess || per_cu < 1)
            fprintf(stderr, "kernel_launch: occupancy query reports %d workgroups per CU\n", per_cu);
        (void)hipGetLastError();
        grid = cus;
    }
    if (grid < 0) return;
    if (hipMemsetAsync((char*)d_ws + WS_CTL, 0, CTL_ZERO_BYTES, stream) != hipSuccess) return;
    Args a{};
    for (int i = 0; i < 31; ++i) a.in[i] = (const float*)d_in[i];
    a.out = (float*)d_out; a.ws = (unsigned char*)d_ws;
#if MK_N_LAUNCHES == 1
    a.ph_lo = 0; a.ph_hi = N_PHASES;
    hipLaunchKernelGGL(fwd_kernel, dim3(grid), dim3(NTHREADS), LDS_BYTES, stream, a);
#else
    for (int p = 0; p < N_PHASES; ++p) { a.ph_lo = p; a.ph_hi = p + 1; hipLaunchKernelGGL(fwd_kernel, dim3(grid), dim3(NTHREADS), LDS_BYTES, stream, a);
#ifdef PROBE_DUP_MASK
        if ((PROBE_DUP_MASK >> p) & 1) hipLaunchKernelGGL(fwd_kernel, dim3(grid), dim3(NTHREADS), LDS_BYTES, stream, a);
#endif
    }
#endif
}
```

```cpp
#include <hip/hip_runtime.h>
#include <hip/hip_bf16.h>
#include <cstdio>
#include <cstdint>

namespace pg8 {
#define PG8_LAS __attribute__((address_space(3)))
typedef unsigned short bf16_t;
typedef short bf16x8 __attribute__((ext_vector_type(8)));
typedef float f32x4 __attribute__((ext_vector_type(4)));
typedef unsigned u32x4 __attribute__((ext_vector_type(4)));
constexpr int BM = 256, BK = 64, HALF = 128, HTB = HALF * BK * 2  , STAGE_BYTES = 8 * HTB, NXCD = 8, WGM = 8;

__host__ __device__ __forceinline__ int lds_byte(int r, int c) { const int st = (r >> 4) * 2 + (c >> 5), rr = r & 15, cc = c & 31, ob = rr * 64 + cc * 2; return st * 1024 + (ob ^ (((ob >> 9) & 1) << 5)); }
__host__ __device__ __forceinline__ void stage_rc(int b, int& R, int& C) { const int st = b / 1024, sb = b % 1024, swz = sb ^ (((sb >> 9) & 1) << 5); R = (st >> 1) * 16 + swz / 64; C = (st & 1) * 32 + (swz % 64) / 2; }
__host__ __device__ __forceinline__ int perm32(int rho) { const int n = rho >> 4, i = rho & 15; return 8 * (i >> 2) + 4 * n + (i & 3); }

struct Unit { int pm, pn, e; const char* A; const char* B; };
struct Gemm { int K, lda, ldb; };

__device__ __forceinline__ unsigned cvt_pk_bf16(float lo, float hi) { unsigned r; asm volatile("v_cvt_pk_bf16_f32 %0, %1, %2" : "=v"(r) : "v"(lo), "v"(hi)); return r; }

struct DenseOrder {
    const char* A; const char* B; size_t tsA, tsB; int nM, nN, nwg, G, c;
    __device__ void init(const void* A_, const void* B_, int M, int N, int lda, int ldb, int G_, int c_) { A = (const char*)A_; B = (const char*)B_; tsA = (size_t)BM * lda * 2; tsB = (size_t)BM * ldb * 2; nM = M / BM; nN = N / BM; nwg = nM * nN; G = G_; c = c_; }
    __device__ __forceinline__ bool next(int i, Unit& u) const {
        const long L = (long)i * G + c; if (L >= nwg) return false;
        int wgid = (int)L; { const int q = nwg / NXCD, r = nwg % NXCD, xcd = wgid % NXCD, off = wgid / NXCD; wgid = (xcd < r ? xcd * (q + 1) : r * (q + 1) + (xcd - r) * q) + off; }
        const int nig = WGM * nN, gid = wgid / nig, fm = gid * WGM, gsz = (nM - fm) < WGM ? (nM - fm) : WGM;
        u.pm = fm + ((wgid % nig) % gsz); u.pn = (wgid % nig) / gsz; u.e = i; u.A = A + (size_t)u.pm * tsA; u.B = B + (size_t)u.pn * tsB; return true;
    }
};

typedef int i32x4 __attribute__((ext_vector_type(4)));
template <bool I8> struct AccSel { typedef f32x4 type; };
template <> struct AccSel<true> { typedef i32x4 type; };
__device__ __forceinline__ f32x4 mma16(bf16x8 a, bf16x8 b, f32x4 c) { return __builtin_amdgcn_mfma_f32_16x16x32_bf16(a, b, c, 0, 0, 0); }
__device__ __forceinline__ i32x4 mma16(bf16x8 a, bf16x8 b, i32x4 c) { return __builtin_amdgcn_mfma_i32_16x16x64_i8(__builtin_bit_cast(i32x4, a), __builtin_bit_cast(i32x4, b), c, 0, 0, 0); }
typedef int i32x8 __attribute__((ext_vector_type(8)));
__device__ __forceinline__ f32x4 mma16f8(bf16x8 b0, bf16x8 b1, bf16x8 a0, bf16x8 a1, f32x4 c) {
    const i32x4 B0 = __builtin_bit_cast(i32x4, b0), B1 = __builtin_bit_cast(i32x4, b1), A0 = __builtin_bit_cast(i32x4, a0), A1 = __builtin_bit_cast(i32x4, a1);
    const i32x8 B8 = {B0[0], B0[1], B0[2], B0[3], B1[0], B1[1], B1[2], B1[3]}, A8 = {A0[0], A0[1], A0[2], A0[3], A1[0], A1[1], A1[2], A1[3]};
    asm volatile("v_mfma_f32_16x16x128_f8f6f4 %0, %1, %2, %0" : "+v"(c) : "v"(B8), "v"(A8));
    return c;
}
template <class S_> struct IsGather { template <class T> static char f(decltype(&T::rows)); template <class T> static int f(...); static constexpr bool v = sizeof(f<S_>(nullptr)) == 1; };
template <class Epi, class Sched, bool ALIGN_EPI, bool I8 = false, bool F8 = false>
__device__ __forceinline__ void gemm_phase(PG8_LAS unsigned char* lds, const Gemm g, const Sched& S, const Epi& E) {
    const int tid = threadIdx.x, wid = __builtin_amdgcn_readfirstlane(tid >> 6), lane = tid & 63, wr = wid >> 2, wc = wid & 3, fr = lane & 15, fq = lane >> 4;
    const int K = g.K, nt = K / BK;
    unsigned voffA[2], voffB[2];
#pragma unroll
    for (int i = 0; i < 2; ++i) { int R, C; stage_rc(tid * 16 + i * 8192, R, C); const int Rb = Epi::PERM ? ((R & ~31) + perm32(R & 31)) : R;
        voffA[i] = (unsigned)(R * g.lda + C) * 2u; voffB[i] = (unsigned)(Rb * g.ldb + C) * 2u; }
    const size_t kstep = (size_t)(BK * 2);
    const size_t hstepA = (size_t)HALF * g.lda * 2, hstepB = (size_t)HALF * g.ldb * 2;
    const unsigned ldsw = (unsigned)wid * 1024u;
    const int aoff = lds_byte(wr * 64 + fr, fq * 8), boff = lds_byte(wc * 32 + fr, fq * 8);
#define PG8_SA(b, h) (((b) * 2 + (h)) * HTB)
#define PG8_SB(b, h) ((4 + (b) * 2 + (h)) * HTB)
#define PG8_STAGE(bufoff, gbase, voff) do { _Pragma("unroll") for (int _i = 0; _i < 2; ++_i) \
        __builtin_amdgcn_global_load_lds((const unsigned*)((const char*)(gbase) + (voff)[_i]), (PG8_LAS unsigned*)(lds + (bufoff) + ldsw + _i * 8192), 16, 0, 0); } while (0)
#define PG8_STAGE_A(b, h, base, v0, v1) do { if constexpr (GA) { if ((h) == 0) PG8_STAGE(PG8_SA(b, h), base, v0); else PG8_STAGE(PG8_SA(b, h), base, v1); } \
        else PG8_STAGE(PG8_SA(b, h), (h) ? (base) + hstepA : (base), voffA); } while (0)
#define PG8_LDA(dst, b, h) do { _Pragma("unroll") for (int m = 0; m < 4; ++m) _Pragma("unroll") for (int k = 0; k < 2; ++k) dst[m][k] = *(const PG8_LAS bf16x8*)(lds + PG8_SA(b, h) + aoff + m * 2048 + k * 1024); } while (0)
#define PG8_LDB(dst, b, h) do { _Pragma("unroll") for (int n = 0; n < 2; ++n) _Pragma("unroll") for (int k = 0; k < 2; ++k) dst[n][k] = *(const PG8_LAS bf16x8*)(lds + PG8_SB(b, h) + boff + n * 2048 + k * 1024); } while (0)
#define PG8_MMA(ai, bj, At, Bt) do { __builtin_amdgcn_s_setprio(1); _Pragma("unroll") for (int m = 0; m < 4; ++m) _Pragma("unroll") for (int n = 0; n < 2; ++n) { \
        if constexpr (F8) acc[ai][bj][m][n] = mma16f8(Bt[n][0], Bt[n][1], At[m][0], At[m][1], acc[ai][bj][m][n]); \
        else { _Pragma("unroll") for (int k = 0; k < 2; ++k) acc[ai][bj][m][n] = mma16(Bt[n][k], At[m][k], acc[ai][bj][m][n]); } } __builtin_amdgcn_s_setprio(0); } while (0)
#define PG8_WAIT_V(n) asm volatile("s_waitcnt vmcnt(" #n ")" ::: "memory")
#define PG8_WAIT_L(n) asm volatile("s_waitcnt lgkmcnt(" #n ")" ::: "memory")
#define PG8_BAR __builtin_amdgcn_s_barrier()
#define PG8_SCHED __builtin_amdgcn_sched_barrier(0)
    Unit cur, nxt; int ui = 0;
    if (!S.next(0, cur)) return;
    constexpr bool GA = IsGather<Sched>::v;
    unsigned voffA1[2], nvA0[2], nvA1[2];
    int gR[2], gC[2];
    if constexpr (GA) {
#pragma unroll
        for (int i = 0; i < 2; ++i) { stage_rc(tid * 16 + i * 8192, gR[i], gC[i]);
            const int* rw = S.rows + (size_t)cur.pm * 256; voffA[i] = (unsigned)(rw[gR[i]] * g.lda + gC[i]) * 2u; voffA1[i] = (unsigned)(rw[128 + gR[i]] * g.lda + gC[i]) * 2u; nvA0[i] = voffA[i]; nvA1[i] = voffA1[i]; }
    }
    typedef typename AccSel<I8>::type acc_t;
    acc_t acc[2][2][4][2];
#pragma unroll
    for (int a = 0; a < 2; ++a)
#pragma unroll
        for (int b = 0; b < 2; ++b)
#pragma unroll
            for (int m = 0; m < 4; ++m)
#pragma unroll
                for (int n = 0; n < 2; ++n) acc[a][b][m][n] = (acc_t){0, 0, 0, 0};
    bf16x8 At[4][2], B0[2][2], B1[2][2];
    const char* cA = cur.A; const char* cB = cur.B;
    PG8_STAGE(PG8_SB(0, 0), cB, voffB); PG8_STAGE(PG8_SB(0, 1), cB + hstepB, voffB); PG8_STAGE_A(0, 0, cA, voffA, voffA1); PG8_STAGE_A(0, 1, cA, voffA, voffA1);
    if (wr == 1) PG8_BAR;
    PG8_WAIT_V(2); PG8_BAR;
    PG8_STAGE(PG8_SB(1, 0), cB + kstep, voffB); PG8_STAGE_A(1, 0, cA + kstep, voffA, voffA1); PG8_STAGE(PG8_SB(1, 1), cB + hstepB + kstep, voffB);
    PG8_WAIT_V(6); PG8_BAR;
    for (;;) {
        const bool has_next = S.next(ui + 1, nxt);
        const char* nA = has_next ? nxt.A : cA; const char* nB = has_next ? nxt.B : cB;
        if constexpr (GA) { if (has_next) { const int* rw = S.rows + (size_t)nxt.pm * 256;
#pragma unroll
            for (int i = 0; i < 2; ++i) { nvA0[i] = (unsigned)(rw[gR[i]] * g.lda + gC[i]) * 2u; nvA1[i] = (unsigned)(rw[128 + gR[i]] * g.lda + gC[i]) * 2u; } } }
        for (int t = 0; t < nt; t += 2) {
            const bool last = (t == nt - 2);
            const char* a1 = cA + (size_t)(t + 1) * kstep;
            const char* a2 = last ? nA : cA + (size_t)(t + 2) * kstep; const char* b2 = last ? nB : cB + (size_t)(t + 2) * kstep;
            const char* a3 = a2 + kstep; const char* b3 = b2 + kstep;
            unsigned w0[2], w1[2];
#pragma unroll
            for (int i = 0; i < 2; ++i) { w0[i] = (GA && last) ? nvA0[i] : voffA[i]; w1[i] = (GA && last) ? nvA1[i] : voffA1[i]; }
            PG8_LDB(B0, 0, 0); PG8_LDB(B1, 0, 1); PG8_SCHED; PG8_LDA(At, 0, 0); PG8_STAGE_A(1, 1, a1, voffA, voffA1);
            PG8_WAIT_V(8); PG8_WAIT_L(0); PG8_BAR; PG8_MMA(0, 0, At, B0); PG8_MMA(0, 1, At, B1); PG8_BAR; PG8_SCHED;
            PG8_LDA(At, 0, 1); PG8_STAGE(PG8_SB(0, 0), b2, voffB); PG8_STAGE(PG8_SB(0, 1), b2 + hstepB, voffB); PG8_STAGE_A(0, 0, a2, w0, w1);
            PG8_WAIT_V(8); PG8_WAIT_L(0); PG8_BAR; PG8_MMA(1, 0, At, B0); PG8_MMA(1, 1, At, B1); PG8_BAR; PG8_SCHED;
            PG8_LDB(B0, 1, 0); PG8_LDB(B1, 1, 1); PG8_SCHED; PG8_LDA(At, 1, 0); PG8_STAGE_A(0, 1, a2, w0, w1);
            PG8_WAIT_V(8); PG8_WAIT_L(0); PG8_BAR; PG8_MMA(0, 0, At, B0); PG8_MMA(0, 1, At, B1); PG8_BAR; PG8_SCHED;
            PG8_LDA(At, 1, 1); PG8_STAGE(PG8_SB(1, 0), b3, voffB); PG8_STAGE(PG8_SB(1, 1), b3 + hstepB, voffB); PG8_STAGE_A(1, 0, a3, w0, w1);
            PG8_WAIT_V(8); PG8_WAIT_L(0); PG8_BAR; PG8_MMA(1, 0, At, B0); PG8_MMA(1, 1, At, B1); PG8_BAR; PG8_SCHED;
        }
        if constexpr (ALIGN_EPI) { if (wr == 0) PG8_BAR; }
        if constexpr (F8) {
            asm volatile("s_nop 15\n\ts_nop 15" ::: "memory");
#pragma unroll
            for (int a = 0; a < 2; ++a)
#pragma unroll
                for (int b = 0; b < 2; ++b)
#pragma unroll
                    for (int m = 0; m < 4; ++m)
#pragma unroll
                        for (int n = 0; n < 2; ++n) asm volatile("" : "+v"(acc[a][b][m][n]));
        }
        E(acc, cur, wr, wc, fr, fq);
        if (!has_next) break;
#pragma unroll
        for (int a = 0; a < 2; ++a)
#pragma unroll
            for (int b = 0; b < 2; ++b)
#pragma unroll
                for (int m = 0; m < 4; ++m)
#pragma unroll
                    for (int n = 0; n < 2; ++n) acc[a][b][m][n] = (acc_t){0, 0, 0, 0};
        cur = nxt; cA = nA; cB = nB; ++ui;
        if constexpr (GA) {
#pragma unroll
            for (int i = 0; i < 2; ++i) { voffA[i] = nvA0[i]; voffA1[i] = nvA1[i]; } }
        if constexpr (ALIGN_EPI) { if (wr == 1) PG8_BAR; }
    }
    PG8_WAIT_V(0);
    if constexpr (!ALIGN_EPI) { if (wr == 0) PG8_BAR; }
    PG8_BAR;
#undef PG8_SA
#undef PG8_SB
#undef PG8_STAGE
#undef PG8_STAGE_A
#undef PG8_LDA
#undef PG8_LDB
#undef PG8_MMA
#undef PG8_WAIT_V
#undef PG8_WAIT_L
#undef PG8_BAR
#undef PG8_SCHED
}
}

namespace att {
constexpr int D = 128;
constexpr float THR = 8.f;
constexpr bool WSKIP = false;
constexpr float SCALE = 0.08838834764831845f;
constexpr int NW = 8, QBLK = 32, KVBLK = 64, QB = NW * QBLK;
constexpr int SHM_V = KVBLK * D * 2, SHM_K = KVBLK * D * 2;
constexpr int LDS_BYTES = 2 * SHM_V + 2 * SHM_K + NW * 64 * 4;
static_assert(D == 128, "geometry");

using bf16 = __hip_bfloat16;
typedef short bf16x8 __attribute__((ext_vector_type(8)));
typedef short s16x4 __attribute__((ext_vector_type(4)));
typedef float f32x16 __attribute__((ext_vector_type(16)));
typedef float f32x4 __attribute__((ext_vector_type(4)));
typedef unsigned u32x4 __attribute__((ext_vector_type(4)));
template <class A, class Bt> struct same_t { static constexpr bool v = false; };
template <class A> struct same_t<A, A> { static constexpr bool v = true; };

#define KSWZ(row, colB) ((row) * 256 + ((colB) ^ (((row) & 7) << 4)))
#define SBAR() __builtin_amdgcn_sched_barrier(0)
__device__ __forceinline__ int v_st(int k, int c) { const int kk = (k & ~0xC) | ((k & 4) << 1) | ((k & 8) >> 1); return ((kk >> 3) * 4 + (c >> 5)) * 512 + ((kk & 7) * 32 + (c & 31)) * 2; }
__device__ __forceinline__ int v_rd_base(int lane) { return ((lane & 3) << 3) | (((lane >> 2) & 3) << 6) | (((lane >> 4) & 1) << 5) | (((lane >> 5) & 1) << 8); }
constexpr int v_rd_off(int d0, int ks, int half) { return d0 * 512 + ks * 4096 + half * 2048; }
__device__ __forceinline__ int crow(int r, int hi) { return (r & 3) + 8 * (r >> 2) + 4 * hi; }
__device__ __forceinline__ unsigned cvtpk(float lo, float hi) {
    unsigned r; asm volatile("v_cvt_pk_bf16_f32 %0, %1, %2" : "=v"(r) : "v"(lo), "v"(hi)); return r;
}
__device__ __forceinline__ bf16x8 pack8(f32x4 a, f32x4 b) {
    u32x4 w = {cvtpk(a[0], a[1]), cvtpk(a[2], a[3]), cvtpk(b[0], b[1]), cvtpk(b[2], b[3])};
    return *reinterpret_cast<bf16x8*>(&w);
}
template <class T> __device__ __forceinline__ bf16x8 load8(const T* p) {
    if constexpr (same_t<T, float>::v) { return pack8(*(const f32x4*)p, *(const f32x4*)(p + 4)); }
    else { return *reinterpret_cast<const bf16x8*>(p); }
}
__device__ __forceinline__ void mask_tile(f32x16& p0, f32x16& p1, int dq, unsigned W) {
    const float NEG = -__builtin_inff();
#pragma unroll
    for (int r = 0; r < 16; ++r) {
        const int c = (r & 3) + 8 * (r >> 2);
        if ((unsigned)(dq - c) >= W) p0[r] = NEG;
        if ((unsigned)(dq - c - 32) >= W) p1[r] = NEG;
    }
}
__device__ __forceinline__ void partialSM(f32x16& p0, f32x16& p1, float& m_reg, float& mn, float& alpha) {
    float pmax = p0[0]; for (int r = 1; r < 16; ++r) pmax = fmaxf(pmax, p0[r]); for (int r = 0; r < 16; ++r) pmax = fmaxf(pmax, p1[r]);
    { auto rr = __builtin_amdgcn_permlane32_swap(__float_as_uint(pmax), __float_as_uint(pmax), false, false);
      pmax = fmaxf(__uint_as_float(rr[0]), __uint_as_float(rr[1])); }
    constexpr float C2 = 1.4426950408889634f * SCALE;
    if (__builtin_expect(__all((pmax - m_reg) * SCALE <= THR), 1)) { mn = m_reg; alpha = 1.f; }
    else { mn = fmaxf(m_reg, pmax); alpha = __builtin_amdgcn_exp2f((m_reg - mn) * C2); m_reg = mn; }
    const float mnL = -mn * C2;
    for (int r = 0; r < 16; ++r) p0[r] = fmaf(p0[r], C2, mnL); for (int r = 0; r < 16; ++r) p1[r] = fmaf(p1[r], C2, mnL);
    for (int r = 0; r < 16; ++r) p0[r] = __builtin_amdgcn_exp2f(p0[r]);
}
__device__ __forceinline__ void finishSM(f32x16& p0, f32x16& p1, float alpha, float& l_reg, bf16x8& pa0, bf16x8& pa1, bf16x8& pa2, bf16x8& pa3) {
    for (int r = 0; r < 16; ++r) p1[r] = __builtin_amdgcn_exp2f(p1[r]);
    float ps = 0; for (int r = 0; r < 16; ++r) ps += p0[r]; for (int r = 0; r < 16; ++r) ps += p1[r];
    { auto rr = __builtin_amdgcn_permlane32_swap(__float_as_uint(ps), __float_as_uint(ps), false, false);
      ps = __uint_as_float(rr[0]) + __uint_as_float(rr[1]); }
    l_reg = l_reg * alpha + ps;
#define PK4(P, B_, OUT) do { unsigned a0 = cvtpk(P[B_+0], P[B_+1]), a1 = cvtpk(P[B_+2], P[B_+3]);                          \
        unsigned b0 = cvtpk(P[B_+4], P[B_+5]), b1 = cvtpk(P[B_+6], P[B_+7]);                                             \
        auto r0 = __builtin_amdgcn_permlane32_swap(a0, b0, false, false); auto r1 = __builtin_amdgcn_permlane32_swap(a1, b1, false, false); \
        u32x4 w = {r0[0], r1[0], r0[1], r1[1]}; OUT = *reinterpret_cast<bf16x8*>(&w); } while (0)
    PK4(p0, 0, pa0); PK4(p0, 8, pa1); PK4(p1, 0, pa2); PK4(p1, 8, pa3);
#undef PK4
}
template <int KB, bool SK>
__device__ __forceinline__ void qkt(f32x16& p0, f32x16& p1, const char* K_lds, int r32, int hi, const bf16x8* qr, bool act) {
    if (SK && !act) { const float NEG = -__builtin_inff();
#pragma unroll
        for (int r = 0; r < 16; ++r) { p0[r] = NEG; p1[r] = NEG; } return; }
    p0 = f32x16{}; p1 = f32x16{};
    const char* kb[4];
#pragma unroll
    for (int dd = 0; dd < 4; ++dd) kb[dd] = K_lds + KB * SHM_K + KSWZ(r32, (dd * 16 + hi * 8) * 2);
#pragma unroll
    for (int d0 = 0; d0 < 8; ++d0) { const char* a = kb[d0 & 3] + (d0 >> 2) * 128;
        bf16x8 b0 = *reinterpret_cast<const bf16x8*>(a);
        bf16x8 b1 = *reinterpret_cast<const bf16x8*>(a + 32 * 256);
        p0 = __builtin_amdgcn_mfma_f32_32x32x16_bf16(b0, qr[d0], p0, 0, 0, 0);
        p1 = __builtin_amdgcn_mfma_f32_32x32x16_bf16(b1, qr[d0], p1, 0, 0, 0); }
}
template <int VB, bool SK>
__device__ __forceinline__ void pv_tile(f32x16* o, int vb0, bf16x8 pa0, bf16x8 pa1, bf16x8 pa2, bf16x8 pa3, bool act) {
    if (SK && !act) return;
#define TRRD(dst, off) asm volatile("ds_read_b64_tr_b16 %0, %1 offset:%2" : "=&v"(dst) : "v"(vb0), "i"(off) : "memory")
#define PV_D0(d0) do { s16x4 l0, l1, l2, l3, h0, h1, h2, h3; constexpr int b_ = VB * SHM_V + v_rd_off(d0, 0, 0);     \
        TRRD(l0, b_); TRRD(h0, b_ + 2048); TRRD(l1, b_ + 4096); TRRD(h1, b_ + 6144); TRRD(l2, b_ + 8192); TRRD(h2, b_ + 10240); TRRD(l3, b_ + 12288); TRRD(h3, b_ + 14336); \
        asm volatile("s_waitcnt lgkmcnt(0)" ::: "memory"); SBAR();                 \
        o[d0] = __builtin_amdgcn_mfma_f32_32x32x16_bf16(pa0, (bf16x8){l0[0], l0[1], l0[2], l0[3], h0[0], h0[1], h0[2], h0[3]}, o[d0], 0, 0, 0);   \
        o[d0] = __builtin_amdgcn_mfma_f32_32x32x16_bf16(pa1, (bf16x8){l1[0], l1[1], l1[2], l1[3], h1[0], h1[1], h1[2], h1[3]}, o[d0], 0, 0, 0);   \
        o[d0] = __builtin_amdgcn_mfma_f32_32x32x16_bf16(pa2, (bf16x8){l2[0], l2[1], l2[2], l2[3], h2[0], h2[1], h2[2], h2[3]}, o[d0], 0, 0, 0);   \
        o[d0] = __builtin_amdgcn_mfma_f32_32x32x16_bf16(pa3, (bf16x8){l3[0], l3[1], l3[2], l3[3], h3[0], h3[1], h3[2], h3[3]}, o[d0], 0, 0, 0); } while (0)
    PV_D0(0); PV_D0(1); PV_D0(2); PV_D0(3);
#undef PV_D0
#undef TRRD
}

template <class TIn, class TOut> struct BlockRef { const TIn* Q; const TIn* K; const TIn* V; TOut* O; int P0; };
template <class TIn> struct Seam {
    bf16x8 qr[8];
    bf16x8 st_v0, st_v1, st_k0, st_k1; f32x4 sf0, sf1, sf2, sf3;
    f32x4 tq[16];
};
__device__ __forceinline__ int swa_jlo(int P0, int W) { const int lowk = P0 - W + 1; return lowk > 0 ? lowk / KVBLK : 0; }
#define ROW(p, k0, rr) ((p) + (size_t)((k0) + (rr)) * D + sc)
#define VMW() asm volatile("s_waitcnt vmcnt(0)" ::: "memory")
#define VMWN(n) asm volatile("s_waitcnt vmcnt(%0)" :: "i"(n) : "memory")
#define SLOAD_H(Kp, Vp, k0) do { S.st_v0 = load8<TIn>(ROW(Vp, k0, sr)); S.st_v1 = load8<TIn>(ROW(Vp, k0, 32 + sr));              \
                         S.st_k0 = load8<TIn>(ROW(Kp, k0, sr)); S.st_k1 = load8<TIn>(ROW(Kp, k0, 32 + sr)); } while (0)
#define SWRITE_HK(bf) do { *(bf16x8*)(K_lds + (bf) * SHM_K + kws) = S.st_k0; *(bf16x8*)(K_lds + (bf) * SHM_K + kws + 32 * 256) = S.st_k1; } while (0)
#define SWRITE_HV(bf) do { *(bf16x8*)(V_lds + (bf) * SHM_V + vst0) = S.st_v0; *(bf16x8*)(V_lds + (bf) * SHM_V + vst1) = S.st_v1; } while (0)
#define SWRITE_H(bf) do { SWRITE_HV(bf); SWRITE_HK(bf); } while (0)
#define SLOAD_F(p, k0) do { S.sf0 = *(const f32x4*)ROW(p, k0, sr); S.sf1 = *(const f32x4*)(ROW(p, k0, sr) + 4);                \
                            S.sf2 = *(const f32x4*)ROW(p, k0, 32 + sr); S.sf3 = *(const f32x4*)(ROW(p, k0, 32 + sr) + 4); } while (0)
#define SWRITE_KF(bf) do { *(bf16x8*)(K_lds + (bf) * SHM_K + kws) = pack8(S.sf0, S.sf1); *(bf16x8*)(K_lds + (bf) * SHM_K + kws + 32 * 256) = pack8(S.sf2, S.sf3); } while (0)
#define SWRITE_VF(bf) do { *(bf16x8*)(V_lds + (bf) * SHM_V + vst0) = pack8(S.sf0, S.sf1); *(bf16x8*)(V_lds + (bf) * SHM_V + vst1) = pack8(S.sf2, S.sf3); } while (0)
template <class TIn, class TOut>
__device__ __forceinline__ void causal_swa_prime(const BlockRef<TIn, TOut>& cur, int W, char* lds, Seam<TIn>& S) {
    constexpr bool F32 = same_t<TIn, float>::v;
    const int tid = threadIdx.x, wid = __builtin_amdgcn_readfirstlane(tid >> 6), lane = tid & 63, r32 = lane & 31, hi = lane >> 5;
    const int sr = tid >> 4, sc = (tid & 15) * 8, kws = KSWZ(sr, sc * 2); char* K_lds = lds + 2 * SHM_V;
    const int kb0 = swa_jlo(cur.P0, W) * KVBLK;
    for (int d0 = 0; d0 < 8; ++d0) S.qr[d0] = load8<TIn>(cur.Q + (size_t)(wid * QBLK + r32) * D + d0 * 16 + hi * 8);
    if constexpr (F32) { SLOAD_F((const float*)cur.K, kb0); VMW(); SWRITE_KF(0); SBAR(); SLOAD_F((const float*)cur.V, kb0); }
    else { SLOAD_H(cur.K, cur.V, kb0); VMW(); SWRITE_HK(0); }
    __syncthreads();
}
template <class TIn, class TOut>
__device__ __forceinline__ void causal_swa_block(const BlockRef<TIn, TOut>& cur, const BlockRef<TIn, TOut>& nxt, int skv, int W, char* lds, Seam<TIn>& S) {
    constexpr bool F32 = same_t<TIn, float>::v;
    const int tid = threadIdx.x, wid = __builtin_amdgcn_readfirstlane(tid >> 6), lane = tid & 63, r32 = lane & 31, hi = lane >> 5;
    const int j_lo = swa_jlo(cur.P0, W);
    int j_hi = (cur.P0 + QB - 1) / KVBLK + 1; if (j_hi > skv / KVBLK) j_hi = skv / KVBLK;
    const int NT = j_hi - j_lo;
    const int kbn = swa_jlo(nxt.P0, W) * KVBLK;
    const int qlo = cur.P0 + wid * QBLK, qm = qlo + r32 - 4 * hi;
    char* V_lds = lds; char* K_lds = lds + 2 * SHM_V;
    float* ws = (float*)(lds + 2 * SHM_V + 2 * SHM_K) + wid * 64; float* li_l = ws, * al_l = ws + 32;
    float m_reg = -1e30f, l_reg = 0; f32x16 o[4] = {};
    const int sr = tid >> 4, sc = (tid & 15) * 8, vst0 = v_st(sr, sc), vst1 = v_st(32 + sr, sc), kws = KSWZ(sr, sc * 2);
    const int vb0 = (int)(uintptr_t)V_lds + v_rd_base(lane);
    const TIn* Kh = cur.K; const TIn* Vh = cur.V;
#define RESC(a) do { if (__any((a) < 1.f)) { if (hi == 0) al_l[r32] = (a); asm volatile("s_waitcnt lgkmcnt(0)" ::: "memory");              \
                     for (int d_ = 0; d_ < 4; ++d_) for (int r = 0; r < 16; ++r) o[d_][r] *= al_l[crow(r, hi)]; } } while (0)
#define KBASE(t) ((j_lo + (t)) * KVBLK)
#define ACT(t) (KBASE(t) <= qlo + QBLK - 1 && KBASE(t) + KVBLK - 1 >= qlo - W + 1)
#define MASKT(P0_, P1_, t) do { const int kb_ = KBASE(t); if ((!SK || ACT(t)) && (kb_ + KVBLK - 1 > qlo || kb_ <= qlo + QBLK - 1 - W)) mask_tile(P0_, P1_, qm - kb_, (unsigned)W); } while (0)
    constexpr int NQL = F32 ? 16 : 8;
    constexpr bool SK = WSKIP && !F32;
#define SEAM_K0() do { VMWN(NQL); if constexpr (F32) { SWRITE_KF(0); SBAR(); SLOAD_F((const float*)nxt.V, kbn); } else { SWRITE_HK(0); } SBAR(); } while (0)
    f32x16 pA0, pA1, pB0, pB1; float mnA, mnB, alA, alB; bf16x8 pa0, pa1, pa2, pa3;
    if constexpr (F32) { VMW(); SWRITE_VF(0); SBAR(); } else { SWRITE_HV(0); SBAR(); }
    if (NT > 1) { if constexpr (F32) SLOAD_F((const float*)Kh, KBASE(1)); else SLOAD_H(Kh, Vh, KBASE(1)); }
    SBAR(); qkt<0, SK>(pA0, pA1, K_lds, r32, hi, S.qr, ACT(0));
    if constexpr (F32) { if (NT > 1) { VMW(); SWRITE_KF(1); SBAR(); SLOAD_F((const float*)Vh, KBASE(1)); } }
    MASKT(pA0, pA1, 0); partialSM(pA0, pA1, m_reg, mnA, alA);
    if (NT > 1) { VMW(); if constexpr (F32) { SWRITE_VF(1); SBAR(); if (NT > 2) SLOAD_F((const float*)Kh, KBASE(2)); } else SWRITE_H(1); }
    __syncthreads();
#define HALF_STEP(PX0, PX1, mnX, alX, PY0, PY1, alY, t, KB, VB, SB) do {                                                      \
        SBAR(); qkt<KB, SK>(PX0, PX1, K_lds, r32, hi, S.qr, ACT(t));                                             \
        finishSM(PY0, PY1, alY, l_reg, pa0, pa1, pa2, pa3); SBAR();                                                           \
        if ((t) + 1 < NT) { if constexpr (F32) { VMW(); SWRITE_KF(SB); SBAR(); SLOAD_F((const float*)Vh, KBASE((t) + 1)); }  \
                            else { SLOAD_H(Kh, Vh, KBASE((t) + 1)); } SBAR(); }                                               \
        pv_tile<VB, SK>(o, vb0, pa0, pa1, pa2, pa3, ACT((t) - 1)); MASKT(PX0, PX1, (t)); partialSM(PX0, PX1, m_reg, mnX, alX);                                        \
        __syncthreads();                                                                                                      \
        if ((t) + 1 < NT) { VMW(); if constexpr (F32) { SWRITE_VF(SB); SBAR(); if ((t) + 2 < NT) SLOAD_F((const float*)Kh, KBASE((t) + 2)); } \
                            else { SWRITE_H(SB); } }                                                                          \
        RESC(alX); __syncthreads(); } while (0)
    for (int t = 1; t + 1 < NT; t += 2) {
        HALF_STEP(pB0, pB1, mnB, alB, pA0, pA1, alA, t, 1, 0, 0);
        HALF_STEP(pA0, pA1, mnA, alA, pB0, pB1, alB, t + 1, 0, 1, 1);
    }
    const bool even = (NT & 1) == 0;
    if (even) { SBAR(); qkt<1, SK>(pB0, pB1, K_lds, r32, hi, S.qr, ACT(NT - 1)); SBAR(); }
#define QROW(e) (nxt.Q + (size_t)(wid * QBLK + r32) * D + ((e) >> 1) * 16 + hi * 8 + ((e) & 1) * 4)
    if constexpr (F32) { SLOAD_F((const float*)nxt.K, kbn); SBAR();
#pragma unroll
        for (int e = 0; e < 8; ++e) S.tq[e] = *(const f32x4*)QROW(e); }
    else { SLOAD_H(nxt.K, nxt.V, kbn); SBAR();
#pragma unroll
        for (int d0 = 0; d0 < 8; ++d0) S.qr[d0] = load8<TIn>(nxt.Q + (size_t)(wid * QBLK + r32) * D + d0 * 16 + hi * 8); }
    SBAR();
    finishSM(pA0, pA1, alA, l_reg, pa0, pa1, pa2, pa3); SBAR();
    if constexpr (F32) {
#pragma unroll
        for (int e = 8; e < 16; ++e) S.tq[e] = *(const f32x4*)QROW(e); SBAR(); }
#undef QROW
    pv_tile<0, SK>(o, vb0, pa0, pa1, pa2, pa3, ACT(even ? NT - 2 : NT - 1));
    if (even) { MASKT(pB0, pB1, NT - 1); partialSM(pB0, pB1, m_reg, mnB, alB); __syncthreads(); RESC(alB);
        finishSM(pB0, pB1, alB, l_reg, pa0, pa1, pa2, pa3); SBAR(); pv_tile<1, SK>(o, vb0, pa0, pa1, pa2, pa3, ACT(NT - 1)); }
    SBAR(); SEAM_K0();
    if (hi == 0) li_l[r32] = l_reg; asm volatile("s_waitcnt lgkmcnt(0)" ::: "memory");
    float rli[16];
#pragma unroll
    for (int r = 0; r < 16; ++r) rli[r] = __builtin_amdgcn_rcpf(li_l[crow(r, hi)]);
    TOut* Ow = cur.O + (size_t)(wid * QBLK) * D;
#pragma unroll
    for (int r = 0; r < 16; ++r) { const int orow = crow(r, hi);
#pragma unroll
        for (int d0 = 0; d0 < 4; ++d0) { const float v = o[d0][r] * rli[r];
            if constexpr (same_t<TOut, float>::v) { Ow[(size_t)orow * D + d0 * 32 + r32] = v; }
            else { const float vn = __shfl_xor(v, 1);
                   if ((r32 & 1) == 0) *(unsigned*)(Ow + (size_t)orow * D + d0 * 32 + r32) = cvtpk(v, vn); } } }
    if constexpr (F32) {
#pragma unroll
        for (int d0 = 0; d0 < 8; ++d0) S.qr[d0] = pack8(S.tq[2 * d0], S.tq[2 * d0 + 1]); }
    __syncthreads();
#undef RESC
#undef KBASE
#undef ACT
#undef MASKT
#undef SEAM_K0
#undef HALF_STEP
}
#undef ROW
#undef VMW
#undef VMWN
#undef SLOAD_H
#undef SWRITE_HK
#undef SWRITE_HV
#undef SWRITE_H
#undef SLOAD_F
#undef SWRITE_KF
#undef SWRITE_VF

}

namespace att2 {
typedef unsigned short bf16_t;
using att::bf16x8; using att::s16x4; using att::f32x16; using att::f32x4; using att::u32x4; using att::cvtpk; using att::crow; using att::v_rd_base;
constexpr int OFF_K = 0  , OFF_V = 49152  , OFF_ML = 147456, OFF_AL = 149504, LDS_END = 150528;
constexpr float SCALE = 0.08838834764831845f, THR = 1.2f, THR16 = 8.f, C2 = 1.4426950408889634f * SCALE, PSH = 7.0f;
__device__ __forceinline__ int v_st256(int k, int c) { const int kk = (k & ~0xC) | ((k & 4) << 1) | ((k & 8) >> 1); return ((kk >> 3) * 8 + (c >> 5)) * 512 + ((kk & 7) * 32 + (c & 31)) * 2; }
#define A2_TRRD(dst, addr, off) asm volatile("ds_read_b64_tr_b16 %0, %1 offset:%2" : "=&v"(dst) : "v"(addr), "i"(off) : "memory")
#define A2_PK4(P, B_, OUT) do { unsigned a0_ = cvtpk(P[B_+0], P[B_+1]), a1_ = cvtpk(P[B_+2], P[B_+3]); unsigned b0_ = cvtpk(P[B_+4], P[B_+5]), b1_ = cvtpk(P[B_+6], P[B_+7]);  \
        auto r0_ = __builtin_amdgcn_permlane32_swap(a0_, b0_, false, false); auto r1_ = __builtin_amdgcn_permlane32_swap(a1_, b1_, false, false); \
        u32x4 w_ = {r0_[0], r1_[0], r0_[1], r1_[1]}; OUT = *reinterpret_cast<bf16x8*>(&w_); } while (0)

__device__ __forceinline__ void attn_block_b16(const bf16_t* __restrict__ Qg, const bf16_t* __restrict__ Kg, const bf16_t* __restrict__ Vg, bf16_t* __restrict__ Og, int qb, char* lds) {
    int tid = threadIdx.x; asm volatile("" : "+v"(tid));
    const int wid = __builtin_amdgcn_readfirstlane(tid >> 6), lane = tid & 63, r32 = lane & 31, hi = lane >> 5;
    const int P0 = qb * 256, NT = 4 * qb + 4, qlo = P0 + 32 * wid, qm = qlo + r32 - 4 * hi, NTW = (qlo >> 6) + 1;
    char* K_lds = lds + OFF_K; char* V_lds = lds + OFF_V;
    float* Ll = (float*)(lds + OFF_ML) + wid * 32; float* al_l = (float*)(lds + OFF_AL) + wid * 32;
    typedef __attribute__((address_space(3))) unsigned lds_u32;
    const int krow = lane >> 4, kslot = lane & 15;
    unsigned koff[2];
#pragma unroll
    for (int i = 0; i < 2; ++i) { const int r = 8 * wid + 4 * i + krow; koff[i] = (unsigned)(r * 256 + ((kslot ^ (r & 7)) << 4)); }
    unsigned voff[4];
#pragma unroll
    for (int i = 0; i < 4; ++i) { const int q = 64 * i + lane, stl = q >> 5, kk = 8 * wid + ((q & 31) >> 2), jj = q & 3;
        const int k = (kk & ~0xC) | ((kk & 4) << 1) | ((kk & 8) >> 1); voff[i] = (unsigned)(k * 512 + (stl * 32 + jj * 8) * 2); }
    const lds_u32* kdst = (const lds_u32*)((__attribute__((address_space(3))) char*)K_lds + wid * 2048);
    const lds_u32* vdst = (const lds_u32*)((__attribute__((address_space(3))) char*)V_lds + wid * 4096);
#define A2_DMAK(i) __builtin_amdgcn_global_load_lds((const unsigned*)(kgn + koff[i]), (lds_u32*)((__attribute__((address_space(3))) char*)kdst + bn2 * 16384 + (i) * 1024), 16, 0, 0)
#define A2_DMAV(i) __builtin_amdgcn_global_load_lds((const unsigned*)(vgn + voff[i]), (lds_u32*)((__attribute__((address_space(3))) char*)vdst + bn2 * 32768 + (i) * 1024), 16, 0, 0)
#define A2_DMA(k0, bf) do { const char* kg_ = (const char*)(Kg + (size_t)(k0) * 128); const char* vg_ = (const char*)(Vg + (size_t)(k0) * 256);                       \
        _Pragma("unroll") for (int i = 0; i < 2; ++i) __builtin_amdgcn_global_load_lds((const unsigned*)(kg_ + koff[i]), (lds_u32*)((__attribute__((address_space(3))) char*)kdst + (bf) * 16384 + i * 1024), 16, 0, 0); \
        _Pragma("unroll") for (int i = 0; i < 4; ++i) __builtin_amdgcn_global_load_lds((const unsigned*)(vg_ + voff[i]), (lds_u32*)((__attribute__((address_space(3))) char*)vdst + (bf) * 32768 + i * 1024), 16, 0, 0); } while (0)
    bf16x8 qf[8];
#pragma unroll
    for (int d0 = 0; d0 < 8; ++d0) qf[d0] = *(const bf16x8*)(Qg + (size_t)(qlo + r32) * 128 + d0 * 16 + hi * 8);
#define A2_BAR(n) do { asm volatile("s_waitcnt vmcnt(" #n ")" ::: "memory"); asm volatile("s_waitcnt lgkmcnt(0)" ::: "memory"); __builtin_amdgcn_s_barrier(); asm volatile("" ::: "memory"); } while (0)
    A2_DMA(0, 0); A2_DMA(64, 1);
    A2_BAR(6);
    float m_reg = -1e30f, l_reg = 0.f;
    f32x16 o[8];
#pragma unroll
    for (int d = 0; d < 8; ++d) o[d] = f32x16{};
    const int vrd0 = (int)(uintptr_t)V_lds + v_rd_base(lane);
    int buf = 0;
    int t = 0;
    for (; t < NTW; ++t) {
        const int kb = t * 64; const int bn2 = buf == 0 ? 2 : buf - 1;
        const bool more = t + 2 < NT;
        const char* kgn = (const char*)(Kg + (size_t)(kb + 128) * 128); const char* vgn = (const char*)(Vg + (size_t)(kb + 128) * 256);
        __builtin_amdgcn_sched_barrier(0);
        {
        bf16x8 pa0, pa1, pa2, pa3;
        const bool mset = m_reg > -1e29f; const float a0 = mset ? -m_reg : 0.f;
        f32x16 p0, p1;
#pragma unroll
        for (int r = 0; r < 16; ++r) { p0[r] = a0; p1[r] = a0; }
        {
            const int kp = (int)(uintptr_t)K_lds + buf * 16384;
            const int kad0 = kp + KSWZ(r32, 0 + hi * 16), kad1 = kp + KSWZ(r32, 32 + hi * 16), kad2 = kp + KSWZ(r32, 64 + hi * 16), kad3 = kp + KSWZ(r32, 96 + hi * 16);
            bf16x8 ka, kb_, kc;
#define A2_KRD(AD, OFF, X0) asm volatile("ds_read_b128 %0, %1 offset:%2" : "=&v"(X0) : "v"(AD), "i"(OFF) : "memory")
#define A2_KMM(P, d0, X0) do { P = __builtin_amdgcn_mfma_f32_32x32x16_bf16(X0, qf[d0], P, 0, 0, 0); __builtin_amdgcn_sched_barrier(0); } while (0)
#define A2_KLW(n) do { asm volatile("s_waitcnt lgkmcnt(" #n ")" ::: "memory"); __builtin_amdgcn_sched_barrier(0); } while (0)
            A2_KRD(kad0, 0, ka); A2_KRD(kad1, 0, kb_); A2_KRD(kad2, 0, kc);
            A2_KLW(2); A2_KMM(p0, 0, ka); A2_KRD(kad3, 0, ka);
            A2_KLW(2); A2_KMM(p0, 1, kb_); A2_KRD(kad0, 128, kb_);
            A2_KLW(2); A2_KMM(p0, 2, kc); A2_KRD(kad1, 128, kc);
            A2_KLW(2); A2_KMM(p0, 3, ka); A2_KRD(kad2, 128, ka);
            A2_KLW(2); A2_KMM(p0, 4, kb_); A2_KRD(kad3, 128, kb_);
            A2_KLW(2); A2_KMM(p0, 5, kc); A2_KRD(kad0, 8192, kc);
            A2_KLW(2); A2_KMM(p0, 6, ka); A2_KRD(kad1, 8192, ka);
            A2_KLW(2); A2_KMM(p0, 7, kb_); A2_KRD(kad2, 8192, kb_);
            A2_KLW(2); A2_KMM(p1, 0, kc); A2_KRD(kad3, 8192, kc);
            A2_KLW(2); A2_KMM(p1, 1, ka); A2_KRD(kad0, 8320, ka);
            A2_KLW(2); A2_KMM(p1, 2, kb_); A2_KRD(kad1, 8320, kb_);
            A2_KLW(2); A2_KMM(p1, 3, kc); A2_KRD(kad2, 8320, kc);
            A2_KLW(2); A2_KMM(p1, 4, ka); A2_KRD(kad3, 8320, ka);
            A2_KLW(2); A2_KMM(p1, 5, kb_);
            A2_KLW(1); A2_KMM(p1, 6, kc);
            A2_KLW(0); A2_KMM(p1, 7, ka);
#undef A2_KRD
#undef A2_KMM
#undef A2_KLW
        }
        if (kb + 63 > qlo) {
            const int dq = qm - kb; const float NEG = -__builtin_inff();
#pragma unroll
            for (int r = 0; r < 16; ++r) { const int c = (r & 3) + 8 * (r >> 2); if (dq - c < 0) p0[r] = NEG; if (dq - c - 32 < 0) p1[r] = NEG; }
        }
        {
            float pmax = fmaxf(fmaxf(fmaxf(p0[0], p0[1]), fmaxf(p0[2], p0[3])), fmaxf(fmaxf(p0[4], p0[5]), fmaxf(p0[6], p0[7])));
            pmax = fmaxf(pmax, fmaxf(fmaxf(fmaxf(p0[8], p0[9]), fmaxf(p0[10], p0[11])), fmaxf(fmaxf(p0[12], p0[13]), fmaxf(p0[14], p0[15]))));
            float pmx1 = fmaxf(fmaxf(fmaxf(p1[0], p1[1]), fmaxf(p1[2], p1[3])), fmaxf(fmaxf(p1[4], p1[5]), fmaxf(p1[6], p1[7])));
            pmx1 = fmaxf(pmx1, fmaxf(fmaxf(fmaxf(p1[8], p1[9]), fmaxf(p1[10], p1[11])), fmaxf(fmaxf(p1[12], p1[13]), fmaxf(p1[14], p1[15]))));
            pmax = fmaxf(pmax, pmx1);
            { auto rr = __builtin_amdgcn_permlane32_swap(__float_as_uint(pmax), __float_as_uint(pmax), false, false); pmax = fmaxf(__uint_as_float(rr[0]), __uint_as_float(rr[1])); }
            float alpha = 1.f;
            if (!__builtin_expect(__all(mset && pmax <= THR16 * 1.4426950408889634f), 1)) {
                const float mn = fmaxf(m_reg, pmax - a0), dl = -a0 - mn; alpha = __builtin_amdgcn_exp2f(m_reg - mn); m_reg = mn;
#pragma unroll
                for (int r = 0; r < 16; ++r) { p0[r] += dl; p1[r] += dl; } }
#pragma unroll
            for (int r = 0; r < 16; ++r) { p0[r] = __builtin_amdgcn_exp2f(p0[r]); p1[r] = __builtin_amdgcn_exp2f(p1[r]); }
            if (__any(alpha < 1.f)) {
                if (hi == 0) al_l[r32] = alpha;
                asm volatile("s_waitcnt lgkmcnt(0)" ::: "memory");
#pragma unroll
                for (int r = 0; r < 16; ++r) { const float ar = (al_l + 4 * hi)[(r & 3) + 8 * (r >> 2)];
#pragma unroll
                    for (int d = 0; d < 8; ++d) o[d][r] *= ar; }
            }
            float ps = ((p0[0] + p0[1]) + (p0[2] + p0[3])) + ((p0[4] + p0[5]) + (p0[6] + p0[7]));
            ps += ((p0[8] + p0[9]) + (p0[10] + p0[11])) + ((p0[12] + p0[13]) + (p0[14] + p0[15]));
            float ps1 = ((p1[0] + p1[1]) + (p1[2] + p1[3])) + ((p1[4] + p1[5]) + (p1[6] + p1[7]));
            ps1 += ((p1[8] + p1[9]) + (p1[10] + p1[11])) + ((p1[12] + p1[13]) + (p1[14] + p1[15]));
            ps += ps1;
            { auto rr = __builtin_amdgcn_permlane32_swap(__float_as_uint(ps), __float_as_uint(ps), false, false); ps = __uint_as_float(rr[0]) + __uint_as_float(rr[1]); }
            l_reg = l_reg * alpha + ps;
            A2_PK4(p0, 0, pa0); A2_PK4(p0, 8, pa1); A2_PK4(p1, 0, pa2); A2_PK4(p1, 8, pa3);
        }
        {
            const int vb = vrd0 + buf * 32768;
            s16x4 a0, a1, a2, a3, b0, b1, b2, b3, c0, c1, c2, c3;
#define A2_RD(h, d0, L0, H0, L1, H1) do { A2_TRRD(L0, vb, (h) * 16384 + (d0) * 512); A2_TRRD(H0, vb, (h) * 16384 + (d0) * 512 + 4096); A2_TRRD(L1, vb, (h) * 16384 + (d0) * 512 + 8192); A2_TRRD(H1, vb, (h) * 16384 + (d0) * 512 + 12288); } while (0)
#define A2_MM(PA, PB, d0, L0, H0, L1, H1) do { o[d0] = __builtin_amdgcn_mfma_f32_32x32x16_bf16(PA, (bf16x8){L0[0], L0[1], L0[2], L0[3], H0[0], H0[1], H0[2], H0[3]}, o[d0], 0, 0, 0);   \
                                               o[d0] = __builtin_amdgcn_mfma_f32_32x32x16_bf16(PB, (bf16x8){L1[0], L1[1], L1[2], L1[3], H1[0], H1[1], H1[2], H1[3]}, o[d0], 0, 0, 0); } while (0)
#define A2_LW(n) do { asm volatile("s_waitcnt lgkmcnt(" #n ")" ::: "memory"); __builtin_amdgcn_sched_barrier(0); } while (0)
#define A2_SB __builtin_amdgcn_sched_barrier(0)
            A2_RD(0, 0, a0, a1, a2, a3); A2_RD(0, 1, b0, b1, b2, b3);
            A2_RD(0, 2, c0, c1, c2, c3); A2_LW(8); A2_MM(pa0, pa1, 0, a0, a1, a2, a3); if (more) A2_DMAK(0); A2_SB;
            A2_RD(0, 3, a0, a1, a2, a3); A2_LW(8); A2_MM(pa0, pa1, 1, b0, b1, b2, b3); if (more) A2_DMAK(1); A2_SB;
            A2_RD(0, 4, b0, b1, b2, b3); A2_LW(8); A2_MM(pa0, pa1, 2, c0, c1, c2, c3); if (more) A2_DMAV(0); A2_SB;
            A2_RD(0, 5, c0, c1, c2, c3); A2_LW(8); A2_MM(pa0, pa1, 3, a0, a1, a2, a3); if (more) A2_DMAV(1); A2_SB;
            A2_RD(0, 6, a0, a1, a2, a3); A2_LW(8); A2_MM(pa0, pa1, 4, b0, b1, b2, b3); if (more) A2_DMAV(2); A2_SB;
            A2_RD(0, 7, b0, b1, b2, b3); A2_LW(8); A2_MM(pa0, pa1, 5, c0, c1, c2, c3); if (more) A2_DMAV(3); A2_SB;
            A2_RD(1, 0, c0, c1, c2, c3); A2_LW(8); A2_MM(pa0, pa1, 6, a0, a1, a2, a3); A2_SB;
            A2_RD(1, 1, a0, a1, a2, a3); A2_LW(8); A2_MM(pa0, pa1, 7, b0, b1, b2, b3); A2_SB;
            A2_RD(1, 2, b0, b1, b2, b3); A2_LW(8); A2_MM(pa2, pa3, 0, c0, c1, c2, c3); A2_SB;
            A2_RD(1, 3, c0, c1, c2, c3); A2_LW(8); A2_MM(pa2, pa3, 1, a0, a1, a2, a3); A2_SB;
            A2_RD(1, 4, a0, a1, a2, a3); A2_LW(8); A2_MM(pa2, pa3, 2, b0, b1, b2, b3); A2_SB;
            A2_RD(1, 5, b0, b1, b2, b3); A2_LW(8); A2_MM(pa2, pa3, 3, c0, c1, c2, c3); A2_SB;
            A2_RD(1, 6, c0, c1, c2, c3); A2_LW(8); A2_MM(pa2, pa3, 4, a0, a1, a2, a3); A2_SB;
            A2_RD(1, 7, a0, a1, a2, a3); A2_LW(8); A2_MM(pa2, pa3, 5, b0, b1, b2, b3); A2_SB;
            A2_LW(4); A2_MM(pa2, pa3, 6, c0, c1, c2, c3); A2_SB;
            A2_LW(0); A2_MM(pa2, pa3, 7, a0, a1, a2, a3);
#undef A2_RD
#undef A2_MM
#undef A2_LW
#undef A2_SB
        }
        }
        __builtin_amdgcn_sched_barrier(0);
        if (t + 2 < NT) A2_BAR(6); else A2_BAR(0);
        buf = buf == 2 ? 0 : buf + 1;
    }
    for (; t < NT; ++t) {
        const int kb = t * 64; const int bn2 = buf == 0 ? 2 : buf - 1; const bool more = t + 2 < NT;
        const char* kgn = (const char*)(Kg + (size_t)(kb + 128) * 128); const char* vgn = (const char*)(Vg + (size_t)(kb + 128) * 256);
        if (more) { A2_DMAK(0); A2_DMAK(1); A2_DMAV(0); A2_DMAV(1); A2_DMAV(2); A2_DMAV(3); }
        if (t + 2 < NT) A2_BAR(6); else A2_BAR(0);
        buf = buf == 2 ? 0 : buf + 1;
    }
    if (hi == 0) Ll[r32] = l_reg;
    asm volatile("s_waitcnt lgkmcnt(0)" ::: "memory");
    int tid2 = threadIdx.x; asm volatile("" : "+v"(tid2));
    const int e32 = tid2 & 31, ehi = (tid2 >> 5) & 1;
    float f[16];
#pragma unroll
    for (int r = 0; r < 16; ++r) f[r] = __builtin_amdgcn_rcpf((Ll + 4 * ehi)[(r & 3) + 8 * (r >> 2)]);
    {
        char* ob = (char*)(Og + (size_t)(qlo + 4 * ehi) * 256 + e32);
#pragma unroll
        for (int d0 = 0; d0 < 8; ++d0)
#pragma unroll
            for (int r = 0; r < 16; ++r) { const int rc = (r & 3) + 8 * (r >> 2); const float v = o[d0][r] * f[r], vn = __shfl_xor(v, 1);
                if ((e32 & 1) == 0) *(unsigned*)(ob + (rc * 256 + 32 * d0) * 2) = cvtpk(v, vn); }
    }
    __syncthreads();
#undef A2_DMA
#undef A2_DMAK
#undef A2_DMAV
#undef A2_BAR
}
typedef int i32x8 __attribute__((ext_vector_type(8)));
typedef int i32x4_ __attribute__((ext_vector_type(4)));
__device__ __forceinline__ void attn_block(const unsigned char* __restrict__ Q8, const unsigned char* __restrict__ K8, int jsh, const unsigned char* __restrict__ V8, float vinv, bf16_t* __restrict__ Og, int qb, char* lds) {
    int tid = threadIdx.x; asm volatile("" : "+v"(tid));
    const int wid = __builtin_amdgcn_readfirstlane(tid >> 6), lane = tid & 63, r32 = lane & 31, hi = lane >> 5;
    const int P0 = qb * 256, NT = 4 * qb + 4, qlo = P0 + 32 * wid, qm = qlo + r32 - 4 * hi, NTW = (qlo >> 6) + 1;
    char* K_lds = lds + OFF_K; char* V_lds = lds + OFF_V;
    float* Ll = (float*)(lds + OFF_ML) + wid * 32; float* al_l = (float*)(lds + OFF_AL) + wid * 32;
    typedef __attribute__((address_space(3))) unsigned lds_u32;
    unsigned koff;
    { const int q = wid * 64 + lane, r = q >> 3, sl = q & 7; koff = (unsigned)(r * 128 + ((sl ^ ((r >> 1) & 7)) << 4)); }
    unsigned voff[2];
#pragma unroll
    for (int i = 0; i < 2; ++i) { const int q = (2 * wid + i) * 64 + lane, dv = q >> 2, sl = q & 3; voff[i] = (unsigned)(dv * 64 + ((sl ^ ((dv >> 2) & 3)) << 4)); }
    const lds_u32* kdst = (const lds_u32*)((__attribute__((address_space(3))) char*)K_lds + wid * 1024);
    const lds_u32* vdst = (const lds_u32*)((__attribute__((address_space(3))) char*)V_lds + wid * 2048);
#define A2_DMAK() __builtin_amdgcn_global_load_lds((const unsigned*)(kgn + koff), (lds_u32*)((__attribute__((address_space(3))) char*)kdst + bn2 * 8192), 16, 0, 0)
#define A2_DMAV(i) __builtin_amdgcn_global_load_lds((const unsigned*)(vgn + voff[i]), (lds_u32*)((__attribute__((address_space(3))) char*)vdst + bn2 * 16384 + (i) * 1024), 16, 0, 0)
#define A2_DMA(tt, bf) do { const char* kg_ = (const char*)(K8 + (size_t)(tt) * 8192); const char* vg_ = (const char*)(V8 + (size_t)(tt) * 16384);                       \
        __builtin_amdgcn_global_load_lds((const unsigned*)(kg_ + koff), (lds_u32*)((__attribute__((address_space(3))) char*)kdst + (bf) * 8192), 16, 0, 0); \
        _Pragma("unroll") for (int i = 0; i < 2; ++i) __builtin_amdgcn_global_load_lds((const unsigned*)(vg_ + voff[i]), (lds_u32*)((__attribute__((address_space(3))) char*)vdst + (bf) * 16384 + i * 1024), 16, 0, 0); } while (0)
    i32x8 qf0, qf1;
    { const i32x4_* qp = (const i32x4_*)(Q8 + (size_t)(qlo + r32) * 128 + hi * 32); const i32x4_ a = qp[0], b = qp[1], c_ = qp[4], d = qp[5];
      qf0 = (i32x8){a[0], a[1], a[2], a[3], b[0], b[1], b[2], b[3]}; qf1 = (i32x8){c_[0], c_[1], c_[2], c_[3], d[0], d[1], d[2], d[3]}; }
    const int scq = (127 - jsh) & 0xff;
#define A2_BAR(n) do { asm volatile("s_waitcnt vmcnt(" #n ")" ::: "memory"); asm volatile("s_waitcnt lgkmcnt(0)" ::: "memory"); __builtin_amdgcn_s_barrier(); asm volatile("" ::: "memory"); } while (0)
    A2_DMA(0, 0); A2_DMA(1, 1);
    A2_BAR(3);
    float m_reg = -1e30f, l_reg = 0.f;
    f32x16 a0v = f32x16{};
    f32x16 o[8];
#pragma unroll
    for (int d = 0; d < 8; ++d) o[d] = f32x16{};
    const int vrd0 = (int)(uintptr_t)V_lds + r32 * 64 + (((2 * hi) ^ ((r32 >> 2) & 3)) << 4);
    const int sc1 = 0x7f7f7f7f;
    int buf = 0;
    int t = 0;
    for (; t < NTW; ++t) {
        const int kb = t * 64; const int bn2 = buf == 0 ? 2 : buf - 1;
        const bool more = t + 2 < NT;
        const char* kgn = (const char*)(K8 + (size_t)(t + 2) * 8192); const char* vgn = (const char*)(V8 + (size_t)(t + 2) * 16384);
        __builtin_amdgcn_sched_barrier(0);
        {
        i32x8 pf;
        const bool mset = m_reg > -1e29f; const float a0 = mset ? PSH - m_reg : 0.f;
        f32x16 p0, p1;
        {
            const int ka_ = (int)(uintptr_t)K_lds + buf * 8192 + r32 * 128 + (((2 * hi) ^ ((r32 >> 1) & 7)) << 4);
            const int kb1 = ka_ ^ 16, kc0 = ka_ ^ 64, kc1 = ka_ ^ 80;
            i32x4_ x0, x1, y0, y1, z0, z1, w0, w1;
            asm volatile("ds_read_b128 %0, %1" : "=&v"(x0) : "v"(ka_) : "memory"); asm volatile("ds_read_b128 %0, %1" : "=&v"(x1) : "v"(kb1) : "memory");
            asm volatile("ds_read_b128 %0, %1" : "=&v"(y0) : "v"(kc0) : "memory"); asm volatile("ds_read_b128 %0, %1" : "=&v"(y1) : "v"(kc1) : "memory");
            asm volatile("ds_read_b128 %0, %1 offset:4096" : "=&v"(z0) : "v"(ka_) : "memory"); asm volatile("ds_read_b128 %0, %1 offset:4096" : "=&v"(z1) : "v"(kb1) : "memory");
            asm volatile("ds_read_b128 %0, %1 offset:4096" : "=&v"(w0) : "v"(kc0) : "memory"); asm volatile("ds_read_b128 %0, %1 offset:4096" : "=&v"(w1) : "v"(kc1) : "memory");
            asm volatile("s_waitcnt lgkmcnt(6)" ::: "memory"); __builtin_amdgcn_sched_barrier(0);
            p0 = __builtin_amdgcn_mfma_scale_f32_32x32x64_f8f6f4((i32x8){x0[0], x0[1], x0[2], x0[3], x1[0], x1[1], x1[2], x1[3]}, qf0, a0v, 0, 0, 0, scq, 0, sc1); __builtin_amdgcn_sched_barrier(0);
            asm volatile("s_waitcnt lgkmcnt(2)" ::: "memory"); __builtin_amdgcn_sched_barrier(0);
            p1 = __builtin_amdgcn_mfma_scale_f32_32x32x64_f8f6f4((i32x8){z0[0], z0[1], z0[2], z0[3], z1[0], z1[1], z1[2], z1[3]}, qf0, a0v, 0, 0, 0, scq, 0, sc1); __builtin_amdgcn_sched_barrier(0);
            p0 = __builtin_amdgcn_mfma_scale_f32_32x32x64_f8f6f4((i32x8){y0[0], y0[1], y0[2], y0[3], y1[0], y1[1], y1[2], y1[3]}, qf1, p0, 0, 0, 0, scq, 0, sc1); __builtin_amdgcn_sched_barrier(0);
            asm volatile("s_waitcnt lgkmcnt(0)" ::: "memory"); __builtin_amdgcn_sched_barrier(0);
            p1 = __builtin_amdgcn_mfma_scale_f32_32x32x64_f8f6f4((i32x8){w0[0], w0[1], w0[2], w0[3], w1[0], w1[1], w1[2], w1[3]}, qf1, p1, 0, 0, 0, scq, 0, sc1); asm volatile("" : "+v"(p0), "+v"(p1)); __builtin_amdgcn_sched_barrier(0);
        }
        if (kb + 63 > qlo) {
            const int dq = qm - kb; const float NEG = -__builtin_inff();
#pragma unroll
            for (int r = 0; r < 16; ++r) { const int c = (r & 3) + 8 * (r >> 2); if (dq - c < 0) p0[r] = NEG; if (dq - c - 32 < 0) p1[r] = NEG; }
        }
        {
            float pmax = fmaxf(fmaxf(fmaxf(p0[0], p0[1]), fmaxf(p0[2], p0[3])), fmaxf(fmaxf(p0[4], p0[5]), fmaxf(p0[6], p0[7])));
            pmax = fmaxf(pmax, fmaxf(fmaxf(fmaxf(p0[8], p0[9]), fmaxf(p0[10], p0[11])), fmaxf(fmaxf(p0[12], p0[13]), fmaxf(p0[14], p0[15]))));
            float pmx1 = fmaxf(fmaxf(fmaxf(p1[0], p1[1]), fmaxf(p1[2], p1[3])), fmaxf(fmaxf(p1[4], p1[5]), fmaxf(p1[6], p1[7])));
            pmx1 = fmaxf(pmx1, fmaxf(fmaxf(fmaxf(p1[8], p1[9]), fmaxf(p1[10], p1[11])), fmaxf(fmaxf(p1[12], p1[13]), fmaxf(p1[14], p1[15]))));
            pmax = fmaxf(pmax, pmx1);
            { auto rr = __builtin_amdgcn_permlane32_swap(__float_as_uint(pmax), __float_as_uint(pmax), false, false); pmax = fmaxf(__uint_as_float(rr[0]), __uint_as_float(rr[1])); }
            float alpha = 1.f;
            if (!__builtin_expect(__all(mset && pmax <= PSH + THR * 1.4426950408889634f), 1)) {
                const float mn = fmaxf(m_reg, pmax - a0), dl = (PSH - mn) - a0; alpha = __builtin_amdgcn_exp2f(m_reg - mn); m_reg = mn;
#pragma unroll
                for (int r = 0; r < 16; ++r) a0v[r] = PSH - mn;
#pragma unroll
                for (int r = 0; r < 16; ++r) { p0[r] += dl; p1[r] += dl; } }
#pragma unroll
            for (int r = 0; r < 16; ++r) { p0[r] = __builtin_amdgcn_exp2f(p0[r]); p1[r] = __builtin_amdgcn_exp2f(p1[r]); }
            if (__any(alpha < 1.f)) {
                if (hi == 0) al_l[r32] = alpha;
                asm volatile("s_waitcnt lgkmcnt(0)" ::: "memory");
#pragma unroll
                for (int r = 0; r < 16; ++r) { const float ar = (al_l + 4 * hi)[(r & 3) + 8 * (r >> 2)];
#pragma unroll
                    for (int d = 0; d < 8; ++d) o[d][r] *= ar; }
            }
            float ps = ((p0[0] + p0[1]) + (p0[2] + p0[3])) + ((p0[4] + p0[5]) + (p0[6] + p0[7]));
            ps += ((p0[8] + p0[9]) + (p0[10] + p0[11])) + ((p0[12] + p0[13]) + (p0[14] + p0[15]));
            float ps1 = ((p1[0] + p1[1]) + (p1[2] + p1[3])) + ((p1[4] + p1[5]) + (p1[6] + p1[7]));
            ps1 += ((p1[8] + p1[9]) + (p1[10] + p1[11])) + ((p1[12] + p1[13]) + (p1[14] + p1[15]));
            ps += ps1;
            { auto rr = __builtin_amdgcn_permlane32_swap(__float_as_uint(ps), __float_as_uint(ps), false, false); ps = __uint_as_float(rr[0]) + __uint_as_float(rr[1]); }
            l_reg = l_reg * alpha + ps;
#pragma unroll
            for (int i = 0; i < 4; ++i) { int w = 0; w = __builtin_amdgcn_cvt_pk_fp8_f32(p0[4 * i], p0[4 * i + 1], w, false); w = __builtin_amdgcn_cvt_pk_fp8_f32(p0[4 * i + 2], p0[4 * i + 3], w, true); pf[i] = w;
                                          int u = 0; u = __builtin_amdgcn_cvt_pk_fp8_f32(p1[4 * i], p1[4 * i + 1], u, false); u = __builtin_amdgcn_cvt_pk_fp8_f32(p1[4 * i + 2], p1[4 * i + 3], u, true); pf[4 + i] = u; }
            asm volatile("" : "+v"(pf)); __builtin_amdgcn_sched_barrier(0);
        }
        {
            const int va = vrd0 + buf * 16384, vx = va ^ 16;
            i32x4_ a0, a1, b0, b1, c0, c1;
#define A2_RD(d0, X0, X1) do { asm volatile("ds_read_b128 %0, %1 offset:%2" : "=&v"(X0) : "v"(va), "i"((d0) * 2048) : "memory"); asm volatile("ds_read_b128 %0, %1 offset:%2" : "=&v"(X1) : "v"(vx), "i"((d0) * 2048) : "memory"); } while (0)
#define A2_MM(d0, X0, X1) do { o[d0] = __builtin_amdgcn_mfma_scale_f32_32x32x64_f8f6f4(pf, (i32x8){X0[0], X0[1], X0[2], X0[3], X1[0], X1[1], X1[2], X1[3]}, o[d0], 0, 0, 0, sc1, 0, sc1); asm volatile("" : "+v"(o[d0])); } while (0)
#define A2_LW(n) do { asm volatile("s_waitcnt lgkmcnt(" #n ")" ::: "memory"); __builtin_amdgcn_sched_barrier(0); } while (0)
#define A2_SB __builtin_amdgcn_sched_barrier(0)
            A2_RD(0, a0, a1); A2_RD(1, b0, b1);
            A2_RD(2, c0, c1); A2_LW(4); A2_MM(0, a0, a1); if (more) A2_DMAK(); A2_SB;
            A2_RD(3, a0, a1); A2_LW(4); A2_MM(1, b0, b1); A2_SB;
            A2_RD(4, b0, b1); A2_LW(4); A2_MM(2, c0, c1); if (more) A2_DMAV(0); A2_SB;
            A2_RD(5, c0, c1); A2_LW(4); A2_MM(3, a0, a1); if (more) A2_DMAV(1); A2_SB;
            A2_RD(6, a0, a1); A2_LW(4); A2_MM(4, b0, b1); A2_SB;
            A2_RD(7, b0, b1); A2_LW(4); A2_MM(5, c0, c1); A2_SB;
            A2_LW(2); A2_MM(6, a0, a1); A2_SB;
            A2_LW(0); A2_MM(7, b0, b1);
#undef A2_RD
#undef A2_MM
#undef A2_LW
#undef A2_SB
        }
        }
        __builtin_amdgcn_sched_barrier(0);
        if (t + 2 < NT) A2_BAR(3); else A2_BAR(0);
        buf = buf == 2 ? 0 : buf + 1;
    }
    for (; t < NT; ++t) {
        const int kb = t * 64; const int bn2 = buf == 0 ? 2 : buf - 1; const bool more = t + 2 < NT;
        const char* kgn = (const char*)(K8 + (size_t)(t + 2) * 8192); const char* vgn = (const char*)(V8 + (size_t)(t + 2) * 16384);
        if (more) { A2_DMAK(); A2_DMAV(0); A2_DMAV(1); }
        if (t + 2 < NT) A2_BAR(3); else A2_BAR(0);
        buf = buf == 2 ? 0 : buf + 1;
    }
    if (hi == 0) Ll[r32] = l_reg;
    asm volatile("s_waitcnt lgkmcnt(0)" ::: "memory");
    int tid2 = threadIdx.x; asm volatile("" : "+v"(tid2));
    const int e32 = tid2 & 31, ehi = (tid2 >> 5) & 1;
    float f[16];
#pragma unroll
    for (int r = 0; r < 16; ++r) f[r] = vinv * __builtin_amdgcn_rcpf((Ll + 4 * ehi)[(r & 3) + 8 * (r >> 2)]);
    {
        char* ob = (char*)(Og + (size_t)(qlo + 4 * ehi) * 256 + e32);
#pragma unroll
        for (int d0 = 0; d0 < 8; ++d0)
#pragma unroll
            for (int r = 0; r < 16; ++r) { const int rc = (r & 3) + 8 * (r >> 2); const float v = o[d0][r] * f[r], vn = __shfl_xor(v, 1);
                if ((e32 & 1) == 0) *(unsigned*)(ob + (rc * 256 + 32 * d0) * 2) = cvtpk(v, vn); }
    }
    __syncthreads();
#undef A2_DMA
#undef A2_DMAK
#undef A2_DMAV
#undef A2_BAR
}
#undef A2_TRRD
#undef A2_PK4
}

constexpr int S_ = 16384, DM = 2048, NIN = 5120, AW = 1024, RW = 1024, NMEM = 256, NE = 32, TOPK = 4, DFF = 2048;
constexpr int NWAVES = 8, NTHREADS = 512;
constexpr float EPS_ = 1e-6f, DA_EPS_ = 1e-5f, LAMBDA_INIT = 0.2f;
constexpr int MPAD_TILES = 288;
#ifndef MK_N_LAUNCHES
#define MK_N_LAUNCHES 1
#endif
constexpr int N_PHASES = 16;
#ifndef MK_NCV
#define MK_NCV 0
#endif
constexpr int NCV = MK_NCV;

constexpr size_t MiB = 1u << 20;
constexpr size_t WS_CTL = 0, CTL_ZERO_BYTES = 1 * MiB;
constexpr size_t WS_SMALL = 1 * MiB;
constexpr size_t WS_LPART = WS_SMALL + 0 * MiB;
constexpr size_t WS_ACH = WS_SMALL + 1 * MiB;
constexpr size_t WS_HCH = WS_SMALL + 2 * MiB;
constexpr size_t WS_CARRY = WS_SMALL + 3 * MiB;
constexpr size_t WS_TOPE = WS_SMALL + 4 * MiB;
constexpr size_t WS_TOPG = WS_TOPE + 256 * 1024;
constexpr size_t WS_POSOF = WS_TOPG + 256 * 1024;
constexpr size_t WS_TCNT = WS_POSOF + 256 * 1024;
constexpr size_t WS_ROWGATE = WS_SMALL + 5 * MiB;
constexpr size_t WS_TILEEXP = WS_ROWGATE + 512 * 1024;
constexpr size_t WS_NRT = WS_TILEEXP + 4096;
constexpr size_t WS_WRGT = WS_SMALL + 6 * MiB;
constexpr size_t WS_MEMN = WS_SMALL + 7 * MiB;
constexpr size_t WS_KM = WS_SMALL + 8 * MiB;
constexpr size_t WS_VT = WS_SMALL + 9 * MiB;
constexpr size_t WS_SBGU = WS_SMALL + 10 * MiB;
constexpr size_t WS_SBDN = WS_SMALL + 10 * MiB + 512 * 1024;
constexpr size_t WS_SBIN = WS_SMALL + 16 * MiB;
constexpr size_t WS_SBOUT = WS_SMALL + 18 * MiB;
constexpr size_t WS_MIXSCALE = WS_SMALL + 19 * MiB;
constexpr size_t WS_SBCQ = WS_SMALL + 20 * MiB, WS_SBCO = WS_SMALL + 21 * MiB;
constexpr size_t WS_SRCTOK = WS_SMALL + 23 * MiB;
constexpr size_t WS_INSCALE = WS_SMALL + 17 * MiB;
constexpr size_t WS_ROWSCALE = WS_SMALL + 11 * MiB;
constexpr size_t WS_TOKSCALE = WS_SMALL + 12 * MiB;
constexpr size_t WS_SSQ = WS_SMALL + 13 * MiB;
constexpr size_t WS_WIN = 32 * MiB, WS_WOUT = 52 * MiB, WS_WCQ = 60 * MiB, WS_WCKV = 68 * MiB, WS_WCO = 84 * MiB;
constexpr size_t WS_WGU = 128 * MiB, WS_WDN = 640 * MiB;
constexpr size_t WS_XN = 896 * MiB;
constexpr size_t WS_Q = 960 * MiB, WS_K = 992 * MiB, WS_V = 1024 * MiB;
constexpr size_t WS_XR = 1056 * MiB, WS_XG = 1088 * MiB;
constexpr size_t WS_AO = 1120 * MiB;
constexpr size_t WS_HL = 1184 * MiB, WS_ACUM = 1248 * MiB;
constexpr size_t WS_MIX = 1312 * MiB;
constexpr size_t WS_H = 1376 * MiB;
constexpr size_t WS_QC = 1504 * MiB;
constexpr size_t WS_PC = 1568 * MiB;
constexpr size_t WS_OC = 1600 * MiB;
constexpr size_t WS_XS = 1664 * MiB, WS_ACT = 1952 * MiB, WS_YB = 2240 * MiB;
constexpr float ACT_QSCALE = 16.0f / 127.0f;
constexpr size_t WS_END = 2528 * MiB;
constexpr int CW_VMAX = 12288;
constexpr int CW_BAR = 4096;

constexpr int SCR_BYTES = 159744;
constexpr int MISC_OFF = SCR_BYTES;
constexpr int LDS_BYTES = 163840;

#define GAS __attribute__((address_space(1)))
#define LAS __attribute__((address_space(3)))
typedef unsigned short bf16_t;
typedef unsigned u32x4 __attribute__((ext_vector_type(4)));
typedef unsigned u32x2 __attribute__((ext_vector_type(2)));
typedef float f32x4 __attribute__((ext_vector_type(4)));
typedef short bf16x8 __attribute__((ext_vector_type(8)));
#define LDS_WAIT() asm volatile("s_waitcnt lgkmcnt(0)" ::: "memory")
#define VM_WAIT() asm volatile("s_waitcnt vmcnt(0)" ::: "memory")
__device__ __forceinline__ unsigned pk2(float lo, float hi) { return pg8::cvt_pk_bf16(lo, hi); }
__device__ __forceinline__ float bflo(unsigned w) { return __uint_as_float(w << 16); }
__device__ __forceinline__ float bfhi(unsigned w) { return __uint_as_float(w & 0xffff0000u); }
__device__ __forceinline__ f32x4 ld_bf16x4(const bf16_t* p) { const u32x2 w = *(const u32x2*)p; return (f32x4){bflo(w.x), bfhi(w.x), bflo(w.y), bfhi(w.y)}; }
__device__ __forceinline__ void st_bf16x4(bf16_t* p, f32x4 v) { u32x2 w; w.x = pk2(v[0], v[1]); w.y = pk2(v[2], v[3]); *(u32x2*)p = w; }
__device__ __forceinline__ float bf1(bf16_t h) { return __uint_as_float((unsigned)h << 16); }

#define XB_TMO      128
#define XB_XCNT(j)  (256  + 64 * (j))
#define XB_XSUB(j)  (1280 + 64 * (j))
#define XB_XGEN(j)  (2304 + 64 * (j))
#define XB_TOP      3328
#define XB_TOPGEN   3392
#define XCD_BAR_WORDS 3456
#define XB_SPIN_CAP (1u << 18)

__device__ __forceinline__ unsigned xb_ld(unsigned* p)              { return __hip_atomic_load(p, __ATOMIC_RELAXED, __HIP_MEMORY_SCOPE_AGENT); }
__device__ __forceinline__ unsigned xb_add(unsigned* p, unsigned v) { return __hip_atomic_fetch_add(p, v, __ATOMIC_RELAXED, __HIP_MEMORY_SCOPE_AGENT); }
__device__ __forceinline__ unsigned xb_xcc_id() { return (unsigned)__builtin_amdgcn_s_getreg((3 << 11) | 20) & 0xFu; }
#define XB_SPIN(cond, bar) do { unsigned _sp = 0; while (cond) { __builtin_amdgcn_s_sleep(1); \
    if ((++_sp & 255u) == 0u) { if (xb_ld(&(bar)[XB_TMO])) break; if (_sp > XB_SPIN_CAP) { atomicAdd(&(bar)[XB_TMO], 1u); break; } } } } while (0)

struct XcdBarrier {
    unsigned* bar; unsigned x;
    volatile LAS unsigned* st;
};
__device__ __forceinline__ XcdBarrier xcd_barrier_post(unsigned* bar, volatile LAS unsigned* st) {
    XcdBarrier b; b.bar = bar; b.x = xb_xcc_id(); b.st = st;
    if (threadIdx.x == 0) (void)xb_add(&bar[XB_XCNT(b.x)], 1u);
    return b;
}
__device__ __forceinline__ void xcd_barrier_complete(unsigned* bar, unsigned x, unsigned& nloc, unsigned& nx) {
    const unsigned G = gridDim.x * gridDim.y * gridDim.z;
    unsigned sum, cnt, mine, sp = 0u;
    for (;;) {
        sum = 0u; cnt = 0u; mine = 0u;
#pragma unroll
        for (unsigned j = 0; j < 16; ++j) { const unsigned c = xb_ld(&bar[XB_XCNT(j)]); sum += c; cnt += (c > 0u) ? 1u : 0u; mine = (j == x) ? c : mine; }
        if (sum == G) break;
        __builtin_amdgcn_s_sleep(1);
        if ((++sp & 255u) == 0u) { if (xb_ld(&bar[XB_TMO])) break; if (sp > XB_SPIN_CAP) { atomicAdd(&bar[XB_TMO], 1u); break; } }
    }
    nloc = mine > 0u ? mine : 1u; nx = cnt > 0u ? cnt : 1u;
}
__device__ __forceinline__ void xcd_barrier(const XcdBarrier& b) {
    asm volatile("s_waitcnt vmcnt(0)" ::: "memory");
    __syncthreads();
    if (threadIdx.x == 0) {
        unsigned* bar = b.bar;
        __builtin_amdgcn_s_waitcnt(0);
        unsigned nloc = b.st[0], nx = b.st[1];
        if (nloc == 0u) { xcd_barrier_complete(bar, b.x, nloc, nx); b.st[0] = nloc; b.st[1] = nx; }
        const unsigned old = xb_add(&bar[XB_XSUB(b.x)], 1u);
        const unsigned gen = old / nloc;
        if (old + 1u == (gen + 1u) * nloc) {
            __builtin_amdgcn_fence(__ATOMIC_RELEASE, "agent");
            asm volatile("s_waitcnt vmcnt(0)" ::: "memory");
            const unsigned og = xb_add(&bar[XB_TOP], 1u);
            const unsigned tg = og / nx;
            if (og + 1u == (tg + 1u) * nx) xb_add(&bar[XB_TOPGEN], 1u);
            else XB_SPIN(xb_ld(&bar[XB_TOPGEN]) == tg, bar);
            __builtin_amdgcn_fence(__ATOMIC_ACQUIRE, "agent");
            xb_add(&bar[XB_XGEN(b.x)], 1u);
            asm volatile("s_waitcnt vmcnt(0)" ::: "memory");
        } else {
            XB_SPIN(xb_ld(&bar[XB_XGEN(b.x)]) == gen, bar);
            __builtin_amdgcn_fence(__ATOMIC_ACQUIRE, "agent");
            asm volatile("s_waitcnt vmcnt(0)" ::: "memory");
        }
    }
    __syncthreads();
}

__device__ __forceinline__ float wave_sum(float v) {
#pragma unroll
    for (int o = 1; o < 64; o <<= 1) v += __shfl_xor(v, o);
    return v;
}
__device__ __forceinline__ float sigmoidf_(float x) { return __builtin_amdgcn_rcpf(1.0f + __builtin_amdgcn_exp2f(-1.4426950408889634f * x)); }
__device__ __forceinline__ float gelu_tanh(float x) { const float u = 0.7978845608028654f * (x + 0.044715f * x * x * x); return 0.5f * x * (1.0f + tanhf(u)); }

__device__ __forceinline__ void p0_transpose_item(const float* W, int K, int N, bf16_t* WT, int k0, int n0, int drow0, LAS float* scr, int lane, const float* kscale = nullptr) {
#pragma unroll 8
    for (int i = 0; i < 32; ++i) { const int kk = 2 * i + (lane >> 5); float wv = W[(size_t)(k0 + kk) * N + n0 + (lane & 31)]; if (kscale) wv *= kscale[k0 + kk]; scr[kk * 33 + (lane & 31)] = wv; }
    LDS_WAIT(); asm volatile("" ::: "memory");
    const int c = lane & 7;
#pragma unroll
    for (int j = 0; j < 4; ++j) { const int n = (lane >> 3) + 8 * j; const LAS float* s = scr + (8 * c) * 33 + n;
        u32x4 o; o.x = pk2(s[0 * 33], s[1 * 33]); o.y = pk2(s[2 * 33], s[3 * 33]); o.z = pk2(s[4 * 33], s[5 * 33]); o.w = pk2(s[6 * 33], s[7 * 33]);
        *(u32x4*)(WT + (size_t)(drow0 + n) * K + k0 + 8 * c) = o; }
    LDS_WAIT(); asm volatile("" ::: "memory");
}
__device__ __forceinline__ void rms_row_bf16(const float* xrow, const float* g, bf16_t* orow, int lane) {
    const f32x4* xr = (const f32x4*)xrow + lane; const f32x4* gr = (const f32x4*)g + lane;
    f32x4 v[8]; float s = 0.f;
#pragma unroll
    for (int j = 0; j < 8; ++j) { v[j] = xr[64 * j]; s += (v[j].x * v[j].x + v[j].y * v[j].y) + (v[j].z * v[j].z + v[j].w * v[j].w); }
    const float r = rsqrtf(wave_sum(s) * (1.f / 2048.f) + EPS_);
    u32x2* o8 = (u32x2*)orow + lane;
#pragma unroll
    for (int j = 0; j < 8; ++j) { const f32x4 gg = gr[64 * j]; u32x2 o; o.x = pk2(v[j].x * r * gg.x, v[j].y * r * gg.y); o.y = pk2(v[j].z * r * gg.z, v[j].w * r * gg.w); o8[64 * j] = o; }
}

__device__ __forceinline__ void rms_row_i8(f32x4 (&v)[8], const float* g, signed char* orow, float* scale_out, int lane) {
    const f32x4* gr = (const f32x4*)g + lane;
    float s = 0.f;
#pragma unroll
    for (int j = 0; j < 8; ++j) s += (v[j].x * v[j].x + v[j].y * v[j].y) + (v[j].z * v[j].z + v[j].w * v[j].w);
    const float r = rsqrtf(wave_sum(s) * (1.f / 2048.f) + 1e-6f);
    float am = 0.f;
#pragma unroll
    for (int j = 0; j < 8; ++j) { const f32x4 gg = gr[64 * j]; v[j].x *= r * gg.x; v[j].y *= r * gg.y; v[j].z *= r * gg.z; v[j].w *= r * gg.w;
        am = fmaxf(fmaxf(am, fmaxf(fabsf(v[j].x), fabsf(v[j].y))), fmaxf(fabsf(v[j].z), fabsf(v[j].w))); }
#pragma unroll
    for (int o = 32; o > 0; o >>= 1) am = fmaxf(am, __shfl_xor(am, o));
    const float inv = am > 0.f ? 127.0f / am : 0.f;
    unsigned* o4 = (unsigned*)orow + lane;
#pragma unroll
    for (int j = 0; j < 8; ++j) {
        const unsigned f0 = __float_as_uint(fmaf(v[j].x, inv, 12582912.0f)), f1 = __float_as_uint(fmaf(v[j].y, inv, 12582912.0f)), f2 = __float_as_uint(fmaf(v[j].z, inv, 12582912.0f)), f3 = __float_as_uint(fmaf(v[j].w, inv, 12582912.0f));
        o4[64 * j] = __builtin_amdgcn_perm(__builtin_amdgcn_perm(f3, f2, 0x0c0c0400u), __builtin_amdgcn_perm(f1, f0, 0x0c0c0400u), 0x05040100u); }
    if (lane == 0) *scale_out = am > 0.f ? am * (1.0f / 127.0f) : 1.0f;
}

struct Args { const float* in[31]; float* out; unsigned char* ws; int ph_lo, ph_hi; };
typedef const __attribute__((address_space(4))) Args CArgs;
__device__ __forceinline__ CArgs* kargs() { CArgs* p = (CArgs*)__builtin_amdgcn_kernarg_segment_ptr(); asm volatile("" : "+s"(p)); return p; }
__device__ __forceinline__ int lane_id() { int t = threadIdx.x; asm volatile("" : "+v"(t)); return t & 63; }
__device__ __forceinline__ int wave_id() { return __builtin_amdgcn_readfirstlane(threadIdx.x >> 6); }
enum { I_X = 0, I_MEM, I_NORM_MIX_G, I_W_IN, I_CONV_W, I_CONV_B, I_W_RG_A, I_B_RG_A, I_W_RG_X, I_B_RG_X, I_RG_LAMBDA, I_REC_NORM_G, I_LQ1, I_LK1, I_LQ2, I_LK2, I_SUBLN_G, I_W_OUT,
       I_NORM_CROSS_G, I_NORM_MEM_G, I_W_CQ, I_W_CKV, I_W_CO, I_NORM_FFN_G, I_W_ROUTER, I_B_ROUTER, I_W_GU, I_B_GU, I_W_DN, I_B_DN, I_NORM_FINAL_G };

__device__ __forceinline__ void convert_expert_strips(unsigned char* ws, LAS unsigned char* lds, int first, int stride) {
    asm volatile("" : "+s"(first), "+s"(stride));
    CArgs& a = *kargs(); const int wave = wave_id(), lane = lane_id();
    LAS float* CM = (LAS float*)(lds + 8 * 16384);
    const int cg = lane & 7, kl = lane >> 3, kbase = 256 * wave + 32 * kl;
    constexpr int NST_GU = 32 * 128, NST_DN = 32 * 64, NST = NST_GU + NST_DN;
    const float* wgu = a.in[I_W_GU]; const float* wdn = a.in[I_W_DN];
    unsigned H[4][16];
    f32x4 v[32];
#define CS_DECODE(st) const bool g_ = (st) < NST_GU; const int s2_ = g_ ? (st) : (st) - NST_GU; const int e_ = g_ ? (s2_ >> 7) : (s2_ >> 6), nb_ = g_ ? (s2_ & 127) : (s2_ & 63), n0_ = 32 * nb_, N_ = g_ ? 4096 : 2048
#define CS_LOAD(st) do { CS_DECODE(st); const float* p_ = (g_ ? wgu : wdn) + ((size_t)e_ * 2048 + kbase) * N_ + n0_ + 4 * cg;                                       \
        _Pragma("unroll") for (int i = 0; i < 32; ++i) v[i] = *(const f32x4*)(p_ + (size_t)i * N_); } while (0)
#define CS_PACK(par) do { f32x4 m_ = {0.f, 0.f, 0.f, 0.f};                                                                                                             \
        _Pragma("unroll") for (int i = 0; i < 32; ++i) { m_[0] = fmaxf(m_[0], fabsf(v[i][0])); m_[1] = fmaxf(m_[1], fabsf(v[i][1])); m_[2] = fmaxf(m_[2], fabsf(v[i][2])); m_[3] = fmaxf(m_[3], fabsf(v[i][3])); } \
        _Pragma("unroll") for (int c = 0; c < 4; ++c) { m_[c] = fmaxf(m_[c], __shfl_xor(m_[c], 8)); m_[c] = fmaxf(m_[c], __shfl_xor(m_[c], 16)); m_[c] = fmaxf(m_[c], __shfl_xor(m_[c], 32)); } \
        if (kl == 0) *(LAS f32x4*)(CM + (par) * 256 + wave * 32 + 4 * cg) = m_;                                                                                       \
        _Pragma("unroll") for (int c = 0; c < 4; ++c) _Pragma("unroll") for (int i = 0; i < 16; ++i) H[c][i] = pk2(v[2 * i][c], v[2 * i + 1][c]); } while (0)
#define CS_STORE(st, par) do { CS_DECODE(st); (void)n0_;                                                                                                              \
        const int j_ = n0_ & 2047, up_ = n0_ >> 11, drow0_ = (g_ ? 256 * (j_ >> 7) + 128 * up_ + (j_ & 127) : n0_) + 4 * cg;                                       \
        signed char* W8_ = (signed char*)(ws + (g_ ? WS_WGU : WS_WDN)); float* SB_ = (float*)(ws + (g_ ? WS_SBGU : WS_SBDN));                                        \
        f32x4 cm_ = *(const LAS f32x4*)(CM + (par) * 256 + 4 * cg);                                                                                                   \
        _Pragma("unroll") for (int w = 1; w < 8; ++w) { const f32x4 o_ = *(const LAS f32x4*)(CM + (par) * 256 + w * 32 + 4 * cg); cm_[0] = fmaxf(cm_[0], o_[0]); cm_[1] = fmaxf(cm_[1], o_[1]); cm_[2] = fmaxf(cm_[2], o_[2]); cm_[3] = fmaxf(cm_[3], o_[3]); } \
        _Pragma("unroll") for (int c = 0; c < 4; ++c) { const float inv_ = cm_[c] > 0.f ? 127.0f / cm_[c] : 0.f;                                                         \
            u32x4* dst_ = (u32x4*)(W8_ + ((size_t)e_ * N_ + drow0_ + c) * 2048 + kbase);                                                                              \
            _Pragma("unroll") for (int q = 0; q < 2; ++q) { u32x4 o_;                                                                                                 \
                _Pragma("unroll") for (int d = 0; d < 4; ++d) { const unsigned h0_ = H[c][8 * q + 2 * d], h1_ = H[c][8 * q + 2 * d + 1];                                \
                    const unsigned f0_ = __float_as_uint(fmaf(bflo(h0_), inv_, 12582912.0f)), f1_ = __float_as_uint(fmaf(bfhi(h0_), inv_, 12582912.0f));                \
                    const unsigned f2_ = __float_as_uint(fmaf(bflo(h1_), inv_, 12582912.0f)), f3_ = __float_as_uint(fmaf(bfhi(h1_), inv_, 12582912.0f));                \
                    o_[d] = __builtin_amdgcn_perm(__builtin_amdgcn_perm(f3_, f2_, 0x0c0c0400u), __builtin_amdgcn_perm(f1_, f0_, 0x0c0c0400u), 0x05040100u); }           \
                dst_[q] = o_; }                                                                                                                                       \
            if (wave == 0 && kl == 0) SB_[(size_t)e_ * N_ + drow0_ + c] = cm_[c] > 0.f ? cm_[c] * (1.0f / 127.0f) : 1.0f; } } while (0)
    int st = first, par = 0;
    if (st < NST) { CS_LOAD(st); CS_PACK(0); }
    while (st < NST) {
        const int sn = st + stride;
        if (sn < NST) CS_LOAD(sn);
        __builtin_amdgcn_sched_barrier(0);
        __syncthreads();
        CS_STORE(st, par);
        __builtin_amdgcn_sched_barrier(0);
        if (sn < NST) CS_PACK(par ^ 1);
        st = sn; par ^= 1;
    }
    __syncthreads();
#undef CS_DECODE
#undef CS_LOAD
#undef CS_PACK
#undef CS_STORE
}

template <bool F8 = false>
__device__ __forceinline__ void convert_strips_i8(const float* win, int N, signed char* dst8, float* sbo, LAS unsigned char* lds, int first, int stride, const float* kscale = nullptr) {
    const int wave = wave_id(), lane = lane_id();
    LAS float* CM = (LAS float*)(lds + 8 * 16384);
    const int cg = lane & 7, kl = lane >> 3, kbase = 256 * wave + 32 * kl;
    for (int st = first; st < N / 32; st += stride) {
        const int n0 = 32 * st; const float* p_ = win + (size_t)kbase * N + n0 + 4 * cg;
        f32x4 v[32]; f32x4 m_ = {0.f, 0.f, 0.f, 0.f};
#pragma unroll
        for (int i = 0; i < 32; ++i) v[i] = *(const f32x4*)(p_ + (size_t)i * N);
        if (kscale) {
#pragma unroll
            for (int i = 0; i < 32; ++i) v[i] *= kscale[kbase + i]; }
#pragma unroll
        for (int i = 0; i < 32; ++i) { m_[0] = fmaxf(m_[0], fabsf(v[i][0])); m_[1] = fmaxf(m_[1], fabsf(v[i][1])); m_[2] = fmaxf(m_[2], fabsf(v[i][2])); m_[3] = fmaxf(m_[3], fabsf(v[i][3])); }
#pragma unroll
        for (int c = 0; c < 4; ++c) { m_[c] = fmaxf(m_[c], __shfl_xor(m_[c], 8)); m_[c] = fmaxf(m_[c], __shfl_xor(m_[c], 16)); m_[c] = fmaxf(m_[c], __shfl_xor(m_[c], 32)); }
        if (kl == 0) *(LAS f32x4*)(CM + wave * 32 + 4 * cg) = m_;
        __syncthreads();
        f32x4 cm_ = *(const LAS f32x4*)(CM + 4 * cg);
#pragma unroll
        for (int w = 1; w < 8; ++w) { const f32x4 o_ = *(const LAS f32x4*)(CM + w * 32 + 4 * cg); cm_[0] = fmaxf(cm_[0], o_[0]); cm_[1] = fmaxf(cm_[1], o_[1]); cm_[2] = fmaxf(cm_[2], o_[2]); cm_[3] = fmaxf(cm_[3], o_[3]); }
#pragma unroll
        for (int c = 0; c < 4; ++c) { constexpr float QMAX = F8 ? 240.0f : 127.0f; const float inv_ = cm_[c] > 0.f ? QMAX / cm_[c] : 0.f;
            u32x4* dst_ = (u32x4*)(dst8 + (size_t)(n0 + 4 * cg + c) * 2048 + kbase);
#pragma unroll
            for (int q = 0; q < 2; ++q) { u32x4 o_;
#pragma unroll
                for (int d = 0; d < 4; ++d) { const int i0 = 16 * q + 4 * d;
                    if constexpr (F8) { unsigned w_ = 0; w_ = __builtin_amdgcn_cvt_pk_fp8_f32(v[i0][c] * inv_, v[i0 + 1][c] * inv_, w_, false); w_ = __builtin_amdgcn_cvt_pk_fp8_f32(v[i0 + 2][c] * inv_, v[i0 + 3][c] * inv_, w_, true); o_[d] = w_; continue; }
                    const unsigned f0_ = __float_as_uint(fmaf(v[i0][c], inv_, 12582912.0f)), f1_ = __float_as_uint(fmaf(v[i0 + 1][c], inv_, 12582912.0f));
                    const unsigned f2_ = __float_as_uint(fmaf(v[i0 + 2][c], inv_, 12582912.0f)), f3_ = __float_as_uint(fmaf(v[i0 + 3][c], inv_, 12582912.0f));
                    o_[d] = __builtin_amdgcn_perm(__builtin_amdgcn_perm(f3_, f2_, 0x0c0c0400u), __builtin_amdgcn_perm(f1_, f0_, 0x0c0c0400u), 0x05040100u); }
                dst_[q] = o_; }
            if (wave == 0 && kl == 0) sbo[n0 + 4 * cg + c] = cm_[c] > 0.f ? cm_[c] * (1.0f / QMAX) : 1.0f; }
        __syncthreads();
    }
}

__device__ __forceinline__ void convert_late_weights(unsigned char* ws, LAS unsigned char* lds, int G);
__device__ __forceinline__ void p0_prologue(unsigned char* ws, LAS unsigned char* lds, int G) {
    CArgs& a = *kargs(); const int wave = wave_id(), lane = lane_id();
    LAS float* scr = (LAS float*)(lds + wave * 16384);
    const int gw = blockIdx.x * NWAVES + wave, NGW = G * NWAVES;
    constexpr int I_IN = 32 * 160, I_SQ = 32 * 64, I_KV = 32 * 128, I_GU = 32 * 32 * 128, I_DN = 32 * 32 * 64, I_RG = 128;
    constexpr int NITEMS = I_IN + 3 * I_SQ + I_KV + I_GU + I_DN + I_RG;
    const bool late_here = (G != 256);
    if (late_here) convert_expert_strips(ws, lds, blockIdx.x, G);
    if (late_here) convert_late_weights(ws, lds, G);
    convert_strips_i8(a.in[I_W_IN], 5120, (signed char*)(ws + WS_WIN), (float*)(ws + WS_SBIN), lds, blockIdx.x, G);
    for (int it = gw + I_GU + I_DN; it < NITEMS; it += NGW) {
        int r = it - I_GU - I_DN;
        if (r < I_IN) continue; r -= I_IN;
        if (r < I_SQ) continue; r -= I_SQ;
        if (r < I_SQ) continue; r -= I_SQ;
        if (r < I_KV) { const int kb = r >> 7, nb = r & 127; p0_transpose_item(a.in[I_W_CKV], 2048, 4096, (bf16_t*)(ws + WS_WCKV), 64 * kb, 32 * nb, 32 * nb, scr, lane); continue; } r -= I_KV;
        if (r < I_SQ) continue; r -= I_SQ;
        { const int mat = r >> 6, n = (r >> 3) & 7, sub = r & 7, kb = sub >> 2, nb = sub & 3;
          p0_transpose_item((mat ? a.in[I_W_RG_X] : a.in[I_W_RG_A]) + n * 16384, 128, 128, (bf16_t*)(ws + WS_WRGT) + (mat * 8 + n) * 16384, 64 * kb, 32 * nb, 32 * nb, scr, lane); }
    }
    for (int m = gw; m < S_; m += 2 * NGW) { const int m1 = m + NGW; const bool two = m1 < S_;
        f32x4 va[8], vb[8]; const f32x4* xa = (const f32x4*)(a.in[I_X] + (size_t)m * DM) + lane; const f32x4* xb = (const f32x4*)(a.in[I_X] + (size_t)(two ? m1 : m) * DM) + lane;
#pragma unroll
        for (int j = 0; j < 8; ++j) { va[j] = xa[64 * j]; vb[j] = xb[64 * j]; }
        rms_row_i8(va, a.in[I_NORM_MIX_G], (signed char*)(ws + WS_XN) + (size_t)m * DM, (float*)(ws + WS_INSCALE) + m, lane);
        if (two) rms_row_i8(vb, a.in[I_NORM_MIX_G], (signed char*)(ws + WS_XN) + (size_t)m1 * DM, (float*)(ws + WS_INSCALE) + m1, lane); }
    for (int m = gw; m < NMEM; m += NGW) rms_row_bf16(a.in[I_MEM] + (size_t)m * DM, a.in[I_NORM_MEM_G], (bf16_t*)(ws + WS_MEMN) + (size_t)m * DM, lane);
}

__device__ __forceinline__ void store_bf16_tile(const f32x4 (&acc)[2][2][4][2], bf16_t* b0, bf16_t* b1, size_t pitch, float sc, int wr, int wc, int fr, int fq, float sc0 = 1.f) {
    const int r0 = wr * 64 + fr, cc = wc * 32 + 8 * fq;
#pragma unroll
    for (int ai = 0; ai < 2; ++ai)
#pragma unroll
        for (int m = 0; m < 4; ++m) { const size_t ro = (size_t)(r0 + ai * 128 + m * 16) * pitch + cc;
#pragma unroll
            for (int bj = 0; bj < 2; ++bj) { const float sb = bj ? sc : sc * sc0; const f32x4 v0 = acc[ai][bj][m][0] * sb, v1 = acc[ai][bj][m][1] * sb;
                u32x4 w; w.x = pk2(v0[0], v0[1]); w.y = pk2(v0[2], v0[3]); w.z = pk2(v1[0], v1[1]); w.w = pk2(v1[2], v1[3]);
                *(u32x4*)((bj ? b1 : b0) + ro) = w; } }
}
struct EpiInProj {
    static constexpr bool PERM = true;
    bf16_t *Q, *XR; unsigned* vmax;
    __device__ __forceinline__ void operator()(const f32x4 (&acc)[2][2][4][2], const pg8::Unit& u, int wr, int wc, int fr, int fq) const {
        const int pn = u.pn; bf16_t *b0, *b1; size_t pitch;
        if (pn < 12) {
            float m = 0.f;
#pragma unroll
            for (int ai = 0; ai < 2; ++ai)
#pragma unroll
                for (int bj = 0; bj < 2; ++bj)
#pragma unroll
                    for (int mm = 0; mm < 4; ++mm)
#pragma unroll
                        for (int n = 0; n < 2; ++n) { if (bj == 0 && pn < 8) continue; const f32x4 v = acc[ai][bj][mm][n]; m = fmaxf(fmaxf(m, fmaxf(fabsf(v[0]), fabsf(v[1]))), fmaxf(fabsf(v[2]), fabsf(v[3]))); }
#pragma unroll
            for (int o = 32; o > 0; o >>= 1) m = fmaxf(m, __shfl_xor(m, o));
            if ((threadIdx.x & 63) == 0) atomicMax(vmax + (pn < 8 ? 4 + 4 * (pn >> 2) : 0) + (pn & 3), __float_as_uint(m * 1.00390625f));
        }
        if (pn < 8) { bf16_t* T = Q + (size_t)(pn >> 2) * ((WS_K - WS_Q) / 2); const int hh = pn & 3; pitch = 128;
            b0 = T + ((size_t)(hh * 2 + 0) * S_ + (size_t)u.pm * 256) * 128; b1 = T + ((size_t)(hh * 2 + 1) * S_ + (size_t)u.pm * 256) * 128; }
        else if (pn < 12) { bf16_t* T = Q + (size_t)2 * ((WS_K - WS_Q) / 2); const int hh = pn & 3; pitch = 256;
            b0 = T + ((size_t)hh * S_ + (size_t)u.pm * 256) * 256; b1 = b0 + 128; }
        else { bf16_t* T = XR + (size_t)((pn - 12) >> 2) * ((WS_XG - WS_XR) / 2) + (pn & 3) * 256; pitch = 1024; b0 = T + (size_t)u.pm * 256 * 1024; b1 = b0 + 128; }
        store_bf16_tile(acc, b0, b1, pitch, 1.f, wr, wc, fr, fq, pn < 4 ? 0.12751743f   : 1.f);
    }
};
struct EpiInProjI8 {
    static constexpr bool PERM = true;
    EpiInProj base; const float* rowscale; const float* colscale;
    __device__ __forceinline__ void operator()(const pg8::i32x4 (&acc)[2][2][4][2], const pg8::Unit& u, int wr, int wc, int fr, int fq) const {
        f32x4 f[2][2][4][2];
        const float* rs = rowscale + (size_t)u.pm * 256 + wr * 64 + fr; const float* cs = colscale + (size_t)u.pn * 256 + wc * 32 + 8 * fq;
        f32x4 c4[2][2];
#pragma unroll
        for (int bj = 0; bj < 2; ++bj)
#pragma unroll
            for (int n = 0; n < 2; ++n) c4[bj][n] = *(const f32x4*)(cs + 128 * bj + 4 * n);
#pragma unroll
        for (int ai = 0; ai < 2; ++ai)
#pragma unroll
            for (int m = 0; m < 4; ++m) { const float r = rs[ai * 128 + m * 16];
#pragma unroll
                for (int bj = 0; bj < 2; ++bj)
#pragma unroll
                    for (int n = 0; n < 2; ++n) { const pg8::i32x4 a = acc[ai][bj][m][n]; const f32x4 c = c4[bj][n];
                        f[ai][bj][m][n] = (f32x4){(float)a[0] * (r * c[0]), (float)a[1] * (r * c[1]), (float)a[2] * (r * c[2]), (float)a[3] * (r * c[3])}; } }
        base(f, u, wr, wc, fr, fq);
    }
};
struct EpiSmall {
    static constexpr bool PERM = true;
    bf16_t *KM, *VT;
    __device__ __forceinline__ void operator()(const f32x4 (&acc)[2][2][4][2], const pg8::Unit& u, int wr, int wc, int fr, int fq) const {
        if (u.e == 0) { bf16_t* b0 = KM + u.pn * 256; store_bf16_tile(acc, b0, b0 + 128, 2048, 1.f, wr, wc, fr, fq); }
        else { bf16_t* b0 = VT + (size_t)u.pm * 256 * 256; store_bf16_tile(acc, b0, b0 + 128, 256, 1.f, wr, wc, fr, fq); }
    }
};
struct SmallOrder {
    const char* memn; const char* wckv; int c;
    __device__ __forceinline__ bool next(int i, pg8::Unit& u) const {
        if (i > 0 || c >= 16) return false;
        const int idx = c & 7; u.e = c >> 3;
        if (u.e == 0) { u.pm = 0; u.pn = idx; u.A = memn; u.B = wckv + (size_t)idx * 256 * 2048 * 2; }
        else { u.pm = idx; u.pn = 0; u.A = wckv + (size_t)(2048 + idx * 256) * 2048 * 2; u.B = memn; }
        return true;
    }
};
struct EpiBf16Plain {
    static constexpr bool PERM = true;
    bf16_t* O; int ldc;
    __device__ __forceinline__ void operator()(const f32x4 (&acc)[2][2][4][2], const pg8::Unit& u, int wr, int wc, int fr, int fq) const {
        bf16_t* b0 = O + (size_t)u.pm * 256 * ldc + u.pn * 256; store_bf16_tile(acc, b0, b0 + 128, (size_t)ldc, 1.f, wr, wc, fr, fq);
    }
};
struct EpiResF32 {
    static constexpr bool PERM = false;
    const bf16_t* res; bf16_t* out; const float* cs; float mul;
    __device__ __forceinline__ void operator()(const f32x4 (&acc)[2][2][4][2], const pg8::Unit& u, int wr, int wc, int fr, int fq) const {
        const int row0 = u.pm * 256 + wr * 64 + fr, col0 = u.pn * 256 + wc * 32 + 4 * fq;
#pragma unroll
        for (int ai = 0; ai < 2; ++ai)
#pragma unroll
            for (int m = 0; m < 4; ++m) { const size_t ro = (size_t)(row0 + ai * 128 + m * 16) * DM + col0;
#pragma unroll
                for (int bj = 0; bj < 2; ++bj)
#pragma unroll
                    for (int n = 0; n < 2; ++n) { const size_t p = ro + bj * 128 + 16 * n; const f32x4 r = ld_bf16x4(res + p); const f32x4 c4 = *(const f32x4*)(cs + col0 + bj * 128 + 16 * n) * mul; st_bf16x4(out + p, r + acc[ai][bj][m][n] * c4); } }
    }
};
struct EpiResNormF32 {
    static constexpr bool PERM = false;
    const float* res; bf16_t* out; unsigned char* HB; float* SSQ;
    __device__ __forceinline__ void operator()(const f32x4 (&acc)[2][2][4][2], const pg8::Unit& u, int wr, int wc, int fr, int fq) const {
        const int row0 = u.pm * 256 + wr * 64 + fr, col0 = u.pn * 256 + wc * 32 + 4 * fq;
#pragma unroll
        for (int ai = 0; ai < 2; ++ai)
#pragma unroll
            for (int m = 0; m < 4; ++m) { const int row = row0 + ai * 128 + m * 16; const size_t ro = (size_t)row * DM + col0; float ss = 0.f;
#pragma unroll
                for (int bj = 0; bj < 2; ++bj)
#pragma unroll
                    for (int n = 0; n < 2; ++n) { const size_t p = ro + bj * 128 + 16 * n; const f32x4 v = *(const f32x4*)(res + p) + acc[ai][bj][m][n]; st_bf16x4(out + p, v);
                        { const f32x4 q = {__builtin_amdgcn_fmed3f(v[0], -448.f, 448.f), __builtin_amdgcn_fmed3f(v[1], -448.f, 448.f), __builtin_amdgcn_fmed3f(v[2], -448.f, 448.f), __builtin_amdgcn_fmed3f(v[3], -448.f, 448.f)};
                          unsigned hb = 0; hb = __builtin_amdgcn_cvt_pk_fp8_f32(q[0], q[1], hb, false); hb = __builtin_amdgcn_cvt_pk_fp8_f32(q[2], q[3], hb, true); *(unsigned*)(HB + p) = hb; } ss += (v[0] * v[0] + v[1] * v[1]) + (v[2] * v[2] + v[3] * v[3]); }
                ss += __shfl_xor(ss, 16); ss += __shfl_xor(ss, 32);
                if (fq == 0) SSQ[(size_t)row * 32 + u.pn * 4 + wc] = ss; }
    }
};
struct EpiResNormI8 {
    static constexpr bool PERM = false;
    EpiResNormF32 base; const float* rowscale; const float* colscale;
    __device__ __forceinline__ void operator()(const pg8::i32x4 (&acc)[2][2][4][2], const pg8::Unit& u, int wr, int wc, int fr, int fq) const {
        f32x4 f[2][2][4][2];
        const float* rs = rowscale + (size_t)u.pm * 256 + wr * 64 + fr; const float* cs = colscale + (size_t)u.pn * 256 + wc * 32 + 4 * fq;
        f32x4 c4[2][2];
#pragma unroll
        for (int bj = 0; bj < 2; ++bj)
#pragma unroll
            for (int n = 0; n < 2; ++n) c4[bj][n] = *(const f32x4*)(cs + 128 * bj + 16 * n);
#pragma unroll
        for (int ai = 0; ai < 2; ++ai)
#pragma unroll
            for (int m = 0; m < 4; ++m) { const float r = rs[ai * 128 + m * 16];
#pragma unroll
                for (int bj = 0; bj < 2; ++bj)
#pragma unroll
                    for (int n = 0; n < 2; ++n) { const pg8::i32x4 a = acc[ai][bj][m][n]; const f32x4 c = c4[bj][n];
                        f[ai][bj][m][n] = (f32x4){(float)a[0] * (r * c[0]), (float)a[1] * (r * c[1]), (float)a[2] * (r * c[2]), (float)a[3] * (r * c[3])}; } }
        base(f, u, wr, wc, fr, fq);
    }
};
struct EpiBf16RowScale {
    static constexpr bool PERM = true;
    bf16_t* O; int ldc; const LAS float* rl; const float* cs;
    __device__ __forceinline__ void operator()(const f32x4 (&acc)[2][2][4][2], const pg8::Unit& u, int wr, int wc, int fr, int fq) const {
        bf16_t* b0 = O + (size_t)u.pm * 256 * ldc + u.pn * 256; const int r0 = wr * 64 + fr, cc = wc * 32 + 8 * fq;
#pragma unroll
        for (int ai = 0; ai < 2; ++ai)
#pragma unroll
            for (int m = 0; m < 4; ++m) { const int r = r0 + ai * 128 + m * 16; const float sc = rl[u.e * 256 + r]; const size_t ro = (size_t)r * ldc + cc;
#pragma unroll
                for (int bj = 0; bj < 2; ++bj) { const f32x4 c0 = *(const f32x4*)(cs + u.pn * 256 + bj * 128 + cc), c1 = *(const f32x4*)(cs + u.pn * 256 + bj * 128 + cc + 4); const f32x4 v0 = acc[ai][bj][m][0] * sc * c0, v1 = acc[ai][bj][m][1] * sc * c1;
                    u32x4 w; w.x = pk2(v0[0], v0[1]); w.y = pk2(v0[2], v0[3]); w.z = pk2(v1[0], v1[1]); w.w = pk2(v1[2], v1[3]);
                    *(u32x4*)(b0 + ro + bj * 128) = w; } }
    }
};
struct HeadOrderS {
    const char* QC; const char* KM; int G, c;
    __device__ __forceinline__ bool next(int i, pg8::Unit& u) const {
        const int L = i * G + c; if (L >= 256) return false;
        u.e = L & 3; u.pm = L >> 2; u.pn = 0; u.A = QC + ((size_t)u.pm * 256 * 2048 + u.e * 512) * 2; u.B = KM + (size_t)u.e * 512 * 2; return true;
    }
};
struct EpiScore {
    static constexpr bool PERM = true;
    bf16_t* PC; float* LPART;
    __device__ __forceinline__ void operator()(const f32x4 (&acc)[2][2][4][2], const pg8::Unit& u, int wr, int wc, int fr, int fq) const {
        constexpr float C2 = 1.4426950408889634f * 0.044194173824159216f;
        const int r0 = u.pm * 256 + wr * 64 + fr, cc = u.e * 256 + wc * 32 + 8 * fq;
#pragma unroll
        for (int ai = 0; ai < 2; ++ai)
#pragma unroll
            for (int m = 0; m < 4; ++m) { const int row = r0 + ai * 128 + m * 16; float ps = 0.f;
#pragma unroll
                for (int bj = 0; bj < 2; ++bj) { f32x4 v0 = acc[ai][bj][m][0], v1 = acc[ai][bj][m][1];
#pragma unroll
                    for (int i = 0; i < 4; ++i) { v0[i] = __builtin_amdgcn_exp2f(v0[i] * C2); v1[i] = __builtin_amdgcn_exp2f(v1[i] * C2); }
                    u32x4 w; w.x = pk2(v0[0], v0[1]); w.y = pk2(v0[2], v0[3]); w.z = pk2(v1[0], v1[1]); w.w = pk2(v1[2], v1[3]);
                    ps += (bflo(w.x) + bfhi(w.x)) + (bflo(w.y) + bfhi(w.y)) + (bflo(w.z) + bfhi(w.z)) + (bflo(w.w) + bfhi(w.w));
                    *(u32x4*)(PC + (size_t)row * 1024 + cc + bj * 128) = w; }
                ps += __shfl_xor(ps, 16); ps += __shfl_xor(ps, 32);
                if (fq == 0) LPART[((size_t)row * 4 + u.e) * 4 + wc] = ps; }
    }
};
struct HeadOrderO {
    const char* PC; const char* VT; int G, c;
    __device__ __forceinline__ bool next(int i, pg8::Unit& u) const {
        int L = i * G + c; if (L >= 512) return false;
        if (G == 256) L = 8 * (c >> 2) + 4 * i + (c & 3);
        u.e = L & 3; u.pn = (L >> 2) & 1; u.pm = L >> 3; u.A = PC + ((size_t)u.pm * 256 * 1024 + u.e * 256) * 2; u.B = VT + ((size_t)(u.e * 512 + u.pn * 256) * 256) * 2; return true;
    }
};
struct EpiCrossO {
    static constexpr bool PERM = true;
    unsigned char* OC; const float* LPART;
    __device__ __forceinline__ void operator()(const f32x4 (&acc)[2][2][4][2], const pg8::Unit& u, int wr, int wc, int fr, int fq) const {
        const int r0 = u.pm * 256 + wr * 64 + fr, cc = u.e * 512 + u.pn * 256 + wc * 32 + 8 * fq;
#pragma unroll
        for (int ai = 0; ai < 2; ++ai)
#pragma unroll
            for (int m = 0; m < 4; ++m) { const int row = r0 + ai * 128 + m * 16; const f32x4 lp = *(const f32x4*)(LPART + ((size_t)row * 4 + u.e) * 4);
                const float inv = 16.0f * __builtin_amdgcn_rcpf((lp[0] + lp[1]) + (lp[2] + lp[3]));
#pragma unroll
                for (int bj = 0; bj < 2; ++bj) { f32x4 v0 = acc[ai][bj][m][0] * inv, v1 = acc[ai][bj][m][1] * inv;
#pragma unroll
                    for (int i = 0; i < 4; ++i) { v0[i] = __builtin_amdgcn_fmed3f(v0[i], -448.f, 448.f); v1[i] = __builtin_amdgcn_fmed3f(v1[i], -448.f, 448.f); }
                    u32x2 w; w.x = 0; w.y = 0;
                    w.x = __builtin_amdgcn_cvt_pk_fp8_f32(v0[0], v0[1], w.x, false); w.x = __builtin_amdgcn_cvt_pk_fp8_f32(v0[2], v0[3], w.x, true);
                    w.y = __builtin_amdgcn_cvt_pk_fp8_f32(v1[0], v1[1], w.y, false); w.y = __builtin_amdgcn_cvt_pk_fp8_f32(v1[2], v1[3], w.y, true);
                    *(u32x2*)(OC + (size_t)row * 2048 + cc + bj * 128) = w; } }
    }
};
struct GroupOrder {
    const char* A; const char* W; const int* texp; size_t wstride, tstride; int nrt, NT, G, c;
    __device__ __forceinline__ bool next(int i, pg8::Unit& u) const {
        const int L = i * G + c; if (L >= nrt * NT) return false;
        const int rt = L / NT; u.pm = rt; u.pn = L - rt * NT; u.e = texp[rt];
        u.A = A + (size_t)rt * tstride; u.B = W + (size_t)u.e * wstride + (size_t)u.pn * tstride; return true;
    }
};
struct GroupOrderG {
    const char* A; const char* W; const int* texp; const int* rows; size_t wstride, tstride; int nrt, NT, G, c;
    __device__ __forceinline__ bool next(int i, pg8::Unit& u) const {
        const int L = i * G + c; if (L >= nrt * NT) return false;
        const int rt = L / NT; u.pm = rt; u.pn = L - rt * NT; u.e = texp[rt];
        u.A = A; u.B = W + (size_t)u.e * wstride + (size_t)u.pn * tstride; return true;
    }
};
struct EpiGateUp {
    static constexpr bool PERM = true;
    bf16_t* ACT; const float* bgu;
    __device__ __forceinline__ void operator()(const f32x4 (&acc)[2][2][4][2], const pg8::Unit& u, int wr, int wc, int fr, int fq) const {
        const int r0 = u.pm * 256 + wr * 64 + fr, j0 = u.pn * 128 + wc * 32 + 8 * fq;
        const float* bg = bgu + (size_t)u.e * 4096 + j0; float g8[8], u8[8];
#pragma unroll
        for (int i = 0; i < 8; ++i) { g8[i] = bg[i]; u8[i] = bg[2048 + i]; }
#pragma unroll
        for (int ai = 0; ai < 2; ++ai)
#pragma unroll
            for (int m = 0; m < 4; ++m) { const int row = r0 + ai * 128 + m * 16; float o[8];
#pragma unroll
                for (int i = 0; i < 8; ++i) { float gt = acc[ai][0][m][i >> 2][i & 3] + g8[i], up = acc[ai][1][m][i >> 2][i & 3] + u8[i];
                    gt = fminf(gt, 7.0f); up = fminf(fmaxf(up, -7.0f), 7.0f);
                    o[i] = (up + 1.0f) * gt * sigmoidf_(1.702f * gt); }
                u32x4 w; w.x = pk2(o[0], o[1]); w.y = pk2(o[2], o[3]); w.z = pk2(o[4], o[5]); w.w = pk2(o[6], o[7]);
                *(u32x4*)(ACT + (size_t)row * 2048 + j0) = w; }
    }
};
struct EpiGateUpI8 {
    static constexpr bool PERM = true;
    signed char* ACT; const float* bgu; const float* rowscale; const float* sb;
    __device__ __forceinline__ void operator()(const pg8::i32x4 (&acc)[2][2][4][2], const pg8::Unit& u, int wr, int wc, int fr, int fq) const {
        const int r0 = u.pm * 256 + wr * 64 + fr, cw = wc * 32 + 8 * fq, j0 = u.pn * 128 + cw;
        const float* bg = bgu + (size_t)u.e * 4096 + j0; const float* sp = sb + (size_t)u.e * 4096 + u.pn * 256 + cw; float g8[8], u8[8], sg8[8], su8[8];
#pragma unroll
        for (int i = 0; i < 8; ++i) { g8[i] = bg[i]; u8[i] = bg[2048 + i]; sg8[i] = sp[i]; su8[i] = sp[128 + i]; }
#pragma unroll
        for (int ai = 0; ai < 2; ++ai)
#pragma unroll
            for (int m = 0; m < 4; ++m) { const int row = r0 + ai * 128 + m * 16; const float rs = rowscale[row]; float o[8];
#pragma unroll
                for (int i = 0; i < 8; ++i) { float gt = (float)acc[ai][0][m][i >> 2][i & 3] * (rs * sg8[i]) + g8[i], up = (float)acc[ai][1][m][i >> 2][i & 3] * (rs * su8[i]) + u8[i];
                    gt = fminf(gt, 7.0f); up = fminf(fmaxf(up, -7.0f), 7.0f);
                    o[i] = (up + 1.0f) * gt * sigmoidf_(1.702f * gt); }
                unsigned q[8];
#pragma unroll
                for (int i = 0; i < 8; ++i) q[i] = (unsigned)(int)rintf(fminf(fmaxf(o[i] * (1.0f / ACT_QSCALE), -127.0f), 127.0f)) & 0xffu;
                u32x2 w; w.x = q[0] | (q[1] << 8) | (q[2] << 16) | (q[3] << 24); w.y = q[4] | (q[5] << 8) | (q[6] << 16) | (q[7] << 24);
                *(u32x2*)(ACT + (size_t)row * 2048 + j0) = w; }
    }
};
constexpr float YB_SCALE = 32.0f;
struct EpiDown {
    static constexpr bool PERM = true;
    unsigned char* YB; const float* bdn; const float* rowgate; const float* sb;
    __device__ __forceinline__ void operator()(const pg8::i32x4 (&acc)[2][2][4][2], const pg8::Unit& u, int wr, int wc, int fr, int fq) const {
        const int r0 = u.pm * 256 + wr * 64 + fr, c0 = u.pn * 256 + wc * 32 + 8 * fq;
        float b8[2][8], s8[2][8];
#pragma unroll
        for (int bj = 0; bj < 2; ++bj)
#pragma unroll
            for (int i = 0; i < 8; ++i) { b8[bj][i] = bdn[(size_t)u.e * 2048 + c0 + bj * 128 + i] * YB_SCALE; s8[bj][i] = sb[(size_t)u.e * 2048 + c0 + bj * 128 + i] * (ACT_QSCALE * YB_SCALE); }
#pragma unroll
        for (int ai = 0; ai < 2; ++ai)
#pragma unroll
            for (int m = 0; m < 4; ++m) { const int row = r0 + ai * 128 + m * 16; const float g = rowgate[row];
#pragma unroll
                for (int bj = 0; bj < 2; ++bj) { float o[8];
#pragma unroll
                    for (int i = 0; i < 8; ++i) o[i] = __builtin_amdgcn_fmed3f(((float)acc[ai][bj][m][i >> 2][i & 3] * s8[bj][i] + b8[bj][i]) * g, -448.0f, 448.0f);
                    u32x2 w; w.x = 0; w.y = 0;
                    w.x = __builtin_amdgcn_cvt_pk_fp8_f32(o[0], o[1], w.x, false); w.x = __builtin_amdgcn_cvt_pk_fp8_f32(o[2], o[3], w.x, true);
                    w.y = __builtin_amdgcn_cvt_pk_fp8_f32(o[4], o[5], w.y, false); w.y = __builtin_amdgcn_cvt_pk_fp8_f32(o[6], o[7], w.y, true);
                    *(u32x2*)(YB + (size_t)row * 2048 + c0 + bj * 128) = w; } }
    }
};
__device__ __forceinline__ void rg_local(unsigned char* ws, LAS unsigned char* lds, int ubeg, int ustride) {
    CArgs& a = *kargs();
    const int tid = threadIdx.x, wave = __builtin_amdgcn_readfirstlane(tid >> 6), lane = tid & 63, fr = lane & 15, fq = lane >> 4;
    LAS bf16_t* XCB = (LAS bf16_t*)lds;
    LAS float* XCF = (LAS float*)(lds + 17408);
    LAS float* AF = (LAS float*)(lds + 17408 + 32768);
    LAS float* BF = (LAS float*)(lds + 17408 + 65536);
    LAS float* QA = (LAS float*)(lds + 17408 + 98304);
    LAS float* QH = QA + 512;
    const bf16_t* XR = (const bf16_t*)(ws + WS_XR); const bf16_t* WRGT = (const bf16_t*)(ws + WS_WRGT);
    bf16_t* HL = (bf16_t*)(ws + WS_HL); bf16_t* ACUM = (bf16_t*)(ws + WS_ACUM); float* ACH = (float*)(ws + WS_ACH); float* HCH = (float*)(ws + WS_HCH);
    int n_cur = -1; f32x4 w0, w1, w2, w3, bb; float ba = 0.f, bx = 0.f, sp8 = 0.f; bf16x8 br[4], bi[4];
    const int c4 = (tid & 31) * 4, tg = tid >> 5, d0 = 16 * wave;
    u32x2 xr[7];
#define RG_LOADX(uu) do { const int t0_ = 64 * ((uu) >> 3), ch_ = 128 * ((uu) & 7) + c4;                                                              \
        _Pragma("unroll") for (int i = 0; i < 7; ++i) { const int tt = t0_ + 4 * tg - 3 + i; xr[i] = tt >= 0 ? *(const u32x2*)(XR + (size_t)tt * 1024 + ch_) : (u32x2){0u, 0u}; } } while (0)
    if (ubeg < 2048) RG_LOADX(ubeg);
    for (int u = ubeg; u < 2048; u += ustride) {
        const int j = u >> 3, n = u & 7, t0 = 64 * j, cb = 128 * n;
        if (n != n_cur) { n_cur = n; const int ch = cb + c4;
            w0 = *(const f32x4*)(a.in[I_CONV_W] + ch); w1 = *(const f32x4*)(a.in[I_CONV_W] + 1024 + ch); w2 = *(const f32x4*)(a.in[I_CONV_W] + 2048 + ch); w3 = *(const f32x4*)(a.in[I_CONV_W] + 3072 + ch);
            bb = *(const f32x4*)(a.in[I_CONV_B] + ch);
            const int chd = cb + d0 + fr; ba = a.in[I_B_RG_A][chd]; bx = a.in[I_B_RG_X][chd]; sp8 = 8.0f * log1pf(__expf(-a.in[I_RG_LAMBDA][chd]));
#pragma unroll
            for (int s = 0; s < 4; ++s) { br[s] = *(const bf16x8*)(WRGT + ((size_t)(0 * 8 + n) * 128 + d0 + fr) * 128 + 32 * s + 8 * fq); bi[s] = *(const bf16x8*)(WRGT + ((size_t)(1 * 8 + n) * 128 + d0 + fr) * 128 + 32 * s + 8 * fq); } }
        {
            f32x4 x[7];
#pragma unroll
            for (int i = 0; i < 7; ++i) x[i] = (f32x4){bflo(xr[i].x), bfhi(xr[i].x), bflo(xr[i].y), bfhi(xr[i].y)};
#pragma unroll
            for (int i = 0; i < 4; ++i) { const f32x4 xc = bb + w0 * x[i] + w1 * x[i + 1] + w2 * x[i + 2] + w3 * x[i + 3]; const int t = 4 * tg + i;
                *(LAS f32x4*)(XCF + t * 128 + c4) = xc; u32x2 pk; pk.x = pk2(xc[0], xc[1]); pk.y = pk2(xc[2], xc[3]); *(LAS u32x2*)(XCB + t * 136 + c4) = pk; }
            if (u + ustride < 2048) RG_LOADX(u + ustride);
        }
        __syncthreads();
        {
            f32x4 ar[4], ai[4];
#pragma unroll
            for (int m = 0; m < 4; ++m) { ar[m] = (f32x4){0.f, 0.f, 0.f, 0.f}; ai[m] = (f32x4){0.f, 0.f, 0.f, 0.f}; }
#pragma unroll
            for (int s = 0; s < 4; ++s) {
#pragma unroll
                for (int m = 0; m < 4; ++m) { const bf16x8 af = *(const LAS bf16x8*)(XCB + (16 * m + fr) * 136 + 32 * s + 8 * fq);
                    ar[m] = __builtin_amdgcn_mfma_f32_16x16x32_bf16(af, br[s], ar[m], 0, 0, 0); ai[m] = __builtin_amdgcn_mfma_f32_16x16x32_bf16(af, bi[s], ai[m], 0, 0, 0); }
            }
            const int d = d0 + fr;
#pragma unroll
            for (int m = 0; m < 4; ++m)
#pragma unroll
                for (int r = 0; r < 4; ++r) { const int t = 16 * m + 4 * fq + r;
                    const float rg = sigmoidf_(ar[m][r] + ba), ig = sigmoidf_(ai[m][r] + bx), la = -sp8 * rg, y = -2.0f * la;
                    const float em = (y > 0.5f) ? -expm1f(-y) : y * (1.0f + y * (-0.5f + y * (0.16666667f + y * (-0.041666668f + y * (0.0083333338f + y * -0.0013888889f)))));
                    AF[t * 128 + d] = __expf(la); BF[t * 128 + d] = sqrtf(em) * (ig * XCF[t * 128 + d]); }
        }
        __syncthreads();
        {
            const int c = tid & 127, q = tid >> 7; float hv[16], pv[16]; float h = 0.f, P = 1.f;
#pragma unroll
            for (int i = 0; i < 16; ++i) { const float av = AF[(16 * q + i) * 128 + c]; h = av * h + BF[(16 * q + i) * 128 + c]; P *= av; hv[i] = h; pv[i] = P; }
            QA[q * 128 + c] = P; QH[q * 128 + c] = h;
            __syncthreads();
            float hin = 0.f, pin = 1.f;
            for (int qq = 0; qq < q; ++qq) { const float qa = QA[qq * 128 + c]; hin = qa * hin + QH[qq * 128 + c]; pin *= qa; }
#pragma unroll
            for (int i = 0; i < 16; ++i) { const float hh = hv[i] + pv[i] * hin, pp = pv[i] * pin;
                BF[(16 * q + i) * 128 + c] = hh; AF[(16 * q + i) * 128 + c] = pp;
                if (q == 3 && i == 15) { ACH[(size_t)j * 1024 + cb + c] = pp; HCH[(size_t)j * 1024 + cb + c] = hh; } }
        }
        __syncthreads();
        {
            const int c4 = (tid & 31) * 4, r = tid >> 5;
#pragma unroll
            for (int p = 0; p < 4; ++p) { const int t = r + 16 * p; const size_t g = (size_t)(t0 + t) * 1024 + cb + c4;
                const f32x4 hh = *(const LAS f32x4*)(BF + t * 128 + c4), pp = *(const LAS f32x4*)(AF + t * 128 + c4);
                u32x2 o; o.x = pk2(hh[0], hh[1]); o.y = pk2(hh[2], hh[3]); *(u32x2*)(HL + g) = o;
                o.x = pk2(pp[0], pp[1]); o.y = pk2(pp[2], pp[3]); *(u32x2*)(ACUM + g) = o; }
        }
        __syncthreads();
    }
}

#undef RG_LOADX
__device__ __forceinline__ void carry_scan(unsigned char* ws, LAS unsigned char* lds, int G) {
    const int tid = threadIdx.x, wave = __builtin_amdgcn_readfirstlane(tid >> 6), lane = tid & 63;
    const float* ACH = (const float*)(ws + WS_ACH); const float* HCH = (const float*)(ws + WS_HCH); float* CARRY = (float*)(ws + WS_CARRY);
    LAS f32x4* WTA = (LAS f32x4*)lds; LAS f32x4* WTH = (LAS f32x4*)(lds + 64);
    for (int cg = blockIdx.x; cg < 256; cg += G) {
        f32x4 A4 = {1.f, 1.f, 1.f, 1.f}, H4 = {0.f, 0.f, 0.f, 0.f};
        if (tid < 256) { A4 = *(const f32x4*)(ACH + (size_t)tid * 1024 + 4 * cg); H4 = *(const f32x4*)(HCH + (size_t)tid * 1024 + 4 * cg); }
#pragma unroll
        for (int off = 1; off < 64; off <<= 1) {
            f32x4 pa, ph;
#pragma unroll
            for (int i = 0; i < 4; ++i) { pa[i] = __shfl_up(A4[i], off); ph[i] = __shfl_up(H4[i], off); }
            if (lane >= off) { H4 = A4 * ph + H4; A4 = A4 * pa; }
        }
        if (tid < 256 && lane == 63) { WTA[wave] = A4; WTH[wave] = H4; }
        __syncthreads();
        if (tid < 256) {
            f32x4 ph = {0.f, 0.f, 0.f, 0.f};
            for (int w = 0; w < wave; ++w) { const f32x4 ta = WTA[w], th = WTH[w]; ph = ta * ph + th; }
            const f32x4 hinc = A4 * ph + H4;
            if (tid + 1 < 256) *(f32x4*)(CARRY + (size_t)(tid + 1) * 1024 + 4 * cg) = hinc;
            if (tid == 0) *(f32x4*)(CARRY + 4 * cg) = (f32x4){0.f, 0.f, 0.f, 0.f};
        }
        __syncthreads();
    }
}

__device__ __forceinline__ void convert_late_weights(unsigned char* ws, LAS unsigned char* lds, int G) {
    CArgs& a = *kargs(); const int wave = wave_id(), lane = lane_id();
    LAS float* scr = (LAS float*)(lds + wave * 16384);
    const int gw = blockIdx.x * NWAVES + wave, NGW = G * NWAVES;
    convert_strips_i8(a.in[I_W_OUT], 2048, (signed char*)(ws + WS_WOUT), (float*)(ws + WS_SBOUT), lds, blockIdx.x, G);
    convert_strips_i8<true>(a.in[I_W_CQ], 2048, (signed char*)(ws + WS_WCQ), (float*)(ws + WS_SBCQ), lds, ((int)blockIdx.x + G - 64) % G, G, a.in[I_NORM_CROSS_G]);
    convert_strips_i8<true>(a.in[I_W_CO], 2048, (signed char*)(ws + WS_WCO), (float*)(ws + WS_SBCO), lds, ((int)blockIdx.x + G - 128) % G, G);
    __syncthreads();
}
constexpr size_t WS_VT8 = WS_ACT;
__device__ __forceinline__ float v_fp8_scale(const unsigned char* ws, int head) { const float am = __uint_as_float(((const unsigned*)(ws + WS_CTL))[CW_VMAX + head]); return am > 0.f ? 240.0f / am : 1.0f; }
constexpr size_t WS_Q8 = WS_VT8 + 16 * MiB, WS_K8 = WS_VT8 + 24 * MiB;
__device__ __forceinline__ float fp8_amax_scale(const unsigned char* ws, int word) { const float am = __uint_as_float(((const unsigned*)(ws + WS_CTL))[CW_VMAX + word]); return am > 0.f ? 240.0f / am : 1.0f; }
__device__ __forceinline__ int qk_fp8_shift(const unsigned char* ws, int head) { int e; (void)frexpf(fp8_amax_scale(ws, 4 + head) * fp8_amax_scale(ws, 8 + head) * (1.0f / 0.12751743f), &e); return e - 1; }
__device__ __forceinline__ float qk_fp8_scale(const unsigned char* ws, int which, int head) {
    const float sk = fp8_amax_scale(ws, 8 + head); if (which) return sk;
    return 0.12751743f * ldexpf(1.0f, qk_fp8_shift(ws, head)) / sk; }
__device__ __forceinline__ void convert_v_fp8(unsigned char* ws, LAS unsigned char* lds, int G) {
    const int wave = wave_id(), lane = lane_id();
    for (int i = blockIdx.x * NTHREADS + threadIdx.x; i < 2 * 4 * S_ * 16; i += G * NTHREADS) {
        const int which = i >> 20, head = (i >> 18) & 3, rem = i & ((1 << 18) - 1);
        const float sc = qk_fp8_scale(ws, which, head);
        const u32x4 w = *(const u32x4*)((const bf16_t*)(ws + (which ? WS_K : WS_Q)) + (size_t)(2 * head + 1) * S_ * 128 + (size_t)rem * 8);
        unsigned b0 = 0, b1 = 0;
        b0 = __builtin_amdgcn_cvt_pk_fp8_f32(bflo(w.x) * sc, bfhi(w.x) * sc, b0, false); b0 = __builtin_amdgcn_cvt_pk_fp8_f32(bflo(w.y) * sc, bfhi(w.y) * sc, b0, true);
        b1 = __builtin_amdgcn_cvt_pk_fp8_f32(bflo(w.z) * sc, bfhi(w.z) * sc, b1, false); b1 = __builtin_amdgcn_cvt_pk_fp8_f32(bflo(w.w) * sc, bfhi(w.w) * sc, b1, true);
        u32x2 o; o.x = b0; o.y = b1;
        *(u32x2*)(ws + (which ? WS_K8 : WS_Q8) + (size_t)head * S_ * 128 + (size_t)rem * 8) = o;
    }
    LAS unsigned char* T = lds + wave * 8192;
    for (int job = blockIdx.x * NWAVES + wave; job < 2048; job += G * NWAVES) {
        const int head = job >> 9, tile = (job >> 1) & 255, half = job & 1;
        const float vs = v_fp8_scale(ws, head);
        const bf16_t* src = (const bf16_t*)(ws + WS_V) + ((size_t)head * S_ + (size_t)tile * 64) * 256 + half * 128;
#pragma unroll 4
        for (int i = 0; i < 16; ++i) { const int idx = i * 64 + lane, key = idx >> 4, ch = idx & 15;
            const u32x4 w = *(const u32x4*)(src + (size_t)key * 256 + ch * 8);
            const int kp = key & 31, pos = ((kp >> 2) & 1) * 32 + (key >> 5) * 16 + (kp & 3) + 4 * (kp >> 3);
            unsigned b0 = 0, b1 = 0;
            b0 = __builtin_amdgcn_cvt_pk_fp8_f32(bflo(w.x) * vs, bfhi(w.x) * vs, b0, false); b0 = __builtin_amdgcn_cvt_pk_fp8_f32(bflo(w.y) * vs, bfhi(w.y) * vs, b0, true);
            b1 = __builtin_amdgcn_cvt_pk_fp8_f32(bflo(w.z) * vs, bfhi(w.z) * vs, b1, false); b1 = __builtin_amdgcn_cvt_pk_fp8_f32(bflo(w.w) * vs, bfhi(w.w) * vs, b1, true);
            LAS unsigned char* d = T + (ch * 8) * 64 + pos;
            d[0 * 64] = (unsigned char)b0; d[1 * 64] = (unsigned char)(b0 >> 8); d[2 * 64] = (unsigned char)(b0 >> 16); d[3 * 64] = (unsigned char)(b0 >> 24);
            d[4 * 64] = (unsigned char)b1; d[5 * 64] = (unsigned char)(b1 >> 8); d[6 * 64] = (unsigned char)(b1 >> 16); d[7 * 64] = (unsigned char)(b1 >> 24); }
        LDS_WAIT(); asm volatile("" ::: "memory");
        unsigned char* dst = ws + WS_VT8 + (((size_t)head * 256 + tile) * 256 + half * 128) * 64;
#pragma unroll
        for (int i = 0; i < 8; ++i) { const int idx = i * 64 + lane; *(u32x4*)(dst + (size_t)idx * 16) = *(const LAS u32x4*)(T + idx * 16); }
        LDS_WAIT(); asm volatile("" ::: "memory");
    }
    __syncthreads();
}

constexpr int CW_ATTQ = 8192;
__device__ __forceinline__ void attn_phase(unsigned char* ws, char* lds, volatile LAS unsigned* MISC, int G) {
    const int c = blockIdx.x, hp = (c & 7) >> 1;
    unsigned* qctr = (unsigned*)(ws + WS_CTL) + CW_ATTQ + 64 * hp;
    if (G != 256) {
        for (int L = c; L < 512; L += G) { const int u = L & 7;
            if ((u & 1) == 0) att2::attn_block_b16((const bf16_t*)(ws + WS_Q) + (size_t)u * S_ * 128, (const bf16_t*)(ws + WS_K) + (size_t)u * S_ * 128, (const bf16_t*)(ws + WS_V) + (size_t)(u >> 1) * S_ * 256,
                                                   (bf16_t*)(ws + WS_AO) + (size_t)u * S_ * 256, L >> 3, lds);
            else att2::attn_block(ws + WS_Q8 + (size_t)(u >> 1) * S_ * 128, ws + WS_K8 + (size_t)(u >> 1) * S_ * 128, qk_fp8_shift(ws, u >> 1), ws + WS_VT8 + (size_t)(u >> 1) * 256 * 16384, 1.0f / v_fp8_scale(ws, u >> 1),
                                  (bf16_t*)(ws + WS_AO) + (size_t)u * S_ * 256, L >> 3, lds); }
        return; }
    const int cohort = (c >> 3) & 3; int ndone = 0; bool strips_done = false;
    for (;;) {
        if (!strips_done && ndone == cohort) { convert_expert_strips(ws, (LAS unsigned char*)lds, c, 256); convert_late_weights(ws, (LAS unsigned char*)lds, G); strips_done = true; }
        if (threadIdx.x == 0) MISC[16] = __hip_atomic_fetch_add(qctr, 1u, __ATOMIC_RELAXED, __HIP_MEMORY_SCOPE_AGENT);
        __syncthreads();
        const unsigned idx = MISC[16];
        __syncthreads();
        if (idx >= 128u) break;
        {
            unsigned char* w2 = kargs()->ws; const int u = (((int)blockIdx.x & 7) & ~1) | (int)(idx & 1u), qb = 63 - (int)(idx >> 1);
            if ((idx & 1u) == 0) att2::attn_block_b16((const bf16_t*)(w2 + WS_Q) + (size_t)u * S_ * 128, (const bf16_t*)(w2 + WS_K) + (size_t)u * S_ * 128, (const bf16_t*)(w2 + WS_V) + (size_t)(u >> 1) * S_ * 256,
                                                      (bf16_t*)(w2 + WS_AO) + (size_t)u * S_ * 256, qb, lds);
            else att2::attn_block(w2 + WS_Q8 + (size_t)(u >> 1) * S_ * 128, w2 + WS_K8 + (size_t)(u >> 1) * S_ * 128, qk_fp8_shift(w2, u >> 1), w2 + WS_VT8 + (size_t)(u >> 1) * 256 * 16384,
                                  1.0f / v_fp8_scale(w2, u >> 1), (bf16_t*)(w2 + WS_AO) + (size_t)u * S_ * 256, qb, lds); }
        ++ndone;
    }
    if (!strips_done) { convert_expert_strips(ws, (LAS unsigned char*)lds, c, 256); convert_late_weights(ws, (LAS unsigned char*)lds, G); }
}

__device__ __forceinline__ void post_mix(unsigned char* ws, int G) {
    CArgs& a = *kargs(); const int wave = wave_id(), lane = lane_id();
    const int gw = blockIdx.x * NWAVES + wave, NGW = G * NWAVES;
    float s1 = 0.f, s2 = 0.f;
    for (int i = lane; i < 128; i += 64) { s1 += a.in[I_LQ1][i] * a.in[I_LK1][i]; s2 += a.in[I_LQ2][i] * a.in[I_LK2][i]; }
    const float lam = __expf(wave_sum(s1)) - __expf(wave_sum(s2)) + LAMBDA_INIT;
    const bf16_t* AO = (const bf16_t*)(ws + WS_AO); const bf16_t* XG = (const bf16_t*)(ws + WS_XG);
    const bf16_t* HL = (const bf16_t*)(ws + WS_HL); const bf16_t* ACUM = (const bf16_t*)(ws + WS_ACUM); const float* CARRY = (const float*)(ws + WS_CARRY);
    const int d = 4 * lane;
    const f32x4 sg = *(const f32x4*)(a.in[I_SUBLN_G] + d);
    signed char* MIX8 = (signed char*)(ws + WS_MIX); float* MIXSCALE = (float*)(ws + WS_MIXSCALE);
    struct RowIn { u32x2 o0[4], o1[4], hl[4], ac[4], xg[4]; f32x4 cr[4]; };
    f32x4 rg[4];
#pragma unroll
    for (int j = 0; j < 4; ++j) rg[j] = *(const f32x4*)(a.in[I_REC_NORM_G] + 4 * lane + 256 * j);
    auto load_row = [&](int t, RowIn& R) {
#pragma unroll
        for (int hh = 0; hh < 4; ++hh) { R.o0[hh] = *(const u32x2*)(AO + ((size_t)(hh * 2 + 0) * S_ + t) * 256 + d); R.o1[hh] = *(const u32x2*)(AO + ((size_t)(hh * 2 + 1) * S_ + t) * 256 + d); }
        const int chunk = t >> 6;
#pragma unroll
        for (int j = 0; j < 4; ++j) { const int c = 4 * lane + 256 * j;
            R.hl[j] = *(const u32x2*)(HL + (size_t)t * 1024 + c); R.ac[j] = *(const u32x2*)(ACUM + (size_t)t * 1024 + c); R.xg[j] = *(const u32x2*)(XG + (size_t)t * 1024 + c); R.cr[j] = *(const f32x4*)(CARRY + (size_t)chunk * 1024 + c); }
    };
    auto finish_row = [&](int t, const RowIn& R) {
        f32x4 av[4]; float am = 0.f;
#pragma unroll
        for (int hh = 0; hh < 4; ++hh) { const u32x2 o0 = R.o0[hh], o1 = R.o1[hh];
            f32x4 v; v[0] = bflo(o0.x) - lam * bflo(o1.x); v[1] = bfhi(o0.x) - lam * bfhi(o1.x); v[2] = bflo(o0.y) - lam * bflo(o1.y); v[3] = bfhi(o0.y) - lam * bfhi(o1.y);
            const float ss = wave_sum((v[0] * v[0] + v[1] * v[1]) + (v[2] * v[2] + v[3] * v[3]));
            const float r = rsqrtf(ss * (1.f / 256.f) + DA_EPS_) * (1.0f - LAMBDA_INIT);
            av[hh] = (f32x4){v[0] * r * sg[0], v[1] * r * sg[1], v[2] * r * sg[2], v[3] * r * sg[3]};
            am = fmaxf(fmaxf(am, fmaxf(fabsf(av[hh][0]), fabsf(av[hh][1]))), fmaxf(fabsf(av[hh][2]), fabsf(av[hh][3]))); }
        f32x4 y[4]; float ss = 0.f;
#pragma unroll
        for (int j = 0; j < 4; ++j) { const u32x2 hl2 = R.hl[j], ac2 = R.ac[j], xg = R.xg[j]; const f32x4 cr = R.cr[j];
            const f32x4 hl = {bflo(hl2.x), bfhi(hl2.x), bflo(hl2.y), bfhi(hl2.y)}, ac = {bflo(ac2.x), bfhi(ac2.x), bflo(ac2.y), bfhi(ac2.y)};
            const f32x4 h = hl + ac * cr;
            y[j][0] = h[0] * gelu_tanh(bflo(xg.x)); y[j][1] = h[1] * gelu_tanh(bfhi(xg.x)); y[j][2] = h[2] * gelu_tanh(bflo(xg.y)); y[j][3] = h[3] * gelu_tanh(bfhi(xg.y));
            ss += (y[j][0] * y[j][0] + y[j][1] * y[j][1]) + (y[j][2] * y[j][2] + y[j][3] * y[j][3]); }
        const float r = rsqrtf(wave_sum(ss) * (1.f / 1024.f) + EPS_);
#pragma unroll
        for (int j = 0; j < 4; ++j) { const f32x4 g = rg[j];
            y[j] = (f32x4){y[j][0] * r * g[0], y[j][1] * r * g[1], y[j][2] * r * g[2], y[j][3] * r * g[3]};
            am = fmaxf(fmaxf(am, fmaxf(fabsf(y[j][0]), fabsf(y[j][1]))), fmaxf(fabsf(y[j][2]), fabsf(y[j][3]))); }
#pragma unroll
        for (int o = 32; o > 0; o >>= 1) am = fmaxf(am, __shfl_xor(am, o));
        const float inv = am > 0.f ? 127.0f / am : 0.f;
#define PM_Q8(V) __builtin_amdgcn_perm(__builtin_amdgcn_perm(__float_as_uint(fmaf(V[3], inv, 12582912.0f)), __float_as_uint(fmaf(V[2], inv, 12582912.0f)), 0x0c0c0400u), \
                                       __builtin_amdgcn_perm(__float_as_uint(fmaf(V[1], inv, 12582912.0f)), __float_as_uint(fmaf(V[0], inv, 12582912.0f)), 0x0c0c0400u), 0x05040100u)
#pragma unroll
        for (int hh = 0; hh < 4; ++hh) *(unsigned*)(MIX8 + (size_t)t * DM + hh * 256 + d) = PM_Q8(av[hh]);
#pragma unroll
        for (int j = 0; j < 4; ++j) *(unsigned*)(MIX8 + (size_t)t * DM + 1024 + 4 * lane + 256 * j) = PM_Q8(y[j]);
#undef PM_Q8
        if (lane == 0) MIXSCALE[t] = am > 0.f ? am * (1.0f / 127.0f) : 1.0f;
    };
    for (int t0 = gw; t0 < S_; t0 += 2 * NGW) {
        const int t1 = t0 + NGW; const bool two = t1 < S_;
        RowIn A, B; load_row(t0, A); load_row(two ? t1 : t0, B);
        finish_row(t0, A); if (two) finish_row(t1, B);
    }
}

__device__ __forceinline__ void ffn_norm_router(unsigned char* ws, LAS unsigned char* lds, int G) {
    CArgs& a = *kargs();
    const int tid = threadIdx.x, wave = __builtin_amdgcn_readfirstlane(tid >> 6), lane = tid & 63, fr = lane & 15, fq = lane >> 4;
    LAS float* XF = (LAS float*)lds;
    LAS float* PL = (LAS float*)lds;
    LAS float* LG = (LAS float*)(lds + 16384);
    LAS int* CNT = (LAS int*)(lds + 16384 + 2048);
    const bf16_t* H = (const bf16_t*)(ws + WS_H); signed char* XQ = (signed char*)(ws + WS_XN); float* TOKSCALE = (float*)(ws + WS_TOKSCALE); const float* WR = a.in[I_W_ROUTER];
    int* TOPE = (int*)(ws + WS_TOPE); float* TOPG = (float*)(ws + WS_TOPG); int* TCNT = (int*)(ws + WS_TCNT);
    for (int tile = blockIdx.x; tile < 1024; tile += G) {
        u32x2 raw[2][8];
#pragma unroll
        for (int rr = 0; rr < 2; ++rr) { const bf16_t* xr = H + ((size_t)tile * 16 + wave * 2 + rr) * DM + 4 * lane;
#pragma unroll
            for (int j = 0; j < 8; ++j) raw[rr][j] = *(const u32x2*)(xr + 256 * j); }
#pragma unroll
        for (int rr = 0; rr < 2; ++rr) { const int row = wave * 2 + rr; const size_t t = (size_t)tile * 16 + row;
            const f32x4* gr = (const f32x4*)a.in[I_NORM_FFN_G] + lane;
            f32x4 v[8]; float s = 0.f;
#pragma unroll
            for (int j = 0; j < 8; ++j) { const u32x2 w = raw[rr][j]; v[j] = (f32x4){bflo(w.x), bfhi(w.x), bflo(w.y), bfhi(w.y)}; s += (v[j].x * v[j].x + v[j].y * v[j].y) + (v[j].z * v[j].z + v[j].w * v[j].w); }
            const float r = rsqrtf(wave_sum(s) * (1.f / 2048.f) + EPS_);
            float am = 0.f;
#pragma unroll
            for (int j = 0; j < 8; ++j) { const f32x4 gg = gr[64 * j]; v[j] = (f32x4){v[j].x * r * gg.x, v[j].y * r * gg.y, v[j].z * r * gg.z, v[j].w * r * gg.w};
                am = fmaxf(fmaxf(am, fmaxf(fabsf(v[j].x), fabsf(v[j].y))), fmaxf(fabsf(v[j].z), fabsf(v[j].w)));
                *(LAS f32x4*)(XF + row * 2052 + 4 * lane + 256 * j) = v[j]; }
#pragma unroll
            for (int o = 1; o < 64; o <<= 1) am = fmaxf(am, __shfl_xor(am, o));
            const float inv = am > 0.f ? 127.0f / am : 0.f;
            unsigned* o4 = (unsigned*)(XQ + t * DM) + lane;
#pragma unroll
            for (int j = 0; j < 8; ++j) { const int q0 = (int)rintf(v[j].x * inv), q1 = (int)rintf(v[j].y * inv), q2 = (int)rintf(v[j].z * inv), q3 = (int)rintf(v[j].w * inv);
                o4[64 * j] = ((unsigned)q0 & 0xffu) | (((unsigned)q1 & 0xffu) << 8) | (((unsigned)q2 & 0xffu) << 16) | (((unsigned)q3 & 0xffu) << 24); }
            if (lane == 0) TOKSCALE[t] = am > 0.f ? am * (1.0f / 127.0f) : 1.0f;
        }
        __syncthreads();
        f32x4 c0 = {0.f, 0.f, 0.f, 0.f}, c1 = {0.f, 0.f, 0.f, 0.f};
#pragma unroll 8
        for (int s = 0; s < 64; ++s) { const int k = 256 * wave + 4 * s + fq;
            const float af = XF[fr * 2052 + k], b0 = WR[(size_t)k * 32 + fr], b1 = WR[(size_t)k * 32 + 16 + fr];
            c0 = __builtin_amdgcn_mfma_f32_16x16x4f32(af, b0, c0, 0, 0, 0); c1 = __builtin_amdgcn_mfma_f32_16x16x4f32(af, b1, c1, 0, 0, 0); }
        __syncthreads();
#pragma unroll
        for (int r = 0; r < 4; ++r) { PL[(wave * 16 + fq * 4 + r) * 32 + fr] = c0[r]; PL[(wave * 16 + fq * 4 + r) * 32 + 16 + fr] = c1[r]; }
        if (tid < 32) CNT[tid] = 0;
        __syncthreads();
        { const int row = tid >> 5, e = tid & 31; float lg = a.in[I_B_ROUTER][e];
#pragma unroll
          for (int w = 0; w < 8; ++w) lg += PL[(w * 16 + row) * 32 + e];
          __syncthreads();
          LG[row * 32 + e] = lg; }
        __syncthreads();
        if (tid < 16) { const int row = tid; const size_t t = (size_t)tile * 16 + row; unsigned mask = 0u; float tv[4]; int te[4];
            for (int k = 0; k < 4; ++k) { float best = -__builtin_inff(); int bi = 0;
                for (int e = 0; e < 32; ++e) { const float x = LG[row * 32 + e]; if (!((mask >> e) & 1u) && x > best) { best = x; bi = e; } }
                mask |= 1u << bi; tv[k] = best; te[k] = bi; }
            float ex[4], sum = 0.f;
            for (int k = 0; k < 4; ++k) { ex[k] = __expf(tv[k] - tv[0]); sum += ex[k]; }
            const float inv = 1.0f / sum;
            for (int k = 0; k < 4; ++k) { TOPE[t * 4 + k] = te[k]; TOPG[t * 4 + k] = ex[k] * inv; __hip_atomic_fetch_add(&CNT[te[k]], 1, __ATOMIC_RELAXED, __HIP_MEMORY_SCOPE_WORKGROUP); }
        }
        __syncthreads();
        if (tid < 32) TCNT[tile * 32 + tid] = CNT[tid];
        __syncthreads();
    }
}

__device__ __forceinline__ void moe_route(unsigned char* ws, LAS unsigned char* lds, int G) {
    const int tid = threadIdx.x, wave = __builtin_amdgcn_readfirstlane(tid >> 6), lane = tid & 63;
    LAS int* TC = (LAS int*)lds;
    LAS int* PS = (LAS int*)(lds + 131072);
    LAS int* PPRE = (LAS int*)(lds + 133120);
    LAS int* TOT = (LAS int*)(lds + 135168);
    LAS int* PADSTART = (LAS int*)(lds + 135296);
    LAS int* SELPOS = (LAS int*)(lds + 135552);
    LAS int* SELTOK = (LAS int*)(lds + 135808);
    const int* TCNT = (const int*)(ws + WS_TCNT); const int* TOPE = (const int*)(ws + WS_TOPE); const float* TOPG = (const float*)(ws + WS_TOPG);
    int* POSOF = (int*)(ws + WS_POSOF); float* ROWGATE = (float*)(ws + WS_ROWGATE); int* TILEEXP = (int*)(ws + WS_TILEEXP); int* NRT = (int*)(ws + WS_NRT);
    int* SRCTOK = (int*)(ws + WS_SRCTOK); const float* TOKSCALE = (const float*)(ws + WS_TOKSCALE); float* ROWSCALE = (float*)(ws + WS_ROWSCALE);
    for (int i = tid; i < 8192; i += NTHREADS) *(LAS u32x4*)(TC + 4 * i) = *(const u32x4*)(TCNT + 4 * i);
    __syncthreads();
    { const int e = tid & 31, part = tid >> 5; int run = 0;
      for (int i = 0; i < 64; ++i) { const int idx = (part * 64 + i) * 32 + e; const int v = TC[idx]; TC[idx] = run; run += v; }
      PS[part * 32 + e] = run; }
    __syncthreads();
    if (tid < 32) { int run = 0; for (int p = 0; p < 16; ++p) { PPRE[p * 32 + tid] = run; run += PS[p * 32 + tid]; } TOT[tid] = run; }
    __syncthreads();
    if (tid == 0) { int run = 0;
        for (int e = 0; e < 32; ++e) { PADSTART[e] = run; const int pad = (TOT[e] + 255) & ~255;
            if (blockIdx.x == 0) for (int rt = run >> 8; rt < (run + pad) >> 8; ++rt) TILEEXP[rt] = e;
            run += pad; }
        PADSTART[32] = run; if (blockIdx.x == 0) NRT[0] = run >> 8; }
    __syncthreads();
    if (blockIdx.x == 0) for (int e = 0; e < 32; ++e) for (int p = PADSTART[e] + TOT[e] + tid; p < PADSTART[e + 1]; p += NTHREADS) SRCTOK[p] = 0;
    const int slot = wave & 3, half = wave >> 2;
    for (int it = 0; half == 0; ++it) {
        const int tile = blockIdx.x + (4 * it + slot) * G; if (tile >= 1024) break;
        const int m = lane, row = m >> 2, k = m & 3; const size_t t = (size_t)tile * 16 + row;
        const int e = TOPE[t * 4 + k]; const float g = TOPG[t * 4 + k]; int rank = 0;
        for (int mm = 0; mm < 64; ++mm) { const int em = __shfl(e, mm); rank += (mm < m && em == e) ? 1 : 0; }
        const int pos = PADSTART[e] + PPRE[(tile >> 6) * 32 + e] + TC[tile * 32 + e] + rank;
        if (half == 0) { ROWGATE[pos] = g; ROWSCALE[pos] = TOKSCALE[t]; POSOF[t * 4 + k] = pos; SRCTOK[pos] = (int)t; }
    }
}

__device__ __forceinline__ void final_combine(unsigned char* ws, int G) {
    CArgs& a = *kargs(); const int wave = wave_id(), lane = lane_id();
    const int gw = blockIdx.x * NWAVES + wave, NGW = G * NWAVES;
    const bf16_t* H = (const bf16_t*)(ws + WS_H); const unsigned char* YB = (const unsigned char*)(ws + WS_YB); const int* POSOF = (const int*)(ws + WS_POSOF);
    f32x4 gg[8];
#pragma unroll
    for (int j = 0; j < 8; ++j) gg[j] = ((const f32x4*)a.in[I_NORM_FINAL_G] + lane)[64 * j];
    for (int t0 = gw; t0 < S_; t0 += 2 * NGW) {
        const int t1 = t0 + NGW; const bool two = t1 < S_; const int tb = two ? t1 : t0;
        int pa[4], pb[4];
#pragma unroll
        for (int k = 0; k < 4; ++k) { pa[k] = POSOF[(size_t)t0 * 4 + k]; pb[k] = POSOF[(size_t)tb * 4 + k]; }
        f32x4 va[8], vb[8];
        { const bf16_t* xa = H + (size_t)t0 * DM + 4 * lane; const bf16_t* xb = H + (size_t)tb * DM + 4 * lane;
#pragma unroll
          for (int j = 0; j < 8; ++j) { va[j] = ld_bf16x4(xa + 256 * j); vb[j] = ld_bf16x4(xb + 256 * j); } }
        unsigned ya[4][8], yb[4][8];
#pragma unroll
        for (int k = 0; k < 4; ++k) { const unsigned* ra = (const unsigned*)(YB + (size_t)pa[k] * DM) + lane; const unsigned* rb = (const unsigned*)(YB + (size_t)pb[k] * DM) + lane;
#pragma unroll
            for (int j = 0; j < 8; ++j) { ya[k][j] = ra[64 * j]; yb[k][j] = rb[64 * j]; } }
#define FC_FINISH(V, Y, T) do {                                                                                                                         \
        _Pragma("unroll") for (int k = 0; k < 4; ++k) _Pragma("unroll") for (int j = 0; j < 8; ++j) { const unsigned y = Y[k][j];                        \
            const auto lo = __builtin_amdgcn_cvt_pk_f32_fp8(y, false), hi = __builtin_amdgcn_cvt_pk_f32_fp8(y, true);                                    \
            V[j].x += lo[0] * (1.0f / YB_SCALE); V[j].y += lo[1] * (1.0f / YB_SCALE); V[j].z += hi[0] * (1.0f / YB_SCALE); V[j].w += hi[1] * (1.0f / YB_SCALE); } \
        float s = 0.f;                                                                                                                                   \
        _Pragma("unroll") for (int j = 0; j < 8; ++j) s += (V[j].x * V[j].x + V[j].y * V[j].y) + (V[j].z * V[j].z + V[j].w * V[j].w);                   \
        const float r = rsqrtf(wave_sum(s) * (1.f / 2048.f) + EPS_);                                                                                    \
        f32x4* o = (f32x4*)(a.out + (size_t)(T) * DM) + lane;                                                                                           \
        _Pragma("unroll") for (int j = 0; j < 8; ++j) o[64 * j] = (f32x4){V[j].x * r * gg[j].x, V[j].y * r * gg[j].y, V[j].z * r * gg[j].z, V[j].w * r * gg[j].w}; } while (0)
        FC_FINISH(va, ya, t0);
        if (two) FC_FINISH(vb, yb, t1);
#undef FC_FINISH
    }
}

__global__ void __launch_bounds__(NTHREADS, 2) fwd_kernel(Args args) {
    extern __shared__ __attribute__((aligned(16))) unsigned char lds_raw[];
    LAS unsigned char* lds = (LAS unsigned char*)lds_raw;
    volatile LAS unsigned* MISC = (volatile LAS unsigned*)(lds + MISC_OFF);
    const int tid = threadIdx.x;
    const int G = gridDim.x, c = blockIdx.x;
    CArgs* ka = kargs();
    unsigned char* ws = ka->ws;
    unsigned* ctl = (unsigned*)(ws + WS_CTL);
    for (int u = tid; u < 64; u += NTHREADS) MISC[u] = 0u;
    __syncthreads();
    const int lo = ka->ph_lo, hi = ka->ph_hi;
    const bool multi = (hi - lo) > 1;
    XcdBarrier bar; bar.bar = ctl + CW_BAR; bar.x = 0; bar.st = nullptr;
    if (multi) bar = xcd_barrier_post(ctl + CW_BAR, MISC + 8);
#define IN(k) (lo <= (k) && (k) < hi)
#define SEAM(k) do { if (IN(k) && IN((k) + 1)) xcd_barrier(bar); } while (0)

    if (IN(0)) { p0_prologue(ws, lds, G); }
    SEAM(0);
    if (IN(1)) {
        pg8::Gemm g{DM / 2, DM / 2, DM / 2}; pg8::DenseOrder O; O.init(ws + WS_XN, ws + WS_WIN, S_, NIN, DM / 2, DM / 2, G, c);
        EpiInProjI8 E{EpiInProj{(bf16_t*)(ws + WS_Q), (bf16_t*)(ws + WS_XR), ctl + CW_VMAX}, (const float*)(ws + WS_INSCALE), (const float*)(ws + WS_SBIN)};
        pg8::gemm_phase<EpiInProjI8, pg8::DenseOrder, true, true>(lds, g, O, E);
    }
    SEAM(1);
    if (IN(2)) { rg_local(ws, lds, c, G); __syncthreads(); convert_v_fp8(ws, lds, G); }
    SEAM(2);
    if (IN(3)) {
        carry_scan(ws, lds, G);
        if (c < 16) {
            pg8::Gemm g{DM, DM, DM}; SmallOrder O{(const char*)(ws + WS_MEMN), (const char*)(ws + WS_WCKV), c};
            EpiSmall E{(bf16_t*)(ws + WS_KM), (bf16_t*)(ws + WS_VT)};
            pg8::gemm_phase<EpiSmall, SmallOrder, true>(lds, g, O, E); }
        attn_phase(ws, (char*)lds_raw, MISC, G);
    }
    SEAM(3);
    if (IN(4)) { post_mix(ws, G); }
    SEAM(4);
    if (IN(5)) {
        pg8::Gemm g{DM / 2, DM / 2, DM / 2}; pg8::DenseOrder O; O.init(ws + WS_MIX, ws + WS_WOUT, S_, DM, DM / 2, DM / 2, G, c);
        EpiResNormI8 E{EpiResNormF32{kargs()->in[I_X], (bf16_t*)(ws + WS_H), (unsigned char*)(ws + WS_XN), (float*)(ws + WS_SSQ)}, (const float*)(ws + WS_MIXSCALE), (const float*)(ws + WS_SBOUT)};
        pg8::gemm_phase<EpiResNormI8, pg8::DenseOrder, true, true>(lds, g, O, E);
    }
    SEAM(5);
    if (IN(7)) {
        pg8::Gemm g{DM / 2, DM / 2, DM / 2}; pg8::DenseOrder O; O.init(ws + WS_XN, ws + WS_WCQ, S_, DM, DM / 2, DM / 2, G, c);
        LAS float* RL = (LAS float*)(lds + 131072);
        { const float* SSQ = (const float*)(ws + WS_SSQ);
          for (int it = tid; it < 8 * 256; it += NTHREADS) { const int ui = it >> 8, row = it & 255; pg8::Unit u;
              if (O.next(ui, u)) { const f32x4* p = (const f32x4*)(SSQ + (size_t)(u.pm * 256 + row) * 32); f32x4 a4 = p[0];
#pragma unroll
                  for (int j = 1; j < 8; ++j) a4 += p[j];
                  RL[it] = rsqrtf(((a4[0] + a4[1]) + (a4[2] + a4[3])) * (1.f / 2048.f) + EPS_); } }
          __syncthreads(); }
        EpiBf16RowScale E{(bf16_t*)(ws + WS_QC), DM, RL, (const float*)(ws + WS_SBCQ)};
        pg8::gemm_phase<EpiBf16RowScale, pg8::DenseOrder, true, false, true>(lds, g, O, E);
    }
    SEAM(7);
    if (IN(8)) {
        pg8::Gemm g{512, DM, DM}; HeadOrderS O{(const char*)(ws + WS_QC), (const char*)(ws + WS_KM), G, c};
        EpiScore E{(bf16_t*)(ws + WS_PC), (float*)(ws + WS_LPART)};
        pg8::gemm_phase<EpiScore, HeadOrderS, true>(lds, g, O, E);
    }
    if (G != 256) SEAM(8);
    if (IN(9)) {
        pg8::Gemm g{256, 1024, 256}; HeadOrderO O{(const char*)(ws + WS_PC), (const char*)(ws + WS_VT), G, c};
        EpiCrossO E{(unsigned char*)(ws + WS_OC), (const float*)(ws + WS_LPART)};
        pg8::gemm_phase<EpiCrossO, HeadOrderO, true>(lds, g, O, E);
    }
    SEAM(9);
    if (IN(10)) {
        pg8::Gemm g{DM / 2, DM / 2, DM / 2}; pg8::DenseOrder O; O.init(ws + WS_OC, ws + WS_WCO, S_, DM, DM / 2, DM / 2, G, c);
        EpiResF32 E{(const bf16_t*)(ws + WS_H), (bf16_t*)(ws + WS_H), (const float*)(ws + WS_SBCO), 1.0f / 16.0f};
        pg8::gemm_phase<EpiResF32, pg8::DenseOrder, true, false, true>(lds, g, O, E);
    }
    SEAM(10);
    if (IN(11)) { ffn_norm_router(ws, lds, G); }
    SEAM(11);
    if (IN(12)) { moe_route(ws, lds, G); }
    SEAM(12);
    if (IN(13)) {
        pg8::Gemm g{DM / 2, DM / 2, DM / 2}; GroupOrderG O{(const char*)(ws + WS_XN), (const char*)(ws + WS_WGU), (const int*)(ws + WS_TILEEXP), (const int*)(ws + WS_SRCTOK), (size_t)4096 * 2048, (size_t)256 * 2048, *(const int*)(ws + WS_NRT), 16, G, c};
        EpiGateUpI8 E{(signed char*)(ws + WS_ACT), kargs()->in[I_B_GU], (const float*)(ws + WS_ROWSCALE), (const float*)(ws + WS_SBGU)};
        pg8::gemm_phase<EpiGateUpI8, GroupOrderG, true, true>(lds, g, O, E);
    }
    SEAM(13);
    if (IN(14)) {
        pg8::Gemm g{DM / 2, DM / 2, DM / 2}; GroupOrder O{(const char*)(ws + WS_ACT), (const char*)(ws + WS_WDN), (const int*)(ws + WS_TILEEXP), (size_t)2048 * 2048, (size_t)256 * 2048, *(const int*)(ws + WS_NRT), 8, G, c};
        EpiDown E{(unsigned char*)(ws + WS_YB), kargs()->in[I_B_DN], (const float*)(ws + WS_ROWGATE), (const float*)(ws + WS_SBDN)};
        pg8::gemm_phase<EpiDown, GroupOrder, true, true>(lds, g, O, E);
    }
    SEAM(14);
    if (IN(15)) { final_combine(ws, G); }
#undef IN
#undef SEAM
}

extern "C" void kernel_launch(void* const* d_in, const int* in_sizes, int n_in, void* d_out, int out_size, void* d_ws, size_t ws_size, hipStream_t stream) {
    static int grid = 0;
    if (grid == 0) {
        if (n_in != 31 || out_size != S_ * DM || ws_size < WS_END) { fprintf(stderr, "kernel_launch: unexpected shapes (n_in %d, out %d, ws %zu); nothing launched\n", n_in, out_size, ws_size); grid = -1; return; }
        int dev = 0, cus = 0, per_cu = 0;
        if (hipGetDevice(&dev) != hipSuccess || hipDeviceGetAttribute(&cus, hipDeviceAttributeMultiprocessorCount, dev) != hipSuccess) { grid = -1; return; }
        if (hipFuncSetAttribute((const void*)fwd_kernel, hipFuncAttributeMaxDynamicSharedMemorySize, LDS_BYTES) != hipSuccess) { fprintf(stderr, "kernel_launch: hipFuncSetAttribute failed\n"); grid = -1; return; }
        if (hipOccupancyMaxActiveBlocksPerMultiprocessor(&per_cu, (const void*)fwd_kernel, NTHREADS, LDS_BYTES) != hipSuccess || per_cu < 1)
            fprintf(stderr, "kernel_launch: occupancy query reports %d workgroups per CU\n", per_cu);
        (void)hipGetLastError();
        grid = cus;
    }
    if (grid < 0) return;
    if (hipMemsetAsync((char*)d_ws + WS_CTL, 0, CTL_ZERO_BYTES, stream) != hipSuccess) return;
    Args a{};
    for (int i = 0; i < 31; ++i) a.in[i] = (const float*)d_in[i];
    a.out = (float*)d_out; a.ws = (unsigned char*)d_ws;
#if MK_N_LAUNCHES == 1
    a.ph_lo = 0; a.ph_hi = N_PHASES;
    hipLaunchKernelGGL(fwd_kernel, dim3(grid), dim3(NTHREADS), LDS_BYTES, stream, a);
#else
    for (int p = 0; p < N_PHASES; ++p) { a.ph_lo = p; a.ph_hi = p + 1; hipLaunchKernelGGL(fwd_kernel, dim3(grid), dim3(NTHREADS), LDS_BYTES, stream, a);
#ifdef PROBE_DUP_MASK
        if ((PROBE_DUP_MASK >> p) & 1) hipLaunchKernelGGL(fwd_kernel, dim3(grid), dim3(NTHREADS), LDS_BYTES, stream, a);
#endif
    }
#endif
}
```

```cpp
#include <hip/hip_runtime.h>
#include <hip/hip_bf16.h>
#include <cstdio>
#include <cstdint>

namespace pg8 {
#define PG8_LAS __attribute__((address_space(3)))
typedef unsigned short bf16_t;
typedef short bf16x8 __attribute__((ext_vector_type(8)));
typedef float f32x4 __attribute__((ext_vector_type(4)));
typedef unsigned u32x4 __attribute__((ext_vector_type(4)));
constexpr int BM = 256, BK = 64, HALF = 128, HTB = HALF * BK * 2  , STAGE_BYTES = 8 * HTB, NXCD = 8, WGM = 8;

__host__ __device__ __forceinline__ int lds_byte(int r, int c) { const int st = (r >> 4) * 2 + (c >> 5), rr = r & 15, cc = c & 31, ob = rr * 64 + cc * 2; return st * 1024 + (ob ^ (((ob >> 9) & 1) << 5)); }
__host__ __device__ __forceinline__ void stage_rc(int b, int& R, int& C) { const int st = b / 1024, sb = b % 1024, swz = sb ^ (((sb >> 9) & 1) << 5); R = (st >> 1) * 16 + swz / 64; C = (st & 1) * 32 + (swz % 64) / 2; }
__host__ __device__ __forceinline__ int perm32(int rho) { const int n = rho >> 4, i = rho & 15; return 8 * (i >> 2) + 4 * n + (i & 3); }

struct Unit { int pm, pn, e; const char* A; const char* B; };
struct Gemm { int K, lda, ldb; };

__device__ __forceinline__ unsigned cvt_pk_bf16(float lo, float hi) { unsigned r; asm volatile("v_cvt_pk_bf16_f32 %0, %1, %2" : "=v"(r) : "v"(lo), "v"(hi)); return r; }

struct DenseOrder {
    const char* A; const char* B; size_t tsA, tsB; int nM, nN, nwg, G, c;
    __device__ void init(const void* A_, const void* B_, int M, int N, int lda, int ldb, int G_, int c_) { A = (const char*)A_; B = (const char*)B_; tsA = (size_t)BM * lda * 2; tsB = (size_t)BM * ldb * 2; nM = M / BM; nN = N / BM; nwg = nM * nN; G = G_; c = c_; }
    __device__ __forceinline__ bool next(int i, Unit& u) const {
        const long L = (long)i * G + c; if (L >= nwg) return false;
        int wgid = (int)L; { const int q = nwg / NXCD, r = nwg % NXCD, xcd = wgid % NXCD, off = wgid / NXCD; wgid = (xcd < r ? xcd * (q + 1) : r * (q + 1) + (xcd - r) * q) + off; }
        const int nig = WGM * nN, gid = wgid / nig, fm = gid * WGM, gsz = (nM - fm) < WGM ? (nM - fm) : WGM;
        u.pm = fm + ((wgid % nig) % gsz); u.pn = (wgid % nig) / gsz; u.e = i; u.A = A + (size_t)u.pm * tsA; u.B = B + (size_t)u.pn * tsB; return true;
    }
};

typedef int i32x4 __attribute__((ext_vector_type(4)));
template <bool I8> struct AccSel { typedef f32x4 type; };
template <> struct AccSel<true> { typedef i32x4 type; };
__device__ __forceinline__ f32x4 mma16(bf16x8 a, bf16x8 b, f32x4 c) { return __builtin_amdgcn_mfma_f32_16x16x32_bf16(a, b, c, 0, 0, 0); }
__device__ __forceinline__ i32x4 mma16(bf16x8 a, bf16x8 b, i32x4 c) { return __builtin_amdgcn_mfma_i32_16x16x64_i8(__builtin_bit_cast(i32x4, a), __builtin_bit_cast(i32x4, b), c, 0, 0, 0); }
typedef int i32x8 __attribute__((ext_vector_type(8)));
__device__ __forceinline__ f32x4 mma16f8(bf16x8 b0, bf16x8 b1, bf16x8 a0, bf16x8 a1, f32x4 c) {
    const i32x4 B0 = __builtin_bit_cast(i32x4, b0), B1 = __builtin_bit_cast(i32x4, b1), A0 = __builtin_bit_cast(i32x4, a0), A1 = __builtin_bit_cast(i32x4, a1);
    const i32x8 B8 = {B0[0], B0[1], B0[2], B0[3], B1[0], B1[1], B1[2], B1[3]}, A8 = {A0[0], A0[1], A0[2], A0[3], A1[0], A1[1], A1[2], A1[3]};
    asm volatile("v_mfma_f32_16x16x128_f8f6f4 %0, %1, %2, %0" : "+v"(c) : "v"(B8), "v"(A8));
    return c;
}
template <class S_> struct IsGather { template <class T> static char f(decltype(&T::rows)); template <class T> static int f(...); static constexpr bool v = sizeof(f<S_>(nullptr)) == 1; };
template <class Epi, class Sched, bool ALIGN_EPI, bool I8 = false, bool F8 = false>
__device__ __forceinline__ void gemm_phase(PG8_LAS unsigned char* lds, const Gemm g, const Sched& S, const Epi& E) {
    const int tid = threadIdx.x, wid = __builtin_amdgcn_readfirstlane(tid >> 6), lane = tid & 63, wr = wid >> 2, wc = wid & 3, fr = lane & 15, fq = lane >> 4;
    const int K = g.K, nt = K / BK;
    unsigned voffA[2], voffB[2];
#pragma unroll
    for (int i = 0; i < 2; ++i) { int R, C; stage_rc(tid * 16 + i * 8192, R, C); const int Rb = Epi::PERM ? ((R & ~31) + perm32(R & 31)) : R;
        voffA[i] = (unsigned)(R * g.lda + C) * 2u; voffB[i] = (unsigned)(Rb * g.ldb + C) * 2u; }
    const size_t kstep = (size_t)(BK * 2);
    const size_t hstepA = (size_t)HALF * g.lda * 2, hstepB = (size_t)HALF * g.ldb * 2;
    const unsigned ldsw = (unsigned)wid * 1024u;
    const int aoff = lds_byte(wr * 64 + fr, fq * 8), boff = lds_byte(wc * 32 + fr, fq * 8);
#define PG8_SA(b, h) (((b) * 2 + (h)) * HTB)
#define PG8_SB(b, h) ((4 + (b) * 2 + (h)) * HTB)
#define PG8_STAGE(bufoff, gbase, voff) do { _Pragma("unroll") for (int _i = 0; _i < 2; ++_i) \
        __builtin_amdgcn_global_load_lds((const unsigned*)((const char*)(gbase) + (voff)[_i]), (PG8_LAS unsigned*)(lds + (bufoff) + ldsw + _i * 8192), 16, 0, 0); } while (0)
#define PG8_STAGE_A(b, h, base, v0, v1) do { if constexpr (GA) { if ((h) == 0) PG8_STAGE(PG8_SA(b, h), base, v0); else PG8_STAGE(PG8_SA(b, h), base, v1); } \
        else PG8_STAGE(PG8_SA(b, h), (h) ? (base) + hstepA : (base), voffA); } while (0)
#define PG8_LDA(dst, b, h) do { _Pragma("unroll") for (int m = 0; m < 4; ++m) _Pragma("unroll") for (int k = 0; k < 2; ++k) dst[m][k] = *(const PG8_LAS bf16x8*)(lds + PG8_SA(b, h) + aoff + m * 2048 + k * 1024); } while (0)
#define PG8_LDB(dst, b, h) do { _Pragma("unroll") for (int n = 0; n < 2; ++n) _Pragma("unroll") for (int k = 0; k < 2; ++k) dst[n][k] = *(const PG8_LAS bf16x8*)(lds + PG8_SB(b, h) + boff + n * 2048 + k * 1024); } while (0)
#define PG8_MMA(ai, bj, At, Bt) do { __builtin_amdgcn_s_setprio(1); _Pragma("unroll") for (int m = 0; m < 4; ++m) _Pragma("unroll") for (int n = 0; n < 2; ++n) { \
        if constexpr (F8) acc[ai][bj][m][n] = mma16f8(Bt[n][0], Bt[n][1], At[m][0], At[m][1], acc[ai][bj][m][n]); \
        else { _Pragma("unroll") for (int k = 0; k < 2; ++k) acc[ai][bj][m][n] = mma16(Bt[n][k], At[m][k], acc[ai][bj][m][n]); } } __builtin_amdgcn_s_setprio(0); } while (0)
#define PG8_WAIT_V(n) asm volatile("s_waitcnt vmcnt(" #n ")" ::: "memory")
#define PG8_WAIT_L(n) asm volatile("s_waitcnt lgkmcnt(" #n ")" ::: "memory")
#define PG8_BAR __builtin_amdgcn_s_barrier()
#define PG8_SCHED __builtin_amdgcn_sched_barrier(0)
    Unit cur, nxt; int ui = 0;
    if (!S.next(0, cur)) return;
    constexpr bool GA = IsGather<Sched>::v;
    unsigned voffA1[2], nvA0[2], nvA1[2];
    int gR[2], gC[2];
    if constexpr (GA) {
#pragma unroll
        for (int i = 0; i < 2; ++i) { stage_rc(tid * 16 + i * 8192, gR[i], gC[i]);
            const int* rw = S.rows + (size_t)cur.pm * 256; voffA[i] = (unsigned)(rw[gR[i]] * g.lda + gC[i]) * 2u; voffA1[i] = (unsigned)(rw[128 + gR[i]] * g.lda + gC[i]) * 2u; nvA0[i] = voffA[i]; nvA1[i] = voffA1[i]; }
    }
    typedef typename AccSel<I8>::type acc_t;
    acc_t acc[2][2][4][2];
#pragma unroll
    for (int a = 0; a < 2; ++a)
#pragma unroll
        for (int b = 0; b < 2; ++b)
#pragma unroll
            for (int m = 0; m < 4; ++m)
#pragma unroll
                for (int n = 0; n < 2; ++n) acc[a][b][m][n] = (acc_t){0, 0, 0, 0};
    bf16x8 At[4][2], B0[2][2], B1[2][2];
    const char* cA = cur.A; const char* cB = cur.B;
    PG8_STAGE(PG8_SB(0, 0), cB, voffB); PG8_STAGE(PG8_SB(0, 1), cB + hstepB, voffB); PG8_STAGE_A(0, 0, cA, voffA, voffA1); PG8_STAGE_A(0, 1, cA, voffA, voffA1);
    if (wr == 1) PG8_BAR;
    PG8_WAIT_V(2); PG8_BAR;
    PG8_STAGE(PG8_SB(1, 0), cB + kstep, voffB); PG8_STAGE_A(1, 0, cA + kstep, voffA, voffA1); PG8_STAGE(PG8_SB(1, 1), cB + hstepB + kstep, voffB);
    PG8_WAIT_V(6); PG8_BAR;
    for (;;) {
        const bool has_next = S.next(ui + 1, nxt);
        const char* nA = has_next ? nxt.A : cA; const char* nB = has_next ? nxt.B : cB;
        if constexpr (GA) { if (has_next) { const int* rw = S.rows + (size_t)nxt.pm * 256;
#pragma unroll
            for (int i = 0; i < 2; ++i) { nvA0[i] = (unsigned)(rw[gR[i]] * g.lda + gC[i]) * 2u; nvA1[i] = (unsigned)(rw[128 + gR[i]] * g.lda + gC[i]) * 2u; } } }
        for (int t = 0; t < nt; t += 2) {
            const bool last = (t == nt - 2);
            const char* a1 = cA + (size_t)(t + 1) * kstep;
            const char* a2 = last ? nA : cA + (size_t)(t + 2) * kstep; const char* b2 = last ? nB : cB + (size_t)(t + 2) * kstep;
            const char* a3 = a2 + kstep; const char* b3 = b2 + kstep;
            unsigned w0[2], w1[2];
#pragma unroll
            for (int i = 0; i < 2; ++i) { w0[i] = (GA && last) ? nvA0[i] : voffA[i]; w1[i] = (GA && last) ? nvA1[i] : voffA1[i]; }
            PG8_LDB(B0, 0, 0); PG8_LDB(B1, 0, 1); PG8_SCHED; PG8_LDA(At, 0, 0); PG8_STAGE_A(1, 1, a1, voffA, voffA1);
            PG8_WAIT_V(8); PG8_WAIT_L(0); PG8_BAR; PG8_MMA(0, 0, At, B0); PG8_MMA(0, 1, At, B1); PG8_BAR; PG8_SCHED;
            PG8_LDA(At, 0, 1); PG8_STAGE(PG8_SB(0, 0), b2, voffB); PG8_STAGE(PG8_SB(0, 1), b2 + hstepB, voffB); PG8_STAGE_A(0, 0, a2, w0, w1);
            PG8_WAIT_V(8); PG8_WAIT_L(0); PG8_BAR; PG8_MMA(1, 0, At, B0); PG8_MMA(1, 1, At, B1); PG8_BAR; PG8_SCHED;
            PG8_LDB(B0, 1, 0); PG8_LDB(B1, 1, 1); PG8_SCHED; PG8_LDA(At, 1, 0); PG8_STAGE_A(0, 1, a2, w0, w1);
            PG8_WAIT_V(8); PG8_WAIT_L(0); PG8_BAR; PG8_MMA(0, 0, At, B0); PG8_MMA(0, 1, At, B1); PG8_BAR; PG8_SCHED;
            PG8_LDA(At, 1, 1); PG8_STAGE(PG8_SB(1, 0), b3, voffB); PG8_STAGE(PG8_SB(1, 1), b3 + hstepB, voffB); PG8_STAGE_A(1, 0, a3, w0, w1);
            PG8_WAIT_V(8); PG8_WAIT_L(0); PG8_BAR; PG8_MMA(1, 0, At, B0); PG8_MMA(1, 1, At, B1); PG8_BAR; PG8_SCHED;
        }
        if constexpr (ALIGN_EPI) { if (wr == 0) PG8_BAR; }
        if constexpr (F8) {
            asm volatile("s_nop 15\n\ts_nop 15" ::: "memory");
#pragma unroll
            for (int a = 0; a < 2; ++a)
#pragma unroll
                for (int b = 0; b < 2; ++b)
#pragma unroll
                    for (int m = 0; m < 4; ++m)
#pragma unroll
                        for (int n = 0; n < 2; ++n) asm volatile("" : "+v"(acc[a][b][m][n]));
        }
        E(acc, cur, wr, wc, fr, fq);
        if (!has_next) break;
#pragma unroll
        for (int a = 0; a < 2; ++a)
#pragma unroll
            for (int b = 0; b < 2; ++b)
#pragma unroll
                for (int m = 0; m < 4; ++m)
#pragma unroll
                    for (int n = 0; n < 2; ++n) acc[a][b][m][n] = (acc_t){0, 0, 0, 0};
        cur = nxt; cA = nA; cB = nB; ++ui;
        if constexpr (GA) {
#pragma unroll
            for (int i = 0; i < 2; ++i) { voffA[i] = nvA0[i]; voffA1[i] = nvA1[i]; } }
        if constexpr (ALIGN_EPI) { if (wr == 1) PG8_BAR; }
    }
    PG8_WAIT_V(0);
    if constexpr (!ALIGN_EPI) { if (wr == 0) PG8_BAR; }
    PG8_BAR;
#undef PG8_SA
#undef PG8_SB
#undef PG8_STAGE
#undef PG8_STAGE_A
#undef PG8_LDA
#undef PG8_LDB
#undef PG8_MMA
#undef PG8_WAIT_V
#undef PG8_WAIT_L
#undef PG8_BAR
#undef PG8_SCHED
}
}

namespace att {
constexpr int D = 128;
constexpr float THR = 8.f;
constexpr bool WSKIP = false;
constexpr float SCALE = 0.08838834764831845f;
constexpr int NW = 8, QBLK = 32, KVBLK = 64, QB = NW * QBLK;
constexpr int SHM_V = KVBLK * D * 2, SHM_K = KVBLK * D * 2;
constexpr int LDS_BYTES = 2 * SHM_V + 2 * SHM_K + NW * 64 * 4;
static_assert(D == 128, "geometry");

using bf16 = __hip_bfloat16;
typedef short bf16x8 __attribute__((ext_vector_type(8)));
typedef short s16x4 __attribute__((ext_vector_type(4)));
typedef float f32x16 __attribute__((ext_vector_type(16)));
typedef float f32x4 __attribute__((ext_vector_type(4)));
typedef unsigned u32x4 __attribute__((ext_vector_type(4)));
template <class A, class Bt> struct same_t { static constexpr bool v = false; };
template <class A> struct same_t<A, A> { static constexpr bool v = true; };

#define KSWZ(row, colB) ((row) * 256 + ((colB) ^ (((row) & 7) << 4)))
#define SBAR() __builtin_amdgcn_sched_barrier(0)
__device__ __forceinline__ int v_st(int k, int c) { const int kk = (k & ~0xC) | ((k & 4) << 1) | ((k & 8) >> 1); return ((kk >> 3) * 4 + (c >> 5)) * 512 + ((kk & 7) * 32 + (c & 31)) * 2; }
__device__ __forceinline__ int v_rd_base(int lane) { return ((lane & 3) << 3) | (((lane >> 2) & 3) << 6) | (((lane >> 4) & 1) << 5) | (((lane >> 5) & 1) << 8); }
constexpr int v_rd_off(int d0, int ks, int half) { return d0 * 512 + ks * 4096 + half * 2048; }
__device__ __forceinline__ int crow(int r, int hi) { return (r & 3) + 8 * (r >> 2) + 4 * hi; }
__device__ __forceinline__ unsigned cvtpk(float lo, float hi) {
    unsigned r; asm volatile("v_cvt_pk_bf16_f32 %0, %1, %2" : "=v"(r) : "v"(lo), "v"(hi)); return r;
}
__device__ __forceinline__ bf16x8 pack8(f32x4 a, f32x4 b) {
    u32x4 w = {cvtpk(a[0], a[1]), cvtpk(a[2], a[3]), cvtpk(b[0], b[1]), cvtpk(b[2], b[3])};
    return *reinterpret_cast<bf16x8*>(&w);
}
template <class T> __device__ __forceinline__ bf16x8 load8(const T* p) {
    if constexpr (same_t<T, float>::v) { return pack8(*(const f32x4*)p, *(const f32x4*)(p + 4)); }
    else { return *reinterpret_cast<const bf16x8*>(p); }
}
__device__ __forceinline__ void mask_tile(f32x16& p0, f32x16& p1, int dq, unsigned W) {
    const float NEG = -__builtin_inff();
#pragma unroll
    for (int r = 0; r < 16; ++r) {
        const int c = (r & 3) + 8 * (r >> 2);
        if ((unsigned)(dq - c) >= W) p0[r] = NEG;
        if ((unsigned)(dq - c - 32) >= W) p1[r] = NEG;
    }
}
__device__ __forceinline__ void partialSM(f32x16& p0, f32x16& p1, float& m_reg, float& mn, float& alpha) {
    float pmax = p0[0]; for (int r = 1; r < 16; ++r) pmax = fmaxf(pmax, p0[r]); for (int r = 0; r < 16; ++r) pmax = fmaxf(pmax, p1[r]);
    { auto rr = __builtin_amdgcn_permlane32_swap(__float_as_uint(pmax), __float_as_uint(pmax), false, false);
      pmax = fmaxf(__uint_as_float(rr[0]), __uint_as_float(rr[1])); }
    constexpr float C2 = 1.4426950408889634f * SCALE;
    if (__builtin_expect(__all((pmax - m_reg) * SCALE <= THR), 1)) { mn = m_reg; alpha = 1.f; }
    else { mn = fmaxf(m_reg, pmax); alpha = __builtin_amdgcn_exp2f((m_reg - mn) * C2); m_reg = mn; }
    const float mnL = -mn * C2;
    for (int r = 0; r < 16; ++r) p0[r] = fmaf(p0[r], C2, mnL); for (int r = 0; r < 16; ++r) p1[r] = fmaf(p1[r], C2, mnL);
    for (int r = 0; r < 16; ++r) p0[r] = __builtin_amdgcn_exp2f(p0[r]);
}
__device__ __forceinline__ void finishSM(f32x16& p0, f32x16& p1, float alpha, float& l_reg, bf16x8& pa0, bf16x8& pa1, bf16x8& pa2, bf16x8& pa3) {
    for (int r = 0; r < 16; ++r) p1[r] = __builtin_amdgcn_exp2f(p1[r]);
    float ps = 0; for (int r = 0; r < 16; ++r) ps += p0[r]; for (int r = 0; r < 16; ++r) ps += p1[r];
    { auto rr = __builtin_amdgcn_permlane32_swap(__float_as_uint(ps), __float_as_uint(ps), false, false);
      ps = __uint_as_float(rr[0]) + __uint_as_float(rr[1]); }
    l_reg = l_reg * alpha + ps;
#define PK4(P, B_, OUT) do { unsigned a0 = cvtpk(P[B_+0], P[B_+1]), a1 = cvtpk(P[B_+2], P[B_+3]);                          \
        unsigned b0 = cvtpk(P[B_+4], P[B_+5]), b1 = cvtpk(P[B_+6], P[B_+7]);                                             \
        auto r0 = __builtin_amdgcn_permlane32_swap(a0, b0, false, false); auto r1 = __builtin_amdgcn_permlane32_swap(a1, b1, false, false); \
        u32x4 w = {r0[0], r1[0], r0[1], r1[1]}; OUT = *reinterpret_cast<bf16x8*>(&w); } while (0)
    PK4(p0, 0, pa0); PK4(p0, 8, pa1); PK4(p1, 0, pa2); PK4(p1, 8, pa3);
#undef PK4
}
template <int KB, bool SK>
__device__ __forceinline__ void qkt(f32x16& p0, f32x16& p1, const char* K_lds, int r32, int hi, const bf16x8* qr, bool act) {
    if (SK && !act) { const float NEG = -__builtin_inff();
#pragma unroll
        for (int r = 0; r < 16; ++r) { p0[r] = NEG; p1[r] = NEG; } return; }
    p0 = f32x16{}; p1 = f32x16{};
    const char* kb[4];
#pragma unroll
    for (int dd = 0; dd < 4; ++dd) kb[dd] = K_lds + KB * SHM_K + KSWZ(r32, (dd * 16 + hi * 8) * 2);
#pragma unroll
    for (int d0 = 0; d0 < 8; ++d0) { const char* a = kb[d0 & 3] + (d0 >> 2) * 128;
        bf16x8 b0 = *reinterpret_cast<const bf16x8*>(a);
        bf16x8 b1 = *reinterpret_cast<const bf16x8*>(a + 32 * 256);
        p0 = __builtin_amdgcn_mfma_f32_32x32x16_bf16(b0, qr[d0], p0, 0, 0, 0);
        p1 = __builtin_amdgcn_mfma_f32_32x32x16_bf16(b1, qr[d0], p1, 0, 0, 0); }
}
template <int VB, bool SK>
__device__ __forceinline__ void pv_tile(f32x16* o, int vb0, bf16x8 pa0, bf16x8 pa1, bf16x8 pa2, bf16x8 pa3, bool act) {
    if (SK && !act) return;
#define TRRD(dst, off) asm volatile("ds_read_b64_tr_b16 %0, %1 offset:%2" : "=&v"(dst) : "v"(vb0), "i"(off) : "memory")
#define PV_D0(d0) do { s16x4 l0, l1, l2, l3, h0, h1, h2, h3; constexpr int b_ = VB * SHM_V + v_rd_off(d0, 0, 0);     \
        TRRD(l0, b_); TRRD(h0, b_ + 2048); TRRD(l1, b_ + 4096); TRRD(h1, b_ + 6144); TRRD(l2, b_ + 8192); TRRD(h2, b_ + 10240); TRRD(l3, b_ + 12288); TRRD(h3, b_ + 14336); \
        asm volatile("s_waitcnt lgkmcnt(0)" ::: "memory"); SBAR();                 \
        o[d0] = __builtin_amdgcn_mfma_f32_32x32x16_bf16(pa0, (bf16x8){l0[0], l0[1], l0[2], l0[3], h0[0], h0[1], h0[2], h0[3]}, o[d0], 0, 0, 0);   \
        o[d0] = __builtin_amdgcn_mfma_f32_32x32x16_bf16(pa1, (bf16x8){l1[0], l1[1], l1[2], l1[3], h1[0], h1[1], h1[2], h1[3]}, o[d0], 0, 0, 0);   \
        o[d0] = __builtin_amdgcn_mfma_f32_32x32x16_bf16(pa2, (bf16x8){l2[0], l2[1], l2[2], l2[3], h2[0], h2[1], h2[2], h2[3]}, o[d0], 0, 0, 0);   \
        o[d0] = __builtin_amdgcn_mfma_f32_32x32x16_bf16(pa3, (bf16x8){l3[0], l3[1], l3[2], l3[3], h3[0], h3[1], h3[2], h3[3]}, o[d0], 0, 0, 0); } while (0)
    PV_D0(0); PV_D0(1); PV_D0(2); PV_D0(3);
#undef PV_D0
#undef TRRD
}

template <class TIn, class TOut> struct BlockRef { const TIn* Q; const TIn* K; const TIn* V; TOut* O; int P0; };
template <class TIn> struct Seam {
    bf16x8 qr[8];
    bf16x8 st_v0, st_v1, st_k0, st_k1; f32x4 sf0, sf1, sf2, sf3;
    f32x4 tq[16];
};
__device__ __forceinline__ int swa_jlo(int P0, int W) { const int lowk = P0 - W + 1; return lowk > 0 ? lowk / KVBLK : 0; }
#define ROW(p, k0, rr) ((p) + (size_t)((k0) + (rr)) * D + sc)
#define VMW() asm volatile("s_waitcnt vmcnt(0)" ::: "memory")
#define VMWN(n) asm volatile("s_waitcnt vmcnt(%0)" :: "i"(n) : "memory")
#define SLOAD_H(Kp, Vp, k0) do { S.st_v0 = load8<TIn>(ROW(Vp, k0, sr)); S.st_v1 = load8<TIn>(ROW(Vp, k0, 32 + sr));              \
                         S.st_k0 = load8<TIn>(ROW(Kp, k0, sr)); S.st_k1 = load8<TIn>(ROW(Kp, k0, 32 + sr)); } while (0)
#define SWRITE_HK(bf) do { *(bf16x8*)(K_lds + (bf) * SHM_K + kws) = S.st_k0; *(bf16x8*)(K_lds + (bf) * SHM_K + kws + 32 * 256) = S.st_k1; } while (0)
#define SWRITE_HV(bf) do { *(bf16x8*)(V_lds + (bf) * SHM_V + vst0) = S.st_v0; *(bf16x8*)(V_lds + (bf) * SHM_V + vst1) = S.st_v1; } while (0)
#define SWRITE_H(bf) do { SWRITE_HV(bf); SWRITE_HK(bf); } while (0)
#define SLOAD_F(p, k0) do { S.sf0 = *(const f32x4*)ROW(p, k0, sr); S.sf1 = *(const f32x4*)(ROW(p, k0, sr) + 4);                \
                            S.sf2 = *(const f32x4*)ROW(p, k0, 32 + sr); S.sf3 = *(const f32x4*)(ROW(p, k0, 32 + sr) + 4); } while (0)
#define SWRITE_KF(bf) do { *(bf16x8*)(K_lds + (bf) * SHM_K + kws) = pack8(S.sf0, S.sf1); *(bf16x8*)(K_lds + (bf) * SHM_K + kws + 32 * 256) = pack8(S.sf2, S.sf3); } while (0)
#define SWRITE_VF(bf) do { *(bf16x8*)(V_lds + (bf) * SHM_V + vst0) = pack8(S.sf0, S.sf1); *(bf16x8*)(V_lds + (bf) * SHM_V + vst1) = pack8(S.sf2, S.sf3); } while (0)
template <class TIn, class TOut>
__device__ __forceinline__ void causal_swa_prime(const BlockRef<TIn, TOut>& cur, int W, char* lds, Seam<TIn>& S) {
    constexpr bool F32 = same_t<TIn, float>::v;
    const int tid = threadIdx.x, wid = __builtin_amdgcn_readfirstlane(tid >> 6), lane = tid & 63, r32 = lane & 31, hi = lane >> 5;
    const int sr = tid >> 4, sc = (tid & 15) * 8, kws = KSWZ(sr, sc * 2); char* K_lds = lds + 2 * SHM_V;
    const int kb0 = swa_jlo(cur.P0, W) * KVBLK;
    for (int d0 = 0; d0 < 8; ++d0) S.qr[d0] = load8<TIn>(cur.Q + (size_t)(wid * QBLK + r32) * D + d0 * 16 + hi * 8);
    if constexpr (F32) { SLOAD_F((const float*)cur.K, kb0); VMW(); SWRITE_KF(0); SBAR(); SLOAD_F((const float*)cur.V, kb0); }
    else { SLOAD_H(cur.K, cur.V, kb0); VMW(); SWRITE_HK(0); }
    __syncthreads();
}
template <class TIn, class TOut>
__device__ __forceinline__ void causal_swa_block(const BlockRef<TIn, TOut>& cur, const BlockRef<TIn, TOut>& nxt, int skv, int W, char* lds, Seam<TIn>& S) {
    constexpr bool F32 = same_t<TIn, float>::v;
    const int tid = threadIdx.x, wid = __builtin_amdgcn_readfirstlane(tid >> 6), lane = tid & 63, r32 = lane & 31, hi = lane >> 5;
    const int j_lo = swa_jlo(cur.P0, W);
    int j_hi = (cur.P0 + QB - 1) / KVBLK + 1; if (j_hi > skv / KVBLK) j_hi = skv / KVBLK;
    const int NT = j_hi - j_lo;
    const int kbn = swa_jlo(nxt.P0, W) * KVBLK;
    const int qlo = cur.P0 + wid * QBLK, qm = qlo + r32 - 4 * hi;
    char* V_lds = lds; char* K_lds = lds + 2 * SHM_V;
    float* ws = (float*)(lds + 2 * SHM_V + 2 * SHM_K) + wid * 64; float* li_l = ws, * al_l = ws + 32;
    float m_reg = -1e30f, l_reg = 0; f32x16 o[4] = {};
    const int sr = tid >> 4, sc = (tid & 15) * 8, vst0 = v_st(sr, sc), vst1 = v_st(32 + sr, sc), kws = KSWZ(sr, sc * 2);
    const int vb0 = (int)(uintptr_t)V_lds + v_rd_base(lane);
    const TIn* Kh = cur.K; const TIn* Vh = cur.V;
#define RESC(a) do { if (__any((a) < 1.f)) { if (hi == 0) al_l[r32] = (a); asm volatile("s_waitcnt lgkmcnt(0)" ::: "memory");              \
                     for (int d_ = 0; d_ < 4; ++d_) for (int r = 0; r < 16; ++r) o[d_][r] *= al_l[crow(r, hi)]; } } while (0)
#define KBASE(t) ((j_lo + (t)) * KVBLK)
#define ACT(t) (KBASE(t) <= qlo + QBLK - 1 && KBASE(t) + KVBLK - 1 >= qlo - W + 1)
#define MASKT(P0_, P1_, t) do { const int kb_ = KBASE(t); if ((!SK || ACT(t)) && (kb_ + KVBLK - 1 > qlo || kb_ <= qlo + QBLK - 1 - W)) mask_tile(P0_, P1_, qm - kb_, (unsigned)W); } while (0)
    constexpr int NQL = F32 ? 16 : 8;
    constexpr bool SK = WSKIP && !F32;
#define SEAM_K0() do { VMWN(NQL); if constexpr (F32) { SWRITE_KF(0); SBAR(); SLOAD_F((const float*)nxt.V, kbn); } else { SWRITE_HK(0); } SBAR(); } while (0)
    f32x16 pA0, pA1, pB0, pB1; float mnA, mnB, alA, alB; bf16x8 pa0, pa1, pa2, pa3;
    if constexpr (F32) { VMW(); SWRITE_VF(0); SBAR(); } else { SWRITE_HV(0); SBAR(); }
    if (NT > 1) { if constexpr (F32) SLOAD_F((const float*)Kh, KBASE(1)); else SLOAD_H(Kh, Vh, KBASE(1)); }
    SBAR(); qkt<0, SK>(pA0, pA1, K_lds, r32, hi, S.qr, ACT(0));
    if constexpr (F32) { if (NT > 1) { VMW(); SWRITE_KF(1); SBAR(); SLOAD_F((const float*)Vh, KBASE(1)); } }
    MASKT(pA0, pA1, 0); partialSM(pA0, pA1, m_reg, mnA, alA);
    if (NT > 1) { VMW(); if constexpr (F32) { SWRITE_VF(1); SBAR(); if (NT > 2) SLOAD_F((const float*)Kh, KBASE(2)); } else SWRITE_H(1); }
    __syncthreads();
#define HALF_STEP(PX0, PX1, mnX, alX, PY0, PY1, alY, t, KB, VB, SB) do {                                                      \
        SBAR(); qkt<KB, SK>(PX0, PX1, K_lds, r32, hi, S.qr, ACT(t));                                             \
        finishSM(PY0, PY1, alY, l_reg, pa0, pa1, pa2, pa3); SBAR();                                                           \
        if ((t) + 1 < NT) { if constexpr (F32) { VMW(); SWRITE_KF(SB); SBAR(); SLOAD_F((const float*)Vh, KBASE((t) + 1)); }  \
                            else { SLOAD_H(Kh, Vh, KBASE((t) + 1)); } SBAR(); }                                               \
        pv_tile<VB, SK>(o, vb0, pa0, pa1, pa2, pa3, ACT((t) - 1)); MASKT(PX0, PX1, (t)); partialSM(PX0, PX1, m_reg, mnX, alX);                                        \
        __syncthreads();                                                                                                      \
        if ((t) + 1 < NT) { VMW(); if constexpr (F32) { SWRITE_VF(SB); SBAR(); if ((t) + 2 < NT) SLOAD_F((const float*)Kh, KBASE((t) + 2)); } \
                            else { SWRITE_H(SB); } }                                                                          \
        RESC(alX); __syncthreads(); } while (0)
    for (int t = 1; t + 1 < NT; t += 2) {
        HALF_STEP(pB0, pB1, mnB, alB, pA0, pA1, alA, t, 1, 0, 0);
        HALF_STEP(pA0, pA1, mnA, alA, pB0, pB1, alB, t + 1, 0, 1, 1);
    }
    const bool even = (NT & 1) == 0;
    if (even) { SBAR(); qkt<1, SK>(pB0, pB1, K_lds, r32, hi, S.qr, ACT(NT - 1)); SBAR(); }
#define QROW(e) (nxt.Q + (size_t)(wid * QBLK + r32) * D + ((e) >> 1) * 16 + hi * 8 + ((e) & 1) * 4)
    if constexpr (F32) { SLOAD_F((const float*)nxt.K, kbn); SBAR();
#pragma unroll
        for (int e = 0; e < 8; ++e) S.tq[e] = *(const f32x4*)QROW(e); }
    else { SLOAD_H(nxt.K, nxt.V, kbn); SBAR();
#pragma unroll
        for (int d0 = 0; d0 < 8; ++d0) S.qr[d0] = load8<TIn>(nxt.Q + (size_t)(wid * QBLK + r32) * D + d0 * 16 + hi * 8); }
    SBAR();
    finishSM(pA0, pA1, alA, l_reg, pa0, pa1, pa2, pa3); SBAR();
    if constexpr (F32) {
#pragma unroll
        for (int e = 8; e < 16; ++e) S.tq[e] = *(const f32x4*)QROW(e); SBAR(); }
#undef QROW
    pv_tile<0, SK>(o, vb0, pa0, pa1, pa2, pa3, ACT(even ? NT - 2 : NT - 1));
    if (even) { MASKT(pB0, pB1, NT - 1); partialSM(pB0, pB1, m_reg, mnB, alB); __syncthreads(); RESC(alB);
        finishSM(pB0, pB1, alB, l_reg, pa0, pa1, pa2, pa3); SBAR(); pv_tile<1, SK>(o, vb0, pa0, pa1, pa2, pa3, ACT(NT - 1)); }
    SBAR(); SEAM_K0();
    if (hi == 0) li_l[r32] = l_reg; asm volatile("s_waitcnt lgkmcnt(0)" ::: "memory");
    float rli[16];
#pragma unroll
    for (int r = 0; r < 16; ++r) rli[r] = __builtin_amdgcn_rcpf(li_l[crow(r, hi)]);
    TOut* Ow = cur.O + (size_t)(wid * QBLK) * D;
#pragma unroll
    for (int r = 0; r < 16; ++r) { const int orow = crow(r, hi);
#pragma unroll
        for (int d0 = 0; d0 < 4; ++d0) { const float v = o[d0][r] * rli[r];
            if constexpr (same_t<TOut, float>::v) { Ow[(size_t)orow * D + d0 * 32 + r32] = v; }
            else { const float vn = __shfl_xor(v, 1);
                   if ((r32 & 1) == 0) *(unsigned*)(Ow + (size_t)orow * D + d0 * 32 + r32) = cvtpk(v, vn); } } }
    if constexpr (F32) {
#pragma unroll
        for (int d0 = 0; d0 < 8; ++d0) S.qr[d0] = pack8(S.tq[2 * d0], S.tq[2 * d0 + 1]); }
    __syncthreads();
#undef RESC
#undef KBASE
#undef ACT
#undef MASKT
#undef SEAM_K0
#undef HALF_STEP
}
#undef ROW
#undef VMW
#undef VMWN
#undef SLOAD_H
#undef SWRITE_HK
#undef SWRITE_HV
#undef SWRITE_H
#undef SLOAD_F
#undef SWRITE_KF
#undef SWRITE_VF

}

namespace att2 {
typedef unsigned short bf16_t;
using att::bf16x8; using att::s16x4; using att::f32x16; using att::f32x4; using att::u32x4; using att::cvtpk; using att::crow; using att::v_rd_base;
constexpr int OFF_K = 0  , OFF_V = 49152  , OFF_ML = 147456, OFF_AL = 149504, LDS_END = 150528;
constexpr float SCALE = 0.08838834764831845f, THR = 1.2f, THR16 = 8.f, C2 = 1.4426950408889634f * SCALE, PSH = 7.0f;
__device__ __forceinline__ int v_st256(int k, int c) { const int kk = (k & ~0xC) | ((k & 4) << 1) | ((k & 8) >> 1); return ((kk >> 3) * 8 + (c >> 5)) * 512 + ((kk & 7) * 32 + (c & 31)) * 2; }
#define A2_TRRD(dst, addr, off) asm volatile("ds_read_b64_tr_b16 %0, %1 offset:%2" : "=&v"(dst) : "v"(addr), "i"(off) : "memory")
#define A2_PK4(P, B_, OUT) do { unsigned a0_ = cvtpk(P[B_+0], P[B_+1]), a1_ = cvtpk(P[B_+2], P[B_+3]); unsigned b0_ = cvtpk(P[B_+4], P[B_+5]), b1_ = cvtpk(P[B_+6], P[B_+7]);  \
        auto r0_ = __builtin_amdgcn_permlane32_swap(a0_, b0_, false, false); auto r1_ = __builtin_amdgcn_permlane32_swap(a1_, b1_, false, false); \
        u32x4 w_ = {r0_[0], r1_[0], r0_[1], r1_[1]}; OUT = *reinterpret_cast<bf16x8*>(&w_); } while (0)

__device__ __forceinline__ void attn_block_b16(const bf16_t* __restrict__ Qg, const bf16_t* __restrict__ Kg, const bf16_t* __restrict__ Vg, bf16_t* __restrict__ Og, int qb, char* lds) {
    int tid = threadIdx.x; asm volatile("" : "+v"(tid));
    const int wid = __builtin_amdgcn_readfirstlane(tid >> 6), lane = tid & 63, r32 = lane & 31, hi = lane >> 5;
    const int P0 = qb * 256, NT = 4 * qb + 4, qlo = P0 + 32 * wid, qm = qlo + r32 - 4 * hi, NTW = (qlo >> 6) + 1;
    char* K_lds = lds + OFF_K; char* V_lds = lds + OFF_V;
    float* Ll = (float*)(lds + OFF_ML) + wid * 32; float* al_l = (float*)(lds + OFF_AL) + wid * 32;
    typedef __attribute__((address_space(3))) unsigned lds_u32;
    const int krow = lane >> 4, kslot = lane & 15;
    unsigned koff[2];
#pragma unroll
    for (int i = 0; i < 2; ++i) { const int r = 8 * wid + 4 * i + krow; koff[i] = (unsigned)(r * 256 + ((kslot ^ (r & 7)) << 4)); }
    unsigned voff[4];
#pragma unroll
    for (int i = 0; i < 4; ++i) { const int q = 64 * i + lane, stl = q >> 5, kk = 8 * wid + ((q & 31) >> 2), jj = q & 3;
        const int k = (kk & ~0xC) | ((kk & 4) << 1) | ((kk & 8) >> 1); voff[i] = (unsigned)(k * 512 + (stl * 32 + jj * 8) * 2); }
    const lds_u32* kdst = (const lds_u32*)((__attribute__((address_space(3))) char*)K_lds + wid * 2048);
    const lds_u32* vdst = (const lds_u32*)((__attribute__((address_space(3))) char*)V_lds + wid * 4096);
#define A2_DMAK(i) __builtin_amdgcn_global_load_lds((const unsigned*)(kgn + koff[i]), (lds_u32*)((__attribute__((address_space(3))) char*)kdst + bn2 * 16384 + (i) * 1024), 16, 0, 0)
#define A2_DMAV(i) __builtin_amdgcn_global_load_lds((const unsigned*)(vgn + voff[i]), (lds_u32*)((__attribute__((address_space(3))) char*)vdst + bn2 * 32768 + (i) * 1024), 16, 0, 0)
#define A2_DMA(k0, bf) do { const char* kg_ = (const char*)(Kg + (size_t)(k0) * 128); const char* vg_ = (const char*)(Vg + (size_t)(k0) * 256);                       \
        _Pragma("unroll") for (int i = 0; i < 2; ++i) __builtin_amdgcn_global_load_lds((const unsigned*)(kg_ + koff[i]), (lds_u32*)((__attribute__((address_space(3))) char*)kdst + (bf) * 16384 + i * 1024), 16, 0, 0); \
        _Pragma("unroll") for (int i = 0; i < 4; ++i) __builtin_amdgcn_global_load_lds((const unsigned*)(vg_ + voff[i]), (lds_u32*)((__attribute__((address_space(3))) char*)vdst + (bf) * 32768 + i * 1024), 16, 0, 0); } while (0)
    bf16x8 qf[8];
#pragma unroll
    for (int d0 = 0; d0 < 8; ++d0) qf[d0] = *(const bf16x8*)(Qg + (size_t)(qlo + r32) * 128 + d0 * 16 + hi * 8);
#define A2_BAR(n) do { asm volatile("s_waitcnt vmcnt(" #n ")" ::: "memory"); asm volatile("s_waitcnt lgkmcnt(0)" ::: "memory"); __builtin_amdgcn_s_barrier(); asm volatile("" ::: "memory"); } while (0)
    A2_DMA(0, 0); A2_DMA(64, 1);
    A2_BAR(6);
    float m_reg = -1e30f, l_reg = 0.f;
    f32x16 o[8];
#pragma unroll
    for (int d = 0; d < 8; ++d) o[d] = f32x16{};
    const int vrd0 = (int)(uintptr_t)V_lds + v_rd_base(lane);
    int buf = 0;
    int t = 0;
    for (; t < NTW; ++t) {
        const int kb = t * 64; const int bn2 = buf == 0 ? 2 : buf - 1;
        const bool more = t + 2 < NT;
        const char* kgn = (const char*)(Kg + (size_t)(kb + 128) * 128); const char* vgn = (const char*)(Vg + (size_t)(kb + 128) * 256);
        __builtin_amdgcn_sched_barrier(0);
        {
        bf16x8 pa0, pa1, pa2, pa3;
        const bool mset = m_reg > -1e29f; const float a0 = mset ? -m_reg : 0.f;
        f32x16 p0, p1;
#pragma unroll
        for (int r = 0; r < 16; ++r) { p0[r] = a0; p1[r] = a0; }
        {
            const int kp = (int)(uintptr_t)K_lds + buf * 16384;
            const int kad0 = kp + KSWZ(r32, 0 + hi * 16), kad1 = kp + KSWZ(r32, 32 + hi * 16), kad2 = kp + KSWZ(r32, 64 + hi * 16), kad3 = kp + KSWZ(r32, 96 + hi * 16);
            bf16x8 ka, kb_, kc;
#define A2_KRD(AD, OFF, X0) asm volatile("ds_read_b128 %0, %1 offset:%2" : "=&v"(X0) : "v"(AD), "i"(OFF) : "memory")
#define A2_KMM(P, d0, X0) do { P = __builtin_amdgcn_mfma_f32_32x32x16_bf16(X0, qf[d0], P, 0, 0, 0); __builtin_amdgcn_sched_barrier(0); } while (0)
#define A2_KLW(n) do { asm volatile("s_waitcnt lgkmcnt(" #n ")" ::: "memory"); __builtin_amdgcn_sched_barrier(0); } while (0)
            A2_KRD(kad0, 0, ka); A2_KRD(kad1, 0, kb_); A2_KRD(kad2, 0, kc);
            A2_KLW(2); A2_KMM(p0, 0, ka); A2_KRD(kad3, 0, ka);
            A2_KLW(2); A2_KMM(p0, 1, kb_); A2_KRD(kad0, 128, kb_);
            A2_KLW(2); A2_KMM(p0, 2, kc); A2_KRD(kad1, 128, kc);
            A2_KLW(2); A2_KMM(p0, 3, ka); A2_KRD(kad2, 128, ka);
            A2_KLW(2); A2_KMM(p0, 4, kb_); A2_KRD(kad3, 128, kb_);
            A2_KLW(2); A2_KMM(p0, 5, kc); A2_KRD(kad0, 8192, kc);
            A2_KLW(2); A2_KMM(p0, 6, ka); A2_KRD(kad1, 8192, ka);
            A2_KLW(2); A2_KMM(p0, 7, kb_); A2_KRD(kad2, 8192, kb_);
            A2_KLW(2); A2_KMM(p1, 0, kc); A2_KRD(kad3, 8192, kc);
            A2_KLW(2); A2_KMM(p1, 1, ka); A2_KRD(kad0, 8320, ka);
            A2_KLW(2); A2_KMM(p1, 2, kb_); A2_KRD(kad1, 8320, kb_);
            A2_KLW(2); A2_KMM(p1, 3, kc); A2_KRD(kad2, 8320, kc);
            A2_KLW(2); A2_KMM(p1, 4, ka); A2_KRD(kad3, 8320, ka);
            A2_KLW(2); A2_KMM(p1, 5, kb_);
            A2_KLW(1); A2_KMM(p1, 6, kc);
            A2_KLW(0); A2_KMM(p1, 7, ka);
#undef A2_KRD
#undef A2_KMM
#undef A2_KLW
        }
        if (kb + 63 > qlo) {
            const int dq = qm - kb; const float NEG = -__builtin_inff();
#pragma unroll
            for (int r = 0; r < 16; ++r) { const int c = (r & 3) + 8 * (r >> 2); if (dq - c < 0) p0[r] = NEG; if (dq - c - 32 < 0) p1[r] = NEG; }
        }
        {
            float pmax = fmaxf(fmaxf(fmaxf(p0[0], p0[1]), fmaxf(p0[2], p0[3])), fmaxf(fmaxf(p0[4], p0[5]), fmaxf(p0[6], p0[7])));
            pmax = fmaxf(pmax, fmaxf(fmaxf(fmaxf(p0[8], p0[9]), fmaxf(p0[10], p0[11])), fmaxf(fmaxf(p0[12], p0[13]), fmaxf(p0[14], p0[15]))));
            float pmx1 = fmaxf(fmaxf(fmaxf(p1[0], p1[1]), fmaxf(p1[2], p1[3])), fmaxf(fmaxf(p1[4], p1[5]), fmaxf(p1[6], p1[7])));
            pmx1 = fmaxf(pmx1, fmaxf(fmaxf(fmaxf(p1[8], p1[9]), fmaxf(p1[10], p1[11])), fmaxf(fmaxf(p1[12], p1[13]), fmaxf(p1[14], p1[15]))));
            pmax = fmaxf(pmax, pmx1);
            { auto rr = __builtin_amdgcn_permlane32_swap(__float_as_uint(pmax), __float_as_uint(pmax), false, false); pmax = fmaxf(__uint_as_float(rr[0]), __uint_as_float(rr[1])); }
            float alpha = 1.f;
            if (!__builtin_expect(__all(mset && pmax <= THR16 * 1.4426950408889634f), 1)) {
                const float mn = fmaxf(m_reg, pmax - a0), dl = -a0 - mn; alpha = __builtin_amdgcn_exp2f(m_reg - mn); m_reg = mn;
#pragma unroll
                for (int r = 0; r < 16; ++r) { p0[r] += dl; p1[r] += dl; } }
#pragma unroll
            for (int r = 0; r < 16; ++r) { p0[r] = __builtin_amdgcn_exp2f(p0[r]); p1[r] = __builtin_amdgcn_exp2f(p1[r]); }
            if (__any(alpha < 1.f)) {
                if (hi == 0) al_l[r32] = alpha;
                asm volatile("s_waitcnt lgkmcnt(0)" ::: "memory");
#pragma unroll
                for (int r = 0; r < 16; ++r) { const float ar = (al_l + 4 * hi)[(r & 3) + 8 * (r >> 2)];
#pragma unroll
                    for (int d = 0; d < 8; ++d) o[d][r] *= ar; }
            }
            float ps = ((p0[0] + p0[1]) + (p0[2] + p0[3])) + ((p0[4] + p0[5]) + (p0[6] + p0[7]));
            ps += ((p0[8] + p0[9]) + (p0[10] + p0[11])) + ((p0[12] + p0[13]) + (p0[14] + p0[15]));
            float ps1 = ((p1[0] + p1[1]) + (p1[2] + p1[3])) + ((p1[4] + p1[5]) + (p1[6] + p1[7]));
            ps1 += ((p1[8] + p1[9]) + (p1[10] + p1[11])) + ((p1[12] + p1[13]) + (p1[14] + p1[15]));
            ps += ps1;
            { auto rr = __builtin_amdgcn_permlane32_swap(__float_as_uint(ps), __float_as_uint(ps), false, false); ps = __uint_as_float(rr[0]) + __uint_as_float(rr[1]); }
            l_reg = l_reg * alpha + ps;
            A2_PK4(p0, 0, pa0); A2_PK4(p0, 8, pa1); A2_PK4(p1, 0, pa2); A2_PK4(p1, 8, pa3);
        }
        {
            const int vb = vrd0 + buf * 32768;
            s16x4 a0, a1, a2, a3, b0, b1, b2, b3, c0, c1, c2, c3;
#define A2_RD(h, d0, L0, H0, L1, H1) do { A2_TRRD(L0, vb, (h) * 16384 + (d0) * 512); A2_TRRD(H0, vb, (h) * 16384 + (d0) * 512 + 4096); A2_TRRD(L1, vb, (h) * 16384 + (d0) * 512 + 8192); A2_TRRD(H1, vb, (h) * 16384 + (d0) * 512 + 12288); } while (0)
#define A2_MM(PA, PB, d0, L0, H0, L1, H1) do { o[d0] = __builtin_amdgcn_mfma_f32_32x32x16_bf16(PA, (bf16x8){L0[0], L0[1], L0[2], L0[3], H0[0], H0[1], H0[2], H0[3]}, o[d0], 0, 0, 0);   \
                                               o[d0] = __builtin_amdgcn_mfma_f32_32x32x16_bf16(PB, (bf16x8){L1[0], L1[1], L1[2], L1[3], H1[0], H1[1], H1[2], H1[3]}, o[d0], 0, 0, 0); } while (0)
#define A2_LW(n) do { asm volatile("s_waitcnt lgkmcnt(" #n ")" ::: "memory"); __builtin_amdgcn_sched_barrier(0); } while (0)
#define A2_SB __builtin_amdgcn_sched_barrier(0)
            A2_RD(0, 0, a0, a1, a2, a3); A2_RD(0, 1, b0, b1, b2, b3);
            A2_RD(0, 2, c0, c1, c2, c3); A2_LW(8); A2_MM(pa0, pa1, 0, a0, a1, a2, a3); if (more) A2_DMAK(0); A2_SB;
            A2_RD(0, 3, a0, a1, a2, a3); A2_LW(8); A2_MM(pa0, pa1, 1, b0, b1, b2, b3); if (more) A2_DMAK(1); A2_SB;
            A2_RD(0, 4, b0, b1, b2, b3); A2_LW(8); A2_MM(pa0, pa1, 2, c0, c1, c2, c3); if (more) A2_DMAV(0); A2_SB;
            A2_RD(0, 5, c0, c1, c2, c3); A2_LW(8); A2_MM(pa0, pa1, 3, a0, a1, a2, a3); if (more) A2_DMAV(1); A2_SB;
            A2_RD(0, 6, a0, a1, a2, a3); A2_LW(8); A2_MM(pa0, pa1, 4, b0, b1, b2, b3); if (more) A2_DMAV(2); A2_SB;
            A2_RD(0, 7, b0, b1, b2, b3); A2_LW(8); A2_MM(pa0, pa1, 5, c0, c1, c2, c3); if (more) A2_DMAV(3); A2_SB;
            A2_RD(1, 0, c0, c1, c2, c3); A2_LW(8); A2_MM(pa0, pa1, 6, a0, a1, a2, a3); A2_SB;
            A2_RD(1, 1, a0, a1, a2, a3); A2_LW(8); A2_MM(pa0, pa1, 7, b0, b1, b2, b3); A2_SB;
            A2_RD(1, 2, b0, b1, b2, b3); A2_LW(8); A2_MM(pa2, pa3, 0, c0, c1, c2, c3); A2_SB;
            A2_RD(1, 3, c0, c1, c2, c3); A2_LW(8); A2_MM(pa2, pa3, 1, a0, a1, a2, a3); A2_SB;
            A2_RD(1, 4, a0, a1, a2, a3); A2_LW(8); A2_MM(pa2, pa3, 2, b0, b1, b2, b3); A2_SB;
            A2_RD(1, 5, b0, b1, b2, b3); A2_LW(8); A2_MM(pa2, pa3, 3, c0, c1, c2, c3); A2_SB;
            A2_RD(1, 6, c0, c1, c2, c3); A2_LW(8); A2_MM(pa2, pa3, 4, a0, a1, a2, a3); A2_SB;
            A2_RD(1, 7, a0, a1, a2, a3); A2_LW(8); A2_MM(pa2, pa3, 5, b0, b1, b2, b3); A2_SB;
            A2_LW(4); A2_MM(pa2, pa3, 6, c0, c1, c2, c3); A2_SB;
            A2_LW(0); A2_MM(pa2, pa3, 7, a0, a1, a2, a3);
#undef A2_RD
#undef A2_MM
#undef A2_LW
#undef A2_SB
        }
        }
        __builtin_amdgcn_sched_barrier(0);
        if (t + 2 < NT) A2_BAR(6); else A2_BAR(0);
        buf = buf == 2 ? 0 : buf + 1;
    }
    for (; t < NT; ++t) {
        const int kb = t * 64; const int bn2 = buf == 0 ? 2 : buf - 1; const bool more = t + 2 < NT;
        const char* kgn = (const char*)(Kg + (size_t)(kb + 128) * 128); const char* vgn = (const char*)(Vg + (size_t)(kb + 128) * 256);
        if (more) { A2_DMAK(0); A2_DMAK(1); A2_DMAV(0); A2_DMAV(1); A2_DMAV(2); A2_DMAV(3); }
        if (t + 2 < NT) A2_BAR(6); else A2_BAR(0);
        buf = buf == 2 ? 0 : buf + 1;
    }
    if (hi == 0) Ll[r32] = l_reg;
    asm volatile("s_waitcnt lgkmcnt(0)" ::: "memory");
    int tid2 = threadIdx.x; asm volatile("" : "+v"(tid2));
    const int e32 = tid2 & 31, ehi = (tid2 >> 5) & 1;
    float f[16];
#pragma unroll
    for (int r = 0; r < 16; ++r) f[r] = __builtin_amdgcn_rcpf((Ll + 4 * ehi)[(r & 3) + 8 * (r >> 2)]);
    {
        char* ob = (char*)(Og + (size_t)(qlo + 4 * ehi) * 256 + e32);
#pragma unroll
        for (int d0 = 0; d0 < 8; ++d0)
#pragma unroll
            for (int r = 0; r < 16; ++r) { const int rc = (r & 3) + 8 * (r >> 2); const float v = o[d0][r] * f[r], vn = __shfl_xor(v, 1);
                if ((e32 & 1) == 0) *(unsigned*)(ob + (rc * 256 + 32 * d0) * 2) = cvtpk(v, vn); }
    }
    __syncthreads();
#undef A2_DMA
#undef A2_DMAK
#undef A2_DMAV
#undef A2_BAR
}
typedef int i32x8 __attribute__((ext_vector_type(8)));
typedef int i32x4_ __attribute__((ext_vector_type(4)));
__device__ __forceinline__ void attn_block(const unsigned char* __restrict__ Q8, const unsigned char* __restrict__ K8, int jsh, const unsigned char* __restrict__ V8, float vinv, bf16_t* __restrict__ Og, int qb, char* lds) {
    int tid = threadIdx.x; asm volatile("" : "+v"(tid));
    const int wid = __builtin_amdgcn_readfirstlane(tid >> 6), lane = tid & 63, r32 = lane & 31, hi = lane >> 5;
    const int P0 = qb * 256, NT = 4 * qb + 4, qlo = P0 + 32 * wid, qm = qlo + r32 - 4 * hi, NTW = (qlo >> 6) + 1;
    char* K_lds = lds + OFF_K; char* V_lds = lds + OFF_V;
    float* Ll = (float*)(lds + OFF_ML) + wid * 32; float* al_l = (float*)(lds + OFF_AL) + wid * 32;
    typedef __attribute__((address_space(3))) unsigned lds_u32;
    unsigned koff;
    { const int q = wid * 64 + lane, r = q >> 3, sl = q & 7; koff = (unsigned)(r * 128 + ((sl ^ ((r >> 1) & 7)) << 4)); }
    unsigned voff[2];
#pragma unroll
    for (int i = 0; i < 2; ++i) { const int q = (2 * wid + i) * 64 + lane, dv = q >> 2, sl = q & 3; voff[i] = (unsigned)(dv * 64 + ((sl ^ ((dv >> 2) & 3)) << 4)); }
    const lds_u32* kdst = (const lds_u32*)((__attribute__((address_space(3))) char*)K_lds + wid * 1024);
    const lds_u32* vdst = (const lds_u32*)((__attribute__((address_space(3))) char*)V_lds + wid * 2048);
#define A2_DMAK() __builtin_amdgcn_global_load_lds((const unsigned*)(kgn + koff), (lds_u32*)((__attribute__((address_space(3))) char*)kdst + bn2 * 8192), 16, 0, 0)
#define A2_DMAV(i) __builtin_amdgcn_global_load_lds((const unsigned*)(vgn + voff[i]), (lds_u32*)((__attribute__((address_space(3))) char*)vdst + bn2 * 16384 + (i) * 1024), 16, 0, 0)
#define A2_DMA(tt, bf) do { const char* kg_ = (const char*)(K8 + (size_t)(tt) * 8192); const char* vg_ = (const char*)(V8 + (size_t)(tt) * 16384);                       \
        __builtin_amdgcn_global_load_lds((const unsigned*)(kg_ + koff), (lds_u32*)((__attribute__((address_space(3))) char*)kdst + (bf) * 8192), 16, 0, 0); \
        _Pragma("unroll") for (int i = 0; i < 2; ++i) __builtin_amdgcn_global_load_lds((const unsigned*)(vg_ + voff[i]), (lds_u32*)((__attribute__((address_space(3))) char*)vdst + (bf) * 16384 + i * 1024), 16, 0, 0); } while (0)
    i32x8 qf0, qf1;
    { const i32x4_* qp = (const i32x4_*)(Q8 + (size_t)(qlo + r32) * 128 + hi * 32); const i32x4_ a = qp[0], b = qp[1], c_ = qp[4], d = qp[5];
      qf0 = (i32x8){a[0], a[1], a[2], a[3], b[0], b[1], b[2], b[3]}; qf1 = (i32x8){c_[0], c_[1], c_[2], c_[3], d[0], d[1], d[2], d[3]}; }
    const int scq = (127 - jsh) & 0xff;
#define A2_BAR(n) do { asm volatile("s_waitcnt vmcnt(" #n ")" ::: "memory"); asm volatile("s_waitcnt lgkmcnt(0)" ::: "memory"); __builtin_amdgcn_s_barrier(); asm volatile("" ::: "memory"); } while (0)
    A2_DMA(0, 0); A2_DMA(1, 1);
    A2_BAR(3);
    float m_reg = -1e30f, l_reg = 0.f;
    f32x16 a0v = f32x16{};
    f32x16 o[8];
#pragma unroll
    for (int d = 0; d < 8; ++d) o[d] = f32x16{};
    const int vrd0 = (int)(uintptr_t)V_lds + r32 * 64 + (((2 * hi) ^ ((r32 >> 2) & 3)) << 4);
    const int sc1 = 0x7f7f7f7f;
    int buf = 0;
    int t = 0;
    for (; t < NTW; ++t) {
        const int kb = t * 64; const int bn2 = buf == 0 ? 2 : buf - 1;
        const bool more = t + 2 < NT;
        const char* kgn = (const char*)(K8 + (size_t)(t + 2) * 8192); const char* vgn = (const char*)(V8 + (size_t)(t + 2) * 16384);
        __builtin_amdgcn_sched_barrier(0);
        {
        i32x8 pf;
        const bool mset = m_reg > -1e29f; const float a0 = mset ? PSH - m_reg : 0.f;
        f32x16 p0, p1;
        {
            const int ka_ = (int)(uintptr_t)K_lds + buf * 8192 + r32 * 128 + (((2 * hi) ^ ((r32 >> 1) & 7)) << 4);
            const int kb1 = ka_ ^ 16, kc0 = ka_ ^ 64, kc1 = ka_ ^ 80;
            i32x4_ x0, x1, y0, y1, z0, z1, w0, w1;
            asm volatile("ds_read_b128 %0, %1" : "=&v"(x0) : "v"(ka_) : "memory"); asm volatile("ds_read_b128 %0, %1" : "=&v"(x1) : "v"(kb1) : "memory");
            asm volatile("ds_read_b128 %0, %1" : "=&v"(y0) : "v"(kc0) : "memory"); asm volatile("ds_read_b128 %0, %1" : "=&v"(y1) : "v"(kc1) : "memory");
            asm volatile("ds_read_b128 %0, %1 offset:4096" : "=&v"(z0) : "v"(ka_) : "memory"); asm volatile("ds_read_b128 %0, %1 offset:4096" : "=&v"(z1) : "v"(kb1) : "memory");
            asm volatile("ds_read_b128 %0, %1 offset:4096" : "=&v"(w0) : "v"(kc0) : "memory"); asm volatile("ds_read_b128 %0, %1 offset:4096" : "=&v"(w1) : "v"(kc1) : "memory");
            asm volatile("s_waitcnt lgkmcnt(6)" ::: "memory"); __builtin_amdgcn_sched_barrier(0);
            p0 = __builtin_amdgcn_mfma_scale_f32_32x32x64_f8f6f4((i32x8){x0[0], x0[1], x0[2], x0[3], x1[0], x1[1], x1[2], x1[3]}, qf0, a0v, 0, 0, 0, scq, 0, sc1); __builtin_amdgcn_sched_barrier(0);
            asm volatile("s_waitcnt lgkmcnt(2)" ::: "memory"); __builtin_amdgcn_sched_barrier(0);
            p1 = __builtin_amdgcn_mfma_scale_f32_32x32x64_f8f6f4((i32x8){z0[0], z0[1], z0[2], z0[3], z1[0], z1[1], z1[2], z1[3]}, qf0, a0v, 0, 0, 0, scq, 0, sc1); __builtin_amdgcn_sched_barrier(0);
            p0 = __builtin_amdgcn_mfma_scale_f32_32x32x64_f8f6f4((i32x8){y0[0], y0[1], y0[2], y0[3], y1[0], y1[1], y1[2], y1[3]}, qf1, p0, 0, 0, 0, scq, 0, sc1); __builtin_amdgcn_sched_barrier(0);
            asm volatile("s_waitcnt lgkmcnt(0)" ::: "memory"); __builtin_amdgcn_sched_barrier(0);
            p1 = __builtin_amdgcn_mfma_scale_f32_32x32x64_f8f6f4((i32x8){w0[0], w0[1], w0[2], w0[3], w1[0], w1[1], w1[2], w1[3]}, qf1, p1, 0, 0, 0, scq, 0, sc1); asm volatile("" : "+v"(p0), "+v"(p1)); __builtin_amdgcn_sched_barrier(0);
        }
        if (kb + 63 > qlo) {
            const int dq = qm - kb; const float NEG = -__builtin_inff();
#pragma unroll
            for (int r = 0; r < 16; ++r) { const int c = (r & 3) + 8 * (r >> 2); if (dq - c < 0) p0[r] = NEG; if (dq - c - 32 < 0) p1[r] = NEG; }
        }
        {
            float pmax = fmaxf(fmaxf(fmaxf(p0[0], p0[1]), fmaxf(p0[2], p0[3])), fmaxf(fmaxf(p0[4], p0[5]), fmaxf(p0[6], p0[7])));
            pmax = fmaxf(pmax, fmaxf(fmaxf(fmaxf(p0[8], p0[9]), fmaxf(p0[10], p0[11])), fmaxf(fmaxf(p0[12], p0[13]), fmaxf(p0[14], p0[15]))));
            float pmx1 = fmaxf(fmaxf(fmaxf(p1[0], p1[1]), fmaxf(p1[2], p1[3])), fmaxf(fmaxf(p1[4], p1[5]), fmaxf(p1[6], p1[7])));
            pmx1 = fmaxf(pmx1, fmaxf(fmaxf(fmaxf(p1[8], p1[9]), fmaxf(p1[10], p1[11])), fmaxf(fmaxf(p1[12], p1[13]), fmaxf(p1[14], p1[15]))));
            pmax = fmaxf(pmax, pmx1);
            { auto rr = __builtin_amdgcn_permlane32_swap(__float_as_uint(pmax), __float_as_uint(pmax), false, false); pmax = fmaxf(__uint_as_float(rr[0]), __uint_as_float(rr[1])); }
            float alpha = 1.f;
            if (!__builtin_expect(__all(mset && pmax <= PSH + THR * 1.4426950408889634f), 1)) {
                const float mn = fmaxf(m_reg, pmax - a0), dl = (PSH - mn) - a0; alpha = __builtin_amdgcn_exp2f(m_reg - mn); m_reg = mn;
#pragma unroll
                for (int r = 0; r < 16; ++r) a0v[r] = PSH - mn;
#pragma unroll
                for (int r = 0; r < 16; ++r) { p0[r] += dl; p1[r] += dl; } }
#pragma unroll
            for (int r = 0; r < 16; ++r) { p0[r] = __builtin_amdgcn_exp2f(p0[r]); p1[r] = __builtin_amdgcn_exp2f(p1[r]); }
            if (__any(alpha < 1.f)) {
                if (hi == 0) al_l[r32] = alpha;
                asm volatile("s_waitcnt lgkmcnt(0)" ::: "memory");
#pragma unroll
                for (int r = 0; r < 16; ++r) { const float ar = (al_l + 4 * hi)[(r & 3) + 8 * (r >> 2)];
#pragma unroll
                    for (int d = 0; d < 8; ++d) o[d][r] *= ar; }
            }
            float ps = ((p0[0] + p0[1]) + (p0[2] + p0[3])) + ((p0[4] + p0[5]) + (p0[6] + p0[7]));
            ps += ((p0[8] + p0[9]) + (p0[10] + p0[11])) + ((p0[12] + p0[13]) + (p0[14] + p0[15]));
            float ps1 = ((p1[0] + p1[1]) + (p1[2] + p1[3])) + ((p1[4] + p1[5]) + (p1[6] + p1[7]));
            ps1 += ((p1[8] + p1[9]) + (p1[10] + p1[11])) + ((p1[12] + p1[13]) + (p1[14] + p1[15]));
            ps += ps1;
            { auto rr = __builtin_amdgcn_permlane32_swap(__float_as_uint(ps), __float_as_uint(ps), false, false); ps = __uint_as_float(rr[0]) + __uint_as_float(rr[1]); }
            l_reg = l_reg * alpha + ps;
#pragma unroll
            for (int i = 0; i < 4; ++i) { int w = 0; w = __builtin_amdgcn_cvt_pk_fp8_f32(p0[4 * i], p0[4 * i + 1], w, false); w = __builtin_amdgcn_cvt_pk_fp8_f32(p0[4 * i + 2], p0[4 * i + 3], w, true); pf[i] = w;
                                          int u = 0; u = __builtin_amdgcn_cvt_pk_fp8_f32(p1[4 * i], p1[4 * i + 1], u, false); u = __builtin_amdgcn_cvt_pk_fp8_f32(p1[4 * i + 2], p1[4 * i + 3], u, true); pf[4 + i] = u; }
            asm volatile("" : "+v"(pf)); __builtin_amdgcn_sched_barrier(0);
        }
        {
            const int va = vrd0 + buf * 16384, vx = va ^ 16;
            i32x4_ a0, a1, b0, b1, c0, c1;
#define A2_RD(d0, X0, X1) do { asm volatile("ds_read_b128 %0, %1 offset:%2" : "=&v"(X0) : "v"(va), "i"((d0) * 2048) : "memory"); asm volatile("ds_read_b128 %0, %1 offset:%2" : "=&v"(X1) : "v"(vx), "i"((d0) * 2048) : "memory"); } while (0)
#define A2_MM(d0, X0, X1) do { o[d0] = __builtin_amdgcn_mfma_scale_f32_32x32x64_f8f6f4(pf, (i32x8){X0[0], X0[1], X0[2], X0[3], X1[0], X1[1], X1[2], X1[3]}, o[d0], 0, 0, 0, sc1, 0, sc1); asm volatile("" : "+v"(o[d0])); } while (0)
#define A2_LW(n) do { asm volatile("s_waitcnt lgkmcnt(" #n ")" ::: "memory"); __builtin_amdgcn_sched_barrier(0); } while (0)
#define A2_SB __builtin_amdgcn_sched_barrier(0)
            A2_RD(0, a0, a1); A2_RD(1, b0, b1);
            A2_RD(2, c0, c1); A2_LW(4); A2_MM(0, a0, a1); if (more) A2_DMAK(); A2_SB;
            A2_RD(3, a0, a1); A2_LW(4); A2_MM(1, b0, b1); A2_SB;
            A2_RD(4, b0, b1); A2_LW(4); A2_MM(2, c0, c1); if (more) A2_DMAV(0); A2_SB;
            A2_RD(5, c0, c1); A2_LW(4); A2_MM(3, a0, a1); if (more) A2_DMAV(1); A2_SB;
            A2_RD(6, a0, a1); A2_LW(4); A2_MM(4, b0, b1); A2_SB;
            A2_RD(7, b0, b1); A2_LW(4); A2_MM(5, c0, c1); A2_SB;
            A2_LW(2); A2_MM(6, a0, a1); A2_SB;
            A2_LW(0); A2_MM(7, b0, b1);
#undef A2_RD
#undef A2_MM
#undef A2_LW
#undef A2_SB
        }
        }
        __builtin_amdgcn_sched_barrier(0);
        if (t + 2 < NT) A2_BAR(3); else A2_BAR(0);
        buf = buf == 2 ? 0 : buf + 1;
    }
    for (; t < NT; ++t) {
        const int kb = t * 64; const int bn2 = buf == 0 ? 2 : buf - 1; const bool more = t + 2 < NT;
        const char* kgn = (const char*)(K8 + (size_t)(t + 2) * 8192); const char* vgn = (const char*)(V8 + (size_t)(t + 2) * 16384);
        if (more) { A2_DMAK(); A2_DMAV(0); A2_DMAV(1); }
        if (t + 2 < NT) A2_BAR(3); else A2_BAR(0);
        buf = buf == 2 ? 0 : buf + 1;
    }
    if (hi == 0) Ll[r32] = l_reg;
    asm volatile("s_waitcnt lgkmcnt(0)" ::: "memory");
    int tid2 = threadIdx.x; asm volatile("" : "+v"(tid2));
    const int e32 = tid2 & 31, ehi = (tid2 >> 5) & 1;
    float f[16];
#pragma unroll
    for (int r = 0; r < 16; ++r) f[r] = vinv * __builtin_amdgcn_rcpf((Ll + 4 * ehi)[(r & 3) + 8 * (r >> 2)]);
    {
        char* ob = (char*)(Og + (size_t)(qlo + 4 * ehi) * 256 + e32);
#pragma unroll
        for (int d0 = 0; d0 < 8; ++d0)
#pragma unroll
            for (int r = 0; r < 16; ++r) { const int rc = (r & 3) + 8 * (r >> 2); const float v = o[d0][r] * f[r], vn = __shfl_xor(v, 1);
                if ((e32 & 1) == 0) *(unsigned*)(ob + (rc * 256 + 32 * d0) * 2) = cvtpk(v, vn); }
    }
    __syncthreads();
#undef A2_DMA
#undef A2_DMAK
#undef A2_DMAV
#undef A2_BAR
}
#undef A2_TRRD
#undef A2_PK4
}

constexpr int S_ = 16384, DM = 2048, NIN = 5120, AW = 1024, RW = 1024, NMEM = 256, NE = 32, TOPK = 4, DFF = 2048;
constexpr int NWAVES = 8, NTHREADS = 512;
constexpr float EPS_ = 1e-6f, DA_EPS_ = 1e-5f, LAMBDA_INIT = 0.2f;
constexpr int MPAD_TILES = 288;
#ifndef MK_N_LAUNCHES
#define MK_N_LAUNCHES 1
#endif
constexpr int N_PHASES = 16;
#ifndef MK_NCV
#define MK_NCV 0
#endif
constexpr int NCV = MK_NCV;

constexpr size_t MiB = 1u << 20;
constexpr size_t WS_CTL = 0, CTL_ZERO_BYTES = 1 * MiB;
constexpr size_t WS_SMALL = 1 * MiB;
constexpr size_t WS_LPART = WS_SMALL + 0 * MiB;
constexpr size_t WS_ACH = WS_SMALL + 1 * MiB;
constexpr size_t WS_HCH = WS_SMALL + 2 * MiB;
constexpr size_t WS_CARRY = WS_SMALL + 3 * MiB;
constexpr size_t WS_TOPE = WS_SMALL + 4 * MiB;
constexpr size_t WS_TOPG = WS_TOPE + 256 * 1024;
constexpr size_t WS_POSOF = WS_TOPG + 256 * 1024;
constexpr size_t WS_TCNT = WS_POSOF + 256 * 1024;
constexpr size_t WS_ROWGATE = WS_SMALL + 5 * MiB;
constexpr size_t WS_TILEEXP = WS_ROWGATE + 512 * 1024;
constexpr size_t WS_NRT = WS_TILEEXP + 4096;
constexpr size_t WS_WRGT = WS_SMALL + 6 * MiB;
constexpr size_t WS_MEMN = WS_SMALL + 7 * MiB;
constexpr size_t WS_KM = WS_SMALL + 8 * MiB;
constexpr size_t WS_VT = WS_SMALL + 9 * MiB;
constexpr size_t WS_SBGU = WS_SMALL + 10 * MiB;
constexpr size_t WS_SBDN = WS_SMALL + 10 * MiB + 512 * 1024;
constexpr size_t WS_SBIN = WS_SMALL + 16 * MiB;
constexpr size_t WS_SBOUT = WS_SMALL + 18 * MiB;
constexpr size_t WS_MIXSCALE = WS_SMALL + 19 * MiB;
constexpr size_t WS_SBCQ = WS_SMALL + 20 * MiB, WS_SBCO = WS_SMALL + 21 * MiB;
constexpr size_t WS_SRCTOK = WS_SMALL + 23 * MiB;
constexpr size_t WS_INSCALE = WS_SMALL + 17 * MiB;
constexpr size_t WS_ROWSCALE = WS_SMALL + 11 * MiB;
constexpr size_t WS_TOKSCALE = WS_SMALL + 12 * MiB;
constexpr size_t WS_SSQ = WS_SMALL + 13 * MiB;
constexpr size_t WS_WIN = 32 * MiB, WS_WOUT = 52 * MiB, WS_WCQ = 60 * MiB, WS_WCKV = 68 * MiB, WS_WCO = 84 * MiB;
constexpr size_t WS_WGU = 128 * MiB, WS_WDN = 640 * MiB;
constexpr size_t WS_XN = 896 * MiB;
constexpr size_t WS_Q = 960 * MiB, WS_K = 992 * MiB, WS_V = 1024 * MiB;
constexpr size_t WS_XR = 1056 * MiB, WS_XG = 1088 * MiB;
constexpr size_t WS_AO = 1120 * MiB;
constexpr size_t WS_HL = 1184 * MiB, WS_ACUM = 1248 * MiB;
constexpr size_t WS_MIX = 1312 * MiB;
constexpr size_t WS_H = 1376 * MiB;
constexpr size_t WS_QC = 1504 * MiB;
constexpr size_t WS_PC = 1568 * MiB;
constexpr size_t WS_OC = 1600 * MiB;
constexpr size_t WS_XS = 1664 * MiB, WS_ACT = 1952 * MiB, WS_YB = 2240 * MiB;
constexpr float ACT_QSCALE = 16.0f / 127.0f;
constexpr size_t WS_END = 2528 * MiB;
constexpr int CW_VMAX = 12288;
constexpr int CW_BAR = 4096;

constexpr int SCR_BYTES = 159744;
constexpr int MISC_OFF = SCR_BYTES;
constexpr int LDS_BYTES = 163840;

#define GAS __attribute__((address_space(1)))
#define LAS __attribute__((address_space(3)))
typedef unsigned short bf16_t;
typedef unsigned u32x4 __attribute__((ext_vector_type(4)));
typedef unsigned u32x2 __attribute__((ext_vector_type(2)));
typedef float f32x4 __attribute__((ext_vector_type(4)));
typedef short bf16x8 __attribute__((ext_vector_type(8)));
#define LDS_WAIT() asm volatile("s_waitcnt lgkmcnt(0)" ::: "memory")
#define VM_WAIT() asm volatile("s_waitcnt vmcnt(0)" ::: "memory")
__device__ __forceinline__ unsigned pk2(float lo, float hi) { return pg8::cvt_pk_bf16(lo, hi); }
__device__ __forceinline__ float bflo(unsigned w) { return __uint_as_float(w << 16); }
__device__ __forceinline__ float bfhi(unsigned w) { return __uint_as_float(w & 0xffff0000u); }
__device__ __forceinline__ f32x4 ld_bf16x4(const bf16_t* p) { const u32x2 w = *(const u32x2*)p; return (f32x4){bflo(w.x), bfhi(w.x), bflo(w.y), bfhi(w.y)}; }
__device__ __forceinline__ void st_bf16x4(bf16_t* p, f32x4 v) { u32x2 w; w.x = pk2(v[0], v[1]); w.y = pk2(v[2], v[3]); *(u32x2*)p = w; }
__device__ __forceinline__ float bf1(bf16_t h) { return __uint_as_float((unsigned)h << 16); }

#define XB_TMO      128
#define XB_XCNT(j)  (256  + 64 * (j))
#define XB_XSUB(j)  (1280 + 64 * (j))
#define XB_XGEN(j)  (2304 + 64 * (j))
#define XB_TOP      3328
#define XB_TOPGEN   3392
#define XCD_BAR_WORDS 3456
#define XB_SPIN_CAP (1u << 18)

__device__ __forceinline__ unsigned xb_ld(unsigned* p)              { return __hip_atomic_load(p, __ATOMIC_RELAXED, __HIP_MEMORY_SCOPE_AGENT); }
__device__ __forceinline__ unsigned xb_add(unsigned* p, unsigned v) { return __hip_atomic_fetch_add(p, v, __ATOMIC_RELAXED, __HIP_MEMORY_SCOPE_AGENT); }
__device__ __forceinline__ unsigned xb_xcc_id() { return (unsigned)__builtin_amdgcn_s_getreg((3 << 11) | 20) & 0xFu; }
#define XB_SPIN(cond, bar) do { unsigned _sp = 0; while (cond) { __builtin_amdgcn_s_sleep(1); \
    if ((++_sp & 255u) == 0u) { if (xb_ld(&(bar)[XB_TMO])) break; if (_sp > XB_SPIN_CAP) { atomicAdd(&(bar)[XB_TMO], 1u); break; } } } } while (0)

struct XcdBarrier {
    unsigned* bar; unsigned x;
    volatile LAS unsigned* st;
};
__device__ __forceinline__ XcdBarrier xcd_barrier_post(unsigned* bar, volatile LAS unsigned* st) {
    XcdBarrier b; b.bar = bar; b.x = xb_xcc_id(); b.st = st;
    if (threadIdx.x == 0) (void)xb_add(&bar[XB_XCNT(b.x)], 1u);
    return b;
}
__device__ __forceinline__ void xcd_barrier_complete(unsigned* bar, unsigned x, unsigned& nloc, unsigned& nx) {
    const unsigned G = gridDim.x * gridDim.y * gridDim.z;
    unsigned sum, cnt, mine, sp = 0u;
    for (;;) {
        sum = 0u; cnt = 0u; mine = 0u;
#pragma unroll
        for (unsigned j = 0; j < 16; ++j) { const unsigned c = xb_ld(&bar[XB_XCNT(j)]); sum += c; cnt += (c > 0u) ? 1u : 0u; mine = (j == x) ? c : mine; }
        if (sum == G) break;
        __builtin_amdgcn_s_sleep(1);
        if ((++sp & 255u) == 0u) { if (xb_ld(&bar[XB_TMO])) break; if (sp > XB_SPIN_CAP) { atomicAdd(&bar[XB_TMO], 1u); break; } }
    }
    nloc = mine > 0u ? mine : 1u; nx = cnt > 0u ? cnt : 1u;
}
__device__ __forceinline__ void xcd_barrier(const XcdBarrier& b) {
    asm volatile("s_waitcnt vmcnt(0)" ::: "memory");
    __syncthreads();
    if (threadIdx.x == 0) {
        unsigned* bar = b.bar;
        __builtin_amdgcn_s_waitcnt(0);
        unsigned nloc = b.st[0], nx = b.st[1];
        if (nloc == 0u) { xcd_barrier_complete(bar, b.x, nloc, nx); b.st[0] = nloc; b.st[1] = nx; }
        const unsigned old = xb_add(&bar[XB_XSUB(b.x)], 1u);
        const unsigned gen = old / nloc;
        if (old + 1u == (gen + 1u) * nloc) {
            __builtin_amdgcn_fence(__ATOMIC_RELEASE, "agent");
            asm volatile("s_waitcnt vmcnt(0)" ::: "memory");
            const unsigned og = xb_add(&bar[XB_TOP], 1u);
            const unsigned tg = og / nx;
            if (og + 1u == (tg + 1u) * nx) xb_add(&bar[XB_TOPGEN], 1u);
            else XB_SPIN(xb_ld(&bar[XB_TOPGEN]) == tg, bar);
            __builtin_amdgcn_fence(__ATOMIC_ACQUIRE, "agent");
            xb_add(&bar[XB_XGEN(b.x)], 1u);
            asm volatile("s_waitcnt vmcnt(0)" ::: "memory");
        } else {
            XB_SPIN(xb_ld(&bar[XB_XGEN(b.x)]) == gen, bar);
            __builtin_amdgcn_fence(__ATOMIC_ACQUIRE, "agent");
            asm volatile("s_waitcnt vmcnt(0)" ::: "memory");
        }
    }
    __syncthreads();
}

__device__ __forceinline__ float wave_sum(float v) {
#pragma unroll
    for (int o = 1; o < 64; o <<= 1) v += __shfl_xor(v, o);
    return v;
}
__device__ __forceinline__ float sigmoidf_(float x) { return __builtin_amdgcn_rcpf(1.0f + __builtin_amdgcn_exp2f(-1.4426950408889634f * x)); }
__device__ __forceinline__ float gelu_tanh(float x) { const float u = 0.7978845608028654f * (x + 0.044715f * x * x * x); return 0.5f * x * (1.0f + tanhf(u)); }

__device__ __forceinline__ void p0_transpose_item(const float* W, int K, int N, bf16_t* WT, int k0, int n0, int drow0, LAS float* scr, int lane, const float* kscale = nullptr) {
#pragma unroll 8
    for (int i = 0; i < 32; ++i) { const int kk = 2 * i + (lane >> 5); float wv = W[(size_t)(k0 + kk) * N + n0 + (lane & 31)]; if (kscale) wv *= kscale[k0 + kk]; scr[kk * 33 + (lane & 31)] = wv; }
    LDS_WAIT(); asm volatile("" ::: "memory");
    const int c = lane & 7;
#pragma unroll
    for (int j = 0; j < 4; ++j) { const int n = (lane >> 3) + 8 * j; const LAS float* s = scr + (8 * c) * 33 + n;
        u32x4 o; o.x = pk2(s[0 * 33], s[1 * 33]); o.y = pk2(s[2 * 33], s[3 * 33]); o.z = pk2(s[4 * 33], s[5 * 33]); o.w = pk2(s[6 * 33], s[7 * 33]);
        *(u32x4*)(WT + (size_t)(drow0 + n) * K + k0 + 8 * c) = o; }
    LDS_WAIT(); asm volatile("" ::: "memory");
}
__device__ __forceinline__ void rms_row_bf16(const float* xrow, const float* g, bf16_t* orow, int lane) {
    const f32x4* xr = (const f32x4*)xrow + lane; const f32x4* gr = (const f32x4*)g + lane;
    f32x4 v[8]; float s = 0.f;
#pragma unroll
    for (int j = 0; j < 8; ++j) { v[j] = xr[64 * j]; s += (v[j].x * v[j].x + v[j].y * v[j].y) + (v[j].z * v[j].z + v[j].w * v[j].w); }
    const float r = rsqrtf(wave_sum(s) * (1.f / 2048.f) + EPS_);
    u32x2* o8 = (u32x2*)orow + lane;
#pragma unroll
    for (int j = 0; j < 8; ++j) { const f32x4 gg = gr[64 * j]; u32x2 o; o.x = pk2(v[j].x * r * gg.x, v[j].y * r * gg.y); o.y = pk2(v[j].z * r * gg.z, v[j].w * r * gg.w); o8[64 * j] = o; }
}

__device__ __forceinline__ void rms_row_i8(f32x4 (&v)[8], const float* g, signed char* orow, float* scale_out, int lane) {
    const f32x4* gr = (const f32x4*)g + lane;
    float s = 0.f;
#pragma unroll
    for (int j = 0; j < 8; ++j) s += (v[j].x * v[j].x + v[j].y * v[j].y) + (v[j].z * v[j].z + v[j].w * v[j].w);
    const float r = rsqrtf(wave_sum(s) * (1.f / 2048.f) + 1e-6f);
    float am = 0.f;
#pragma unroll
    for (int j = 0; j < 8; ++j) { const f32x4 gg = gr[64 * j]; v[j].x *= r * gg.x; v[j].y *= r * gg.y; v[j].z *= r * gg.z; v[j].w *= r * gg.w;
        am = fmaxf(fmaxf(am, fmaxf(fabsf(v[j].x), fabsf(v[j].y))), fmaxf(fabsf(v[j].z), fabsf(v[j].w))); }
#pragma unroll
    for (int o = 32; o > 0; o >>= 1) am = fmaxf(am, __shfl_xor(am, o));
    const float inv = am > 0.f ? 127.0f / am : 0.f;
    unsigned* o4 = (unsigned*)orow + lane;
#pragma unroll
    for (int j = 0; j < 8; ++j) {
        const unsigned f0 = __float_as_uint(fmaf(v[j].x, inv, 12582912.0f)), f1 = __float_as_uint(fmaf(v[j].y, inv, 12582912.0f)), f2 = __float_as_uint(fmaf(v[j].z, inv, 12582912.0f)), f3 = __float_as_uint(fmaf(v[j].w, inv, 12582912.0f));
        o4[64 * j] = __builtin_amdgcn_perm(__builtin_amdgcn_perm(f3, f2, 0x0c0c0400u), __builtin_amdgcn_perm(f1, f0, 0x0c0c0400u), 0x05040100u); }
    if (lane == 0) *scale_out = am > 0.f ? am * (1.0f / 127.0f) : 1.0f;
}

struct Args { const float* in[31]; float* out; unsigned char* ws; int ph_lo, ph_hi; };
typedef const __attribute__((address_space(4))) Args CArgs;
__device__ __forceinline__ CArgs* kargs() { CArgs* p = (CArgs*)__builtin_amdgcn_kernarg_segment_ptr(); asm volatile("" : "+s"(p)); return p; }
__device__ __forceinline__ int lane_id() { int t = threadIdx.x; asm volatile("" : "+v"(t)); return t & 63; }
__device__ __forceinline__ int wave_id() { return __builtin_amdgcn_readfirstlane(threadIdx.x >> 6); }
enum { I_X = 0, I_MEM, I_NORM_MIX_G, I_W_IN, I_CONV_W, I_CONV_B, I_W_RG_A, I_B_RG_A, I_W_RG_X, I_B_RG_X, I_RG_LAMBDA, I_REC_NORM_G, I_LQ1, I_LK1, I_LQ2, I_LK2, I_SUBLN_G, I_W_OUT,
       I_NORM_CROSS_G, I_NORM_MEM_G, I_W_CQ, I_W_CKV, I_W_CO, I_NORM_FFN_G, I_W_ROUTER, I_B_ROUTER, I_W_GU, I_B_GU, I_W_DN, I_B_DN, I_NORM_FINAL_G };

__device__ __forceinline__ void convert_expert_strips(unsigned char* ws, LAS unsigned char* lds, int first, int stride) {
    asm volatile("" : "+s"(first), "+s"(stride));
    CArgs& a = *kargs(); const int wave = wave_id(), lane = lane_id();
    LAS float* CM = (LAS float*)(lds + 8 * 16384);
    const int cg = lane & 7, kl = lane >> 3, kbase = 256 * wave + 32 * kl;
    constexpr int NST_GU = 32 * 128, NST_DN = 32 * 64, NST = NST_GU + NST_DN;
    const float* wgu = a.in[I_W_GU]; const float* wdn = a.in[I_W_DN];
    unsigned H[4][16];
    f32x4 v[32];
#define CS_DECODE(st) const bool g_ = (st) < NST_GU; const int s2_ = g_ ? (st) : (st) - NST_GU; const int e_ = g_ ? (s2_ >> 7) : (s2_ >> 6), nb_ = g_ ? (s2_ & 127) : (s2_ & 63), n0_ = 32 * nb_, N_ = g_ ? 4096 : 2048
#define CS_LOAD(st) do { CS_DECODE(st); const float* p_ = (g_ ? wgu : wdn) + ((size_t)e_ * 2048 + kbase) * N_ + n0_ + 4 * cg;                                       \
        _Pragma("unroll") for (int i = 0; i < 32; ++i) v[i] = *(const f32x4*)(p_ + (size_t)i * N_); } while (0)
#define CS_PACK(par) do { f32x4 m_ = {0.f, 0.f, 0.f, 0.f};                                                                                                             \
        _Pragma("unroll") for (int i = 0; i < 32; ++i) { m_[0] = fmaxf(m_[0], fabsf(v[i][0])); m_[1] = fmaxf(m_[1], fabsf(v[i][1])); m_[2] = fmaxf(m_[2], fabsf(v[i][2])); m_[3] = fmaxf(m_[3], fabsf(v[i][3])); } \
        _Pragma("unroll") for (int c = 0; c < 4; ++c) { m_[c] = fmaxf(m_[c], __shfl_xor(m_[c], 8)); m_[c] = fmaxf(m_[c], __shfl_xor(m_[c], 16)); m_[c] = fmaxf(m_[c], __shfl_xor(m_[c], 32)); } \
        if (kl == 0) *(LAS f32x4*)(CM + (par) * 256 + wave * 32 + 4 * cg) = m_;                                                                                       \
        _Pragma("unroll") for (int c = 0; c < 4; ++c) _Pragma("unroll") for (int i = 0; i < 16; ++i) H[c][i] = pk2(v[2 * i][c], v[2 * i + 1][c]); } while (0)
#define CS_STORE(st, par) do { CS_DECODE(st); (void)n0_;                                                                                                              \
        const int j_ = n0_ & 2047, up_ = n0_ >> 11, drow0_ = (g_ ? 256 * (j_ >> 7) + 128 * up_ + (j_ & 127) : n0_) + 4 * cg;                                       \
        signed char* W8_ = (signed char*)(ws + (g_ ? WS_WGU : WS_WDN)); float* SB_ = (float*)(ws + (g_ ? WS_SBGU : WS_SBDN));                                        \
        f32x4 cm_ = *(const LAS f32x4*)(CM + (par) * 256 + 4 * cg);                                                                                                   \
        _Pragma("unroll") for (int w = 1; w < 8; ++w) { const f32x4 o_ = *(const LAS f32x4*)(CM + (par) * 256 + w * 32 + 4 * cg); cm_[0] = fmaxf(cm_[0], o_[0]); cm_[1] = fmaxf(cm_[1], o_[1]); cm_[2] = fmaxf(cm_[2], o_[2]); cm_[3] = fmaxf(cm_[3], o_[3]); } \
        _Pragma("unroll") for (int c = 0; c < 4; ++c) { const float inv_ = cm_[c] > 0.f ? 127.0f / cm_[c] : 0.f;                                                         \
            u32x4* dst_ = (u32x4*)(W8_ + ((size_t)e_ * N_ + drow0_ + c) * 2048 + kbase);                                                                              \
            _Pragma("unroll") for (int q = 0; q < 2; ++q) { u32x4 o_;                                                                                                 \
                _Pragma("unroll") for (int d = 0; d < 4; ++d) { const unsigned h0_ = H[c][8 * q + 2 * d], h1_ = H[c][8 * q + 2 * d + 1];                                \
                    const unsigned f0_ = __float_as_uint(fmaf(bflo(h0_), inv_, 12582912.0f)), f1_ = __float_as_uint(fmaf(bfhi(h0_), inv_, 12582912.0f));                \
                    const unsigned f2_ = __float_as_uint(fmaf(bflo(h1_), inv_, 12582912.0f)), f3_ = __float_as_uint(fmaf(bfhi(h1_), inv_, 12582912.0f));                \
                    o_[d] = __builtin_amdgcn_perm(__builtin_amdgcn_perm(f3_, f2_, 0x0c0c0400u), __builtin_amdgcn_perm(f1_, f0_, 0x0c0c0400u), 0x05040100u); }           \
                dst_[q] = o_; }                                                                                                                                       \
            if (wave == 0 && kl == 0) SB_[(size_t)e_ * N_ + drow0_ + c] = cm_[c] > 0.f ? cm_[c] * (1.0f / 127.0f) : 1.0f; } } while (0)
    int st = first, par = 0;
    if (st < NST) { CS_LOAD(st); CS_PACK(0); }
    while (st < NST) {
        const int sn = st + stride;
        if (sn < NST) CS_LOAD(sn);
        __builtin_amdgcn_sched_barrier(0);
        __syncthreads();
        CS_STORE(st, par);
        __builtin_amdgcn_sched_barrier(0);
        if (sn < NST) CS_PACK(par ^ 1);
        st = sn; par ^= 1;
    }
    __syncthreads();
#undef CS_DECODE
#undef CS_LOAD
#undef CS_PACK
#undef CS_STORE
}

template <bool F8 = false>
__device__ __forceinline__ void convert_strips_i8(const float* win, int N, signed char* dst8, float* sbo, LAS unsigned char* lds, int first, int stride, const float* kscale = nullptr) {
    const int wave = wave_id(), lane = lane_id();
    LAS float* CM = (LAS float*)(lds + 8 * 16384);
    const int cg = lane & 7, kl = lane >> 3, kbase = 256 * wave + 32 * kl;
    for (int st = first; st < N / 32; st += stride) {
        const int n0 = 32 * st; const float* p_ = win + (size_t)kbase * N + n0 + 4 * cg;
        f32x4 v[32]; f32x4 m_ = {0.f, 0.f, 0.f, 0.f};
#pragma unroll
        for (int i = 0; i < 32; ++i) v[i] = *(const f32x4*)(p_ + (size_t)i * N);
        if (kscale) {
#pragma unroll
            for (int i = 0; i < 32; ++i) v[i] *= kscale[kbase + i]; }
#pragma unroll
        for (int i = 0; i < 32; ++i) { m_[0] = fmaxf(m_[0], fabsf(v[i][0])); m_[1] = fmaxf(m_[1], fabsf(v[i][1])); m_[2] = fmaxf(m_[2], fabsf(v[i][2])); m_[3] = fmaxf(m_[3], fabsf(v[i][3])); }
#pragma unroll
        for (int c = 0; c < 4; ++c) { m_[c] = fmaxf(m_[c], __shfl_xor(m_[c], 8)); m_[c] = fmaxf(m_[c], __shfl_xor(m_[c], 16)); m_[c] = fmaxf(m_[c], __shfl_xor(m_[c], 32)); }
        if (kl == 0) *(LAS f32x4*)(CM + wave * 32 + 4 * cg) = m_;
        __syncthreads();
        f32x4 cm_ = *(const LAS f32x4*)(CM + 4 * cg);
#pragma unroll
        for (int w = 1; w < 8; ++w) { const f32x4 o_ = *(const LAS f32x4*)(CM + w * 32 + 4 * cg); cm_[0] = fmaxf(cm_[0], o_[0]); cm_[1] = fmaxf(cm_[1], o_[1]); cm_[2] = fmaxf(cm_[2], o_[2]); cm_[3] = fmaxf(cm_[3], o_[3]); }
#pragma unroll
        for (int c = 0; c < 4; ++c) { constexpr float QMAX = F8 ? 240.0f : 127.0f; const float inv_ = cm_[c] > 0.f ? QMAX / cm_[c] : 0.f;
            u32x4* dst_ = (u32x4*)(dst8 + (size_t)(n0 + 4 * cg + c) * 2048 + kbase);
#pragma unroll
            for (int q = 0; q < 2; ++q) { u32x4 o_;
#pragma unroll
                for (int d = 0; d < 4; ++d) { const int i0 = 16 * q + 4 * d;
                    if constexpr (F8) { unsigned w_ = 0; w_ = __builtin_amdgcn_cvt_pk_fp8_f32(v[i0][c] * inv_, v[i0 + 1][c] * inv_, w_, false); w_ = __builtin_amdgcn_cvt_pk_fp8_f32(v[i0 + 2][c] * inv_, v[i0 + 3][c] * inv_, w_, true); o_[d] = w_; continue; }
                    const unsigned f0_ = __float_as_uint(fmaf(v[i0][c], inv_, 12582912.0f)), f1_ = __float_as_uint(fmaf(v[i0 + 1][c], inv_, 12582912.0f));
                    const unsigned f2_ = __float_as_uint(fmaf(v[i0 + 2][c], inv_, 12582912.0f)), f3_ = __float_as_uint(fmaf(v[i0 + 3][c], inv_, 12582912.0f));
                    o_[d] = __builtin_amdgcn_perm(__builtin_amdgcn_perm(f3_, f2_, 0x0c0c0400u), __builtin_amdgcn_perm(f1_, f0_, 0x0c0c0400u), 0x05040100u); }
                dst_[q] = o_; }
            if (wave == 0 && kl == 0) sbo[n0 + 4 * cg + c] = cm_[c] > 0.f ? cm_[c] * (1.0f / QMAX) : 1.0f; }
        __syncthreads();
    }
}

__device__ __forceinline__ void convert_late_weights(unsigned char* ws, LAS unsigned char* lds, int G);
__device__ __forceinline__ void p0_prologue(unsigned char* ws, LAS unsigned char* lds, int G) {
    CArgs& a = *kargs(); const int wave = wave_id(), lane = lane_id();
    LAS float* scr = (LAS float*)(lds + wave * 16384);
    const int gw = blockIdx.x * NWAVES + wave, NGW = G * NWAVES;
    constexpr int I_IN = 32 * 160, I_SQ = 32 * 64, I_KV = 32 * 128, I_GU = 32 * 32 * 128, I_DN = 32 * 32 * 64, I_RG = 128;
    constexpr int NITEMS = I_IN + 3 * I_SQ + I_KV + I_GU + I_DN + I_RG;
    const bool late_here = (G != 256);
    if (late_here) convert_expert_strips(ws, lds, blockIdx.x, G);
    if (late_here) convert_late_weights(ws, lds, G);
    convert_strips_i8(a.in[I_W_IN], 5120, (signed char*)(ws + WS_WIN), (float*)(ws + WS_SBIN), lds, blockIdx.x, G);
    for (int it = gw + I_GU + I_DN; it < NITEMS; it += NGW) {
        int r = it - I_GU - I_DN;
        if (r < I_IN) continue; r -= I_IN;
        if (r < I_SQ) continue; r -= I_SQ;
        if (r < I_SQ) continue; r -= I_SQ;
        if (r < I_KV) { const int kb = r >> 7, nb = r & 127; p0_transpose_item(a.in[I_W_CKV], 2048, 4096, (bf16_t*)(ws + WS_WCKV), 64 * kb, 32 * nb, 32 * nb, scr, lane); continue; } r -= I_KV;
        if (r < I_SQ) continue; r -= I_SQ;
        { const int mat = r >> 6, n = (r >> 3) & 7, sub = r & 7, kb = sub >> 2, nb = sub & 3;
          p0_transpose_item((mat ? a.in[I_W_RG_X] : a.in[I_W_RG_A]) + n * 16384, 128, 128, (bf16_t*)(ws + WS_WRGT) + (mat * 8 + n) * 16384, 64 * kb, 32 * nb, 32 * nb, scr, lane); }
    }
    for (int m = gw; m < S_; m += 2 * NGW) { const int m1 = m + NGW; const bool two = m1 < S_;
        f32x4 va[8], vb[8]; const f32x4* xa = (const f32x4*)(a.in[I_X] + (size_t)m * DM) + lane; const f32x4* xb = (const f32x4*)(a.in[I_X] + (size_t)(two ? m1 : m) * DM) + lane;
#pragma unroll
        for (int j = 0; j < 8; ++j) { va[j] = xa[64 * j]; vb[j] = xb[64 * j]; }
        rms_row_i8(va, a.in[I_NORM_MIX_G], (signed char*)(ws + WS_XN) + (size_t)m * DM, (float*)(ws + WS_INSCALE) + m, lane);
        if (two) rms_row_i8(vb, a.in[I_NORM_MIX_G], (signed char*)(ws + WS_XN) + (size_t)m1 * DM, (float*)(ws + WS_INSCALE) + m1, lane); }
    for (int m = gw; m < NMEM; m += NGW) rms_row_bf16(a.in[I_MEM] + (size_t)m * DM, a.in[I_NORM_MEM_G], (bf16_t*)(ws + WS_MEMN) + (size_t)m * DM, lane);
}

__device__ __forceinline__ void store_bf16_tile(const f32x4 (&acc)[2][2][4][2], bf16_t* b0, bf16_t* b1, size_t pitch, float sc, int wr, int wc, int fr, int fq, float sc0 = 1.f) {
    const int r0 = wr * 64 + fr, cc = wc * 32 + 8 * fq;
#pragma unroll
    for (int ai = 0; ai < 2; ++ai)
#pragma unroll
        for (int m = 0; m < 4; ++m) { const size_t ro = (size_t)(r0 + ai * 128 + m * 16) * pitch + cc;
#pragma unroll
            for (int bj = 0; bj < 2; ++bj) { const float sb = bj ? sc : sc * sc0; const f32x4 v0 = acc[ai][bj][m][0] * sb, v1 = acc[ai][bj][m][1] * sb;
                u32x4 w; w.x = pk2(v0[0], v0[1]); w.y = pk2(v0[2], v0[3]); w.z = pk2(v1[0], v1[1]); w.w = pk2(v1[2], v1[3]);
                *(u32x4*)((bj ? b1 : b0) + ro) = w; } }
}
struct EpiInProj {
    static constexpr bool PERM = true;
    bf16_t *Q, *XR; unsigned* vmax;
    __device__ __forceinline__ void operator()(const f32x4 (&acc)[2][2][4][2], const pg8::Unit& u, int wr, int wc, int fr, int fq) const {
        const int pn = u.pn; bf16_t *b0, *b1; size_t pitch;
        if (pn < 12) {
            float m = 0.f;
#pragma unroll
            for (int ai = 0; ai < 2; ++ai)
#pragma unroll
                for (int bj = 0; bj < 2; ++bj)
#pragma unroll
                    for (int mm = 0; mm < 4; ++mm)
#pragma unroll
                        for (int n = 0; n < 2; ++n) { if (bj == 0 && pn < 8) continue; const f32x4 v = acc[ai][bj][mm][n]; m = fmaxf(fmaxf(m, fmaxf(fabsf(v[0]), fabsf(v[1]))), fmaxf(fabsf(v[2]), fabsf(v[3]))); }
#pragma unroll
            for (int o = 32; o > 0; o >>= 1) m = fmaxf(m, __shfl_xor(m, o));
            if ((threadIdx.x & 63) == 0) atomicMax(vmax + (pn < 8 ? 4 + 4 * (pn >> 2) : 0) + (pn & 3), __float_as_uint(m * 1.00390625f));
        }
        if (pn < 8) { bf16_t* T = Q + (size_t)(pn >> 2) * ((WS_K - WS_Q) / 2); const int hh = pn & 3; pitch = 128;
            b0 = T + ((size_t)(hh * 2 + 0) * S_ + (size_t)u.pm * 256) * 128; b1 = T + ((size_t)(hh * 2 + 1) * S_ + (size_t)u.pm * 256) * 128; }
        else if (pn < 12) { bf16_t* T = Q + (size_t)2 * ((WS_K - WS_Q) / 2); const int hh = pn & 3; pitch = 256;
            b0 = T + ((size_t)hh * S_ + (size_t)u.pm * 256) * 256; b1 = b0 + 128; }
        else { bf16_t* T = XR + (size_t)((pn - 12) >> 2) * ((WS_XG - WS_XR) / 2) + (pn & 3) * 256; pitch = 1024; b0 = T + (size_t)u.pm * 256 * 1024; b1 = b0 + 128; }
        store_bf16_tile(acc, b0, b1, pitch, 1.f, wr, wc, fr, fq, pn < 4 ? 0.12751743f   : 1.f);
    }
};
struct EpiInProjI8 {
    static constexpr bool PERM = true;
    EpiInProj base; const float* rowscale; const float* colscale;
    __device__ __forceinline__ void operator()(const pg8::i32x4 (&acc)[2][2][4][2], const pg8::Unit& u, int wr, int wc, int fr, int fq) const {
        f32x4 f[2][2][4][2];
        const float* rs = rowscale + (size_t)u.pm * 256 + wr * 64 + fr; const float* cs = colscale + (size_t)u.pn * 256 + wc * 32 + 8 * fq;
        f32x4 c4[2][2];
#pragma unroll
        for (int bj = 0; bj < 2; ++bj)
#pragma unroll
            for (int n = 0; n < 2; ++n) c4[bj][n] = *(const f32x4*)(cs + 128 * bj + 4 * n);
#pragma unroll
        for (int ai = 0; ai < 2; ++ai)
#pragma unroll
            for (int m = 0; m < 4; ++m) { const float r = rs[ai * 128 + m * 16];
#pragma unroll
                for (int bj = 0; bj < 2; ++bj)
#pragma unroll
                    for (int n = 0; n < 2; ++n) { const pg8::i32x4 a = acc[ai][bj][m][n]; const f32x4 c = c4[bj][n];
                        f[ai][bj][m][n] = (f32x4){(float)a[0] * (r * c[0]), (float)a[1] * (r * c[1]), (float)a[2] * (r * c[2]), (float)a[3] * (r * c[3])}; } }
        base(f, u, wr, wc, fr, fq);
    }
};
struct EpiSmall {
    static constexpr bool PERM = true;
    bf16_t *KM, *VT;
    __device__ __forceinline__ void operator()(const f32x4 (&acc)[2][2][4][2], const pg8::Unit& u, int wr, int wc, int fr, int fq) const {
        if (u.e == 0) { bf16_t* b0 = KM + u.pn * 256; store_bf16_tile(acc, b0, b0 + 128, 2048, 1.f, wr, wc, fr, fq); }
        else { bf16_t* b0 = VT + (size_t)u.pm * 256 * 256; store_bf16_tile(acc, b0, b0 + 128, 256, 1.f, wr, wc, fr, fq); }
    }
};
struct SmallOrder {
    const char* memn; const char* wckv; int c;
    __device__ __forceinline__ bool next(int i, pg8::Unit& u) const {
        if (i > 0 || c >= 16) return false;
        const int idx = c & 7; u.e = c >> 3;
        if (u.e == 0) { u.pm = 0; u.pn = idx; u.A = memn; u.B = wckv + (size_t)idx * 256 * 2048 * 2; }
        else { u.pm = idx; u.pn = 0; u.A = wckv + (size_t)(2048 + idx * 256) * 2048 * 2; u.B = memn; }
        return true;
    }
};
struct EpiBf16Plain {
    static constexpr bool PERM = true;
    bf16_t* O; int ldc;
    __device__ __forceinline__ void operator()(const f32x4 (&acc)[2][2][4][2], const pg8::Unit& u, int wr, int wc, int fr, int fq) const {
        bf16_t* b0 = O + (size_t)u.pm * 256 * ldc + u.pn * 256; store_bf16_tile(acc, b0, b0 + 128, (size_t)ldc, 1.f, wr, wc, fr, fq);
    }
};
struct EpiResF32 {
    static constexpr bool PERM = false;
    const bf16_t* res; bf16_t* out; const float* cs; float mul;
    __device__ __forceinline__ void operator()(const f32x4 (&acc)[2][2][4][2], const pg8::Unit& u, int wr, int wc, int fr, int fq) const {
        const int row0 = u.pm * 256 + wr * 64 + fr, col0 = u.pn * 256 + wc * 32 + 4 * fq;
#pragma unroll
        for (int ai = 0; ai < 2; ++ai)
#pragma unroll
            for (int m = 0; m < 4; ++m) { const size_t ro = (size_t)(row0 + ai * 128 + m * 16) * DM + col0;
#pragma unroll
                for (int bj = 0; bj < 2; ++bj)
#pragma unroll
                    for (int n = 0; n < 2; ++n) { const size_t p = ro + bj * 128 + 16 * n; const f32x4 r = ld_bf16x4(res + p); const f32x4 c4 = *(const f32x4*)(cs + col0 + bj * 128 + 16 * n) * mul; st_bf16x4(out + p, r + acc[ai][bj][m][n] * c4); } }
    }
};
struct EpiResNormF32 {
    static constexpr bool PERM = false;
    const float* res; bf16_t* out; unsigned char* HB; float* SSQ;
    __device__ __forceinline__ void operator()(const f32x4 (&acc)[2][2][4][2], const pg8::Unit& u, int wr, int wc, int fr, int fq) const {
        const int row0 = u.pm * 256 + wr * 64 + fr, col0 = u.pn * 256 + wc * 32 + 4 * fq;
#pragma unroll
        for (int ai = 0; ai < 2; ++ai)
#pragma unroll
            for (int m = 0; m < 4; ++m) { const int row = row0 + ai * 128 + m * 16; const size_t ro = (size_t)row * DM + col0; float ss = 0.f;
#pragma unroll
                for (int bj = 0; bj < 2; ++bj)
#pragma unroll
                    for (int n = 0; n < 2; ++n) { const size_t p = ro + bj * 128 + 16 * n; const f32x4 v = *(const f32x4*)(res + p) + acc[ai][bj][m][n]; st_bf16x4(out + p, v);
                        { const f32x4 q = {__builtin_amdgcn_fmed3f(v[0], -448.f, 448.f), __builtin_amdgcn_fmed3f(v[1], -448.f, 448.f), __builtin_amdgcn_fmed3f(v[2], -448.f, 448.f), __builtin_amdgcn_fmed3f(v[3], -448.f, 448.f)};
                          unsigned hb = 0; hb = __builtin_amdgcn_cvt_pk_fp8_f32(q[0], q[1], hb, false); hb = __builtin_amdgcn_cvt_pk_fp8_f32(q[2], q[3], hb, true); *(unsigned*)(HB + p) = hb; } ss += (v[0] * v[0] + v[1] * v[1]) + (v[2] * v[2] + v[3] * v[3]); }
                ss += __shfl_xor(ss, 16); ss += __shfl_xor(ss, 32);
                if (fq == 0) SSQ[(size_t)row * 32 + u.pn * 4 + wc] = ss; }
    }
};
struct EpiResNormI8 {
    static constexpr bool PERM = false;
    EpiResNormF32 base; const float* rowscale; const float* colscale;
    __device__ __forceinline__ void operator()(const pg8::i32x4 (&acc)[2][2][4][2], const pg8::Unit& u, int wr, int wc, int fr, int fq) const {
        f32x4 f[2][2][4][2];
        const float* rs = rowscale + (size_t)u.pm * 256 + wr * 64 + fr; const float* cs = colscale + (size_t)u.pn * 256 + wc * 32 + 4 * fq;
        f32x4 c4[2][2];
#pragma unroll
        for (int bj = 0; bj < 2; ++bj)
#pragma unroll
            for (int n = 0; n < 2; ++n) c4[bj][n] = *(const f32x4*)(cs + 128 * bj + 16 * n);
#pragma unroll
        for (int ai = 0; ai < 2; ++ai)
#pragma unroll
            for (int m = 0; m < 4; ++m) { const float r = rs[ai * 128 + m * 16];
#pragma unroll
                for (int bj = 0; bj < 2; ++bj)
#pragma unroll
                    for (int n = 0; n < 2; ++n) { const pg8::i32x4 a = acc[ai][bj][m][n]; const f32x4 c = c4[bj][n];
                        f[ai][bj][m][n] = (f32x4){(float)a[0] * (r * c[0]), (float)a[1] * (r * c[1]), (float)a[2] * (r * c[2]), (float)a[3] * (r * c[3])}; } }
        base(f, u, wr, wc, fr, fq);
    }
};
struct EpiBf16RowScale {
    static constexpr bool PERM = true;
    bf16_t* O; int ldc; const LAS float* rl; const float* cs;
    __device__ __forceinline__ void operator()(const f32x4 (&acc)[2][2][4][2], const pg8::Unit& u, int wr, int wc, int fr, int fq) const {
        bf16_t* b0 = O + (size_t)u.pm * 256 * ldc + u.pn * 256; const int r0 = wr * 64 + fr, cc = wc * 32 + 8 * fq;
#pragma unroll
        for (int ai = 0; ai < 2; ++ai)
#pragma unroll
            for (int m = 0; m < 4; ++m) { const int r = r0 + ai * 128 + m * 16; const float sc = rl[u.e * 256 + r]; const size_t ro = (size_t)r * ldc + cc;
#pragma unroll
                for (int bj = 0; bj < 2; ++bj) { const f32x4 c0 = *(const f32x4*)(cs + u.pn * 256 + bj * 128 + cc), c1 = *(const f32x4*)(cs + u.pn * 256 + bj * 128 + cc + 4); const f32x4 v0 = acc[ai][bj][m][0] * sc * c0, v1 = acc[ai][bj][m][1] * sc * c1;
                    u32x4 w; w.x = pk2(v0[0], v0[1]); w.y = pk2(v0[2], v0[3]); w.z = pk2(v1[0], v1[1]); w.w = pk2(v1[2], v1[3]);
                    *(u32x4*)(b0 + ro + bj * 128) = w; } }
    }
};
struct HeadOrderS {
    const char* QC; const char* KM; int G, c;
    __device__ __forceinline__ bool next(int i, pg8::Unit& u) const {
        const int L = i * G + c; if (L >= 256) return false;
        u.e = L & 3; u.pm = L >> 2; u.pn = 0; u.A = QC + ((size_t)u.pm * 256 * 2048 + u.e * 512) * 2; u.B = KM + (size_t)u.e * 512 * 2; return true;
    }
};
struct EpiScore {
    static constexpr bool PERM = true;
    bf16_t* PC; float* LPART;
    __device__ __forceinline__ void operator()(const f32x4 (&acc)[2][2][4][2], const pg8::Unit& u, int wr, int wc, int fr, int fq) const {
        constexpr float C2 = 1.4426950408889634f * 0.044194173824159216f;
        const int r0 = u.pm * 256 + wr * 64 + fr, cc = u.e * 256 + wc * 32 + 8 * fq;
#pragma unroll
        for (int ai = 0; ai < 2; ++ai)
#pragma unroll
            for (int m = 0; m < 4; ++m) { const int row = r0 + ai * 128 + m * 16; float ps = 0.f;
#pragma unroll
                for (int bj = 0; bj < 2; ++bj) { f32x4 v0 = acc[ai][bj][m][0], v1 = acc[ai][bj][m][1];
#pragma unroll
                    for (int i = 0; i < 4; ++i) { v0[i] = __builtin_amdgcn_exp2f(v0[i] * C2); v1[i] = __builtin_amdgcn_exp2f(v1[i] * C2); }
                    u32x4 w; w.x = pk2(v0[0], v0[1]); w.y = pk2(v0[2], v0[3]); w.z = pk2(v1[0], v1[1]); w.w = pk2(v1[2], v1[3]);
                    ps += (bflo(w.x) + bfhi(w.x)) + (bflo(w.y) + bfhi(w.y)) + (bflo(w.z) + bfhi(w.z)) + (bflo(w.w) + bfhi(w.w));
                    *(u32x4*)(PC + (size_t)row * 1024 + cc + bj * 128) = w; }
                ps += __shfl_xor(ps, 16); ps += __shfl_xor(ps, 32);
                if (fq == 0) LPART[((size_t)row * 4 + u.e) * 4 + wc] = ps; }
    }
};
struct HeadOrderO {
    const char* PC; const char* VT; int G, c;
    __device__ __forceinline__ bool next(int i, pg8::Unit& u) const {
        int L = i * G + c; if (L >= 512) return false;
        if (G == 256) L = 8 * (c >> 2) + 4 * i + (c & 3);
        u.e = L & 3; u.pn = (L >> 2) & 1; u.pm = L >> 3; u.A = PC + ((size_t)u.pm * 256 * 1024 + u.e * 256) * 2; u.B = VT + ((size_t)(u.e * 512 + u.pn * 256) * 256) * 2; return true;
    }
};
struct EpiCrossO {
    static constexpr bool PERM = true;
    unsigned char* OC; const float* LPART;
    __device__ __forceinline__ void operator()(const f32x4 (&acc)[2][2][4][2], const pg8::Unit& u, int wr, int wc, int fr, int fq) const {
        const int r0 = u.pm * 256 + wr * 64 + fr, cc = u.e * 512 + u.pn * 256 + wc * 32 + 8 * fq;
#pragma unroll
        for (int ai = 0; ai < 2; ++ai)
#pragma unroll
            for (int m = 0; m < 4; ++m) { const int row = r0 + ai * 128 + m * 16; const f32x4 lp = *(const f32x4*)(LPART + ((size_t)row * 4 + u.e) * 4);
                const float inv = 16.0f * __builtin_amdgcn_rcpf((lp[0] + lp[1]) + (lp[2] + lp[3]));
#pragma unroll
                for (int bj = 0; bj < 2; ++bj) { f32x4 v0 = acc[ai][bj][m][0] * inv, v1 = acc[ai][bj][m][1] * inv;
#pragma unroll
                    for (int i = 0; i < 4; ++i) { v0[i] = __builtin_amdgcn_fmed3f(v0[i], -448.f, 448.f); v1[i] = __builtin_amdgcn_fmed3f(v1[i], -448.f, 448.f); }
                    u32x2 w; w.x = 0; w.y = 0;
                    w.x = __builtin_amdgcn_cvt_pk_fp8_f32(v0[0], v0[1], w.x, false); w.x = __builtin_amdgcn_cvt_pk_fp8_f32(v0[2], v0[3], w.x, true);
                    w.y = __builtin_amdgcn_cvt_pk_fp8_f32(v1[0], v1[1], w.y, false); w.y = __builtin_amdgcn_cvt_pk_fp8_f32(v1[2], v1[3], w.y, true);
                    *(u32x2*)(OC + (size_t)row * 2048 + cc + bj * 128) = w; } }
    }
};
struct GroupOrder {
    const char* A; const char* W; const int* texp; size_t wstride, tstride; int nrt, NT, G, c;
    __device__ __forceinline__ bool next(int i, pg8::Unit& u) const {
        const int L = i * G + c; if (L >= nrt * NT) return false;
        const int rt = L / NT; u.pm = rt; u.pn = L - rt * NT; u.e = texp[rt];
        u.A = A + (size_t)rt * tstride; u.B = W + (size_t)u.e * wstride + (size_t)u.pn * tstride; return true;
    }
};
struct GroupOrderG {
    const char* A; const char* W; const int* texp; const int* rows; size_t wstride, tstride; int nrt, NT, G, c;
    __device__ __forceinline__ bool next(int i, pg8::Unit& u) const {
        const int L = i * G + c; if (L >= nrt * NT) return false;
        const int rt = L / NT; u.pm = rt; u.pn = L - rt * NT; u.e = texp[rt];
        u.A = A; u.B = W + (size_t)u.e * wstride + (size_t)u.pn * tstride; return true;
    }
};
struct EpiGateUp {
    static constexpr bool PERM = true;
    bf16_t* ACT; const float* bgu;
    __device__ __forceinline__ void operator()(const f32x4 (&acc)[2][2][4][2], const pg8::Unit& u, int wr, int wc, int fr, int fq) const {
        const int r0 = u.pm * 256 + wr * 64 + fr, j0 = u.pn * 128 + wc * 32 + 8 * fq;
        const float* bg = bgu + (size_t)u.e * 4096 + j0; float g8[8], u8[8];
#pragma unroll
        for (int i = 0; i < 8; ++i) { g8[i] = bg[i]; u8[i] = bg[2048 + i]; }
#pragma unroll
        for (int ai = 0; ai < 2; ++ai)
#pragma unroll
            for (int m = 0; m < 4; ++m) { const int row = r0 + ai * 128 + m * 16; float o[8];
#pragma unroll
                for (int i = 0; i < 8; ++i) { float gt = acc[ai][0][m][i >> 2][i & 3] + g8[i], up = acc[ai][1][m][i >> 2][i & 3] + u8[i];
                    gt = fminf(gt, 7.0f); up = fminf(fmaxf(up, -7.0f), 7.0f);
                    o[i] = (up + 1.0f) * gt * sigmoidf_(1.702f * gt); }
                u32x4 w; w.x = pk2(o[0], o[1]); w.y = pk2(o[2], o[3]); w.z = pk2(o[4], o[5]); w.w = pk2(o[6], o[7]);
                *(u32x4*)(ACT + (size_t)row * 2048 + j0) = w; }
    }
};
struct EpiGateUpI8 {
    static constexpr bool PERM = true;
    signed char* ACT; const float* bgu; const float* rowscale; const float* sb;
    __device__ __forceinline__ void operator()(const pg8::i32x4 (&acc)[2][2][4][2], const pg8::Unit& u, int wr, int wc, int fr, int fq) const {
        const int r0 = u.pm * 256 + wr * 64 + fr, cw = wc * 32 + 8 * fq, j0 = u.pn * 128 + cw;
        const float* bg = bgu + (size_t)u.e * 4096 + j0; const float* sp = sb + (size_t)u.e * 4096 + u.pn * 256 + cw; float g8[8], u8[8], sg8[8], su8[8];
#pragma unroll
        for (int i = 0; i < 8; ++i) { g8[i] = bg[i]; u8[i] = bg[2048 + i]; sg8[i] = sp[i]; su8[i] = sp[128 + i]; }
#pragma unroll
        for (int ai = 0; ai < 2; ++ai)
#pragma unroll
            for (int m = 0; m < 4; ++m) { const int row = r0 + ai * 128 + m * 16; const float rs = rowscale[row]; float o[8];
#pragma unroll
                for (int i = 0; i < 8; ++i) { float gt = (float)acc[ai][0][m][i >> 2][i & 3] * (rs * sg8[i]) + g8[i], up = (float)acc[ai][1][m][i >> 2][i & 3] * (rs * su8[i]) + u8[i];
                    gt = fminf(gt, 7.0f); up = fminf(fmaxf(up, -7.0f), 7.0f);
                    o[i] = (up + 1.0f) * gt * sigmoidf_(1.702f * gt); }
                unsigned q[8];
#pragma unroll
                for (int i = 0; i < 8; ++i) q[i] = (unsigned)(int)rintf(fminf(fmaxf(o[i] * (1.0f / ACT_QSCALE), -127.0f), 127.0f)) & 0xffu;
                u32x2 w; w.x = q[0] | (q[1] << 8) | (q[2] << 16) | (q[3] << 24); w.y = q[4] | (q[5] << 8) | (q[6] << 16) | (q[7] << 24);
                *(u32x2*)(ACT + (size_t)row * 2048 + j0) = w; }
    }
};
constexpr float YB_SCALE = 32.0f;
struct EpiDown {
    static constexpr bool PERM = true;
    unsigned char* YB; const float* bdn; const float* rowgate; const float* sb;
    __device__ __forceinline__ void operator()(const pg8::i32x4 (&acc)[2][2][4][2], const pg8::Unit& u, int wr, int wc, int fr, int fq) const {
        const int r0 = u.pm * 256 + wr * 64 + fr, c0 = u.pn * 256 + wc * 32 + 8 * fq;
        float b8[2][8], s8[2][8];
#pragma unroll
        for (int bj = 0; bj < 2; ++bj)
#pragma unroll
            for (int i = 0; i < 8; ++i) { b8[bj][i] = bdn[(size_t)u.e * 2048 + c0 + bj * 128 + i] * YB_SCALE; s8[bj][i] = sb[(size_t)u.e * 2048 + c0 + bj * 128 + i] * (ACT_QSCALE * YB_SCALE); }
#pragma unroll
        for (int ai = 0; ai < 2; ++ai)
#pragma unroll
            for (int m = 0; m < 4; ++m) { const int row = r0 + ai * 128 + m * 16; const float g = rowgate[row];
#pragma unroll
                for (int bj = 0; bj < 2; ++bj) { float o[8];
#pragma unroll
                    for (int i = 0; i < 8; ++i) o[i] = __builtin_amdgcn_fmed3f(((float)acc[ai][bj][m][i >> 2][i & 3] * s8[bj][i] + b8[bj][i]) * g, -448.0f, 448.0f);
                    u32x2 w; w.x = 0; w.y = 0;
                    w.x = __builtin_amdgcn_cvt_pk_fp8_f32(o[0], o[1], w.x, false); w.x = __builtin_amdgcn_cvt_pk_fp8_f32(o[2], o[3], w.x, true);
                    w.y = __builtin_amdgcn_cvt_pk_fp8_f32(o[4], o[5], w.y, false); w.y = __builtin_amdgcn_cvt_pk_fp8_f32(o[6], o[7], w.y, true);
                    *(u32x2*)(YB + (size_t)row * 2048 + c0 + bj * 128) = w; } }
    }
};
__device__ __forceinline__ void rg_local(unsigned char* ws, LAS unsigned char* lds, int ubeg, int ustride) {
    CArgs& a = *kargs();
    const int tid = threadIdx.x, wave = __builtin_amdgcn_readfirstlane(tid >> 6), lane = tid & 63, fr = lane & 15, fq = lane >> 4;
    LAS bf16_t* XCB = (LAS bf16_t*)lds;
    LAS float* XCF = (LAS float*)(lds + 17408);
    LAS float* AF = (LAS float*)(lds + 17408 + 32768);
    LAS float* BF = (LAS float*)(lds + 17408 + 65536);
    LAS float* QA = (LAS float*)(lds + 17408 + 98304);
    LAS float* QH = QA + 512;
    const bf16_t* XR = (const bf16_t*)(ws + WS_XR); const bf16_t* WRGT = (const bf16_t*)(ws + WS_WRGT);
    bf16_t* HL = (bf16_t*)(ws + WS_HL); bf16_t* ACUM = (bf16_t*)(ws + WS_ACUM); float* ACH = (float*)(ws + WS_ACH); float* HCH = (float*)(ws + WS_HCH);
    int n_cur = -1; f32x4 w0, w1, w2, w3, bb; float ba = 0.f, bx = 0.f, sp8 = 0.f; bf16x8 br[4], bi[4];
    const int c4 = (tid & 31) * 4, tg = tid >> 5, d0 = 16 * wave;
    u32x2 xr[7];
#define RG_LOADX(uu) do { const int t0_ = 64 * ((uu) >> 3), ch_ = 128 * ((uu) & 7) + c4;                                                              \
        _Pragma("unroll") for (int i = 0; i < 7; ++i) { const int tt = t0_ + 4 * tg - 3 + i; xr[i] = tt >= 0 ? *(const u32x2*)(XR + (size_t)tt * 1024 + ch_) : (u32x2){0u, 0u}; } } while (0)
    if (ubeg < 2048) RG_LOADX(ubeg);
    for (int u = ubeg; u < 2048; u += ustride) {
        const int j = u >> 3, n = u & 7, t0 = 64 * j, cb = 128 * n;
        if (n != n_cur) { n_cur = n; const int ch = cb + c4;
            w0 = *(const f32x4*)(a.in[I_CONV_W] + ch); w1 = *(const f32x4*)(a.in[I_CONV_W] + 1024 + ch); w2 = *(const f32x4*)(a.in[I_CONV_W] + 2048 + ch); w3 = *(const f32x4*)(a.in[I_CONV_W] + 3072 + ch);
            bb = *(const f32x4*)(a.in[I_CONV_B] + ch);
            const int chd = cb + d0 + fr; ba = a.in[I_B_RG_A][chd]; bx = a.in[I_B_RG_X][chd]; sp8 = 8.0f * log1pf(__expf(-a.in[I_RG_LAMBDA][chd]));
#pragma unroll
            for (int s = 0; s < 4; ++s) { br[s] = *(const bf16x8*)(WRGT + ((size_t)(0 * 8 + n) * 128 + d0 + fr) * 128 + 32 * s + 8 * fq); bi[s] = *(const bf16x8*)(WRGT + ((size_t)(1 * 8 + n) * 128 + d0 + fr) * 128 + 32 * s + 8 * fq); } }
        {
            f32x4 x[7];
#pragma unroll
            for (int i = 0; i < 7; ++i) x[i] = (f32x4){bflo(xr[i].x), bfhi(xr[i].x), bflo(xr[i].y), bfhi(xr[i].y)};
#pragma unroll
            for (int i = 0; i < 4; ++i) { const f32x4 xc = bb + w0 * x[i] + w1 * x[i + 1] + w2 * x[i + 2] + w3 * x[i + 3]; const int t = 4 * tg + i;
                *(LAS f32x4*)(XCF + t * 128 + c4) = xc; u32x2 pk; pk.x = pk2(xc[0], xc[1]); pk.y = pk2(xc[2], xc[3]); *(LAS u32x2*)(XCB + t * 136 + c4) = pk; }
            if (u + ustride < 2048) RG_LOADX(u + ustride);
        }
        __syncthreads();
        {
            f32x4 ar[4], ai[4];
#pragma unroll
            for (int m = 0; m < 4; ++m) { ar[m] = (f32x4){0.f, 0.f, 0.f, 0.f}; ai[m] = (f32x4){0.f, 0.f, 0.f, 0.f}; }
#pragma unroll
            for (int s = 0; s < 4; ++s) {
#pragma unroll
                for (int m = 0; m < 4; ++m) { const bf16x8 af = *(const LAS bf16x8*)(XCB + (16 * m + fr) * 136 + 32 * s + 8 * fq);
                    ar[m] = __builtin_amdgcn_mfma_f32_16x16x32_bf16(af, br[s], ar[m], 0, 0, 0); ai[m] = __builtin_amdgcn_mfma_f32_16x16x32_bf16(af, bi[s], ai[m], 0, 0, 0); }
            }
            const int d = d0 + fr;
#pragma unroll
            for (int m = 0; m < 4; ++m)
#pragma unroll
                for (int r = 0; r < 4; ++r) { const int t = 16 * m + 4 * fq + r;
                    const float rg = sigmoidf_(ar[m][r] + ba), ig = sigmoidf_(ai[m][r] + bx), la = -sp8 * rg, y = -2.0f * la;
                    const float em = (y > 0.5f) ? -expm1f(-y) : y * (1.0f + y * (-0.5f + y * (0.16666667f + y * (-0.041666668f + y * (0.0083333338f + y * -0.0013888889f)))));
                    AF[t * 128 + d] = __expf(la); BF[t * 128 + d] = sqrtf(em) * (ig * XCF[t * 128 + d]); }
        }
        __syncthreads();
        {
            const int c = tid & 127, q = tid >> 7; float hv[16], pv[16]; float h = 0.f, P = 1.f;
#pragma unroll
            for (int i = 0; i < 16; ++i) { const float av = AF[(16 * q + i) * 128 + c]; h = av * h + BF[(16 * q + i) * 128 + c]; P *= av; hv[i] = h; pv[i] = P; }
            QA[q * 128 + c] = P; QH[q * 128 + c] = h;
            __syncthreads();
            float hin = 0.f, pin = 1.f;
            for (int qq = 0; qq < q; ++qq) { const float qa = QA[qq * 128 + c]; hin = qa * hin + QH[qq * 128 + c]; pin *= qa; }
#pragma unroll
            for (int i = 0; i < 16; ++i) { const float hh = hv[i] + pv[i] * hin, pp = pv[i] * pin;
                BF[(16 * q + i) * 128 + c] = hh; AF[(16 * q + i) * 128 + c] = pp;
                if (q == 3 && i == 15) { ACH[(size_t)j * 1024 + cb + c] = pp; HCH[(size_t)j * 1024 + cb + c] = hh; } }
        }
        __syncthreads();
        {
            const int c4 = (tid & 31) * 4, r = tid >> 5;
#pragma unroll
            for (int p = 0; p < 4; ++p) { const int t = r + 16 * p; const size_t g = (size_t)(t0 + t) * 1024 + cb + c4;
                const f32x4 hh = *(const LAS f32x4*)(BF + t * 128 + c4), pp = *(const LAS f32x4*)(AF + t * 128 + c4);
                u32x2 o; o.x = pk2(hh[0], hh[1]); o.y = pk2(hh[2], hh[3]); *(u32x2*)(HL + g) = o;
                o.x = pk2(pp[0], pp[1]); o.y = pk2(pp[2], pp[3]); *(u32x2*)(ACUM + g) = o; }
        }
        __syncthreads();
    }
}

#undef RG_LOADX
__device__ __forceinline__ void carry_scan(unsigned char* ws, LAS unsigned char* lds, int G) {
    const int tid = threadIdx.x, wave = __builtin_amdgcn_readfirstlane(tid >> 6), lane = tid & 63;
    const float* ACH = (const float*)(ws + WS_ACH); const float* HCH = (const float*)(ws + WS_HCH); float* CARRY = (float*)(ws + WS_CARRY);
    LAS f32x4* WTA = (LAS f32x4*)lds; LAS f32x4* WTH = (LAS f32x4*)(lds + 64);
    for (int cg = blockIdx.x; cg < 256; cg += G) {
        f32x4 A4 = {1.f, 1.f, 1.f, 1.f}, H4 = {0.f, 0.f, 0.f, 0.f};
        if (tid < 256) { A4 = *(const f32x4*)(ACH + (size_t)tid * 1024 + 4 * cg); H4 = *(const f32x4*)(HCH + (size_t)tid * 1024 + 4 * cg); }
#pragma unroll
        for (int off = 1; off < 64; off <<= 1) {
            f32x4 pa, ph;
#pragma unroll
            for (int i = 0; i < 4; ++i) { pa[i] = __shfl_up(A4[i], off); ph[i] = __shfl_up(H4[i], off); }
            if (lane >= off) { H4 = A4 * ph + H4; A4 = A4 * pa; }
        }
        if (tid < 256 && lane == 63) { WTA[wave] = A4; WTH[wave] = H4; }
        __syncthreads();
        if (tid < 256) {
            f32x4 ph = {0.f, 0.f, 0.f, 0.f};
            for (int w = 0; w < wave; ++w) { const f32x4 ta = WTA[w], th = WTH[w]; ph = ta * ph + th; }
            const f32x4 hinc = A4 * ph + H4;
            if (tid + 1 < 256) *(f32x4*)(CARRY + (size_t)(tid + 1) * 1024 + 4 * cg) = hinc;
            if (tid == 0) *(f32x4*)(CARRY + 4 * cg) = (f32x4){0.f, 0.f, 0.f, 0.f};
        }
        __syncthreads();
    }
}

__device__ __forceinline__ void convert_late_weights(unsigned char* ws, LAS unsigned char* lds, int G) {
    CArgs& a = *kargs(); const int wave = wave_id(), lane = lane_id();
    LAS float* scr = (LAS float*)(lds + wave * 16384);
    const int gw = blockIdx.x * NWAVES + wave, NGW = G * NWAVES;
    convert_strips_i8(a.in[I_W_OUT], 2048, (signed char*)(ws + WS_WOUT), (float*)(ws + WS_SBOUT), lds, blockIdx.x, G);
    convert_strips_i8<true>(a.in[I_W_CQ], 2048, (signed char*)(ws + WS_WCQ), (float*)(ws + WS_SBCQ), lds, ((int)blockIdx.x + G - 64) % G, G, a.in[I_NORM_CROSS_G]);
    convert_strips_i8<true>(a.in[I_W_CO], 2048, (signed char*)(ws + WS_WCO), (float*)(ws + WS_SBCO), lds, ((int)blockIdx.x + G - 128) % G, G);
    __syncthreads();
}
constexpr size_t WS_VT8 = WS_ACT;
__device__ __forceinline__ float v_fp8_scale(const unsigned char* ws, int head) { const float am = __uint_as_float(((const unsigned*)(ws + WS_CTL))[CW_VMAX + head]); return am > 0.f ? 240.0f / am : 1.0f; }
constexpr size_t WS_Q8 = WS_VT8 + 16 * MiB, WS_K8 = WS_VT8 + 24 * MiB;
__device__ __forceinline__ float fp8_amax_scale(const unsigned char* ws, int word) { const float am = __uint_as_float(((const unsigned*)(ws + WS_CTL))[CW_VMAX + word]); return am > 0.f ? 240.0f / am : 1.0f; }
__device__ __forceinline__ int qk_fp8_shift(const unsigned char* ws, int head) { int e; (void)frexpf(fp8_amax_scale(ws, 4 + head) * fp8_amax_scale(ws, 8 + head) * (1.0f / 0.12751743f), &e); return e - 1; }
__device__ __forceinline__ float qk_fp8_scale(const unsigned char* ws, int which, int head) {
    const float sk = fp8_amax_scale(ws, 8 + head); if (which) return sk;
    return 0.12751743f * ldexpf(1.0f, qk_fp8_shift(ws, head)) / sk; }
__device__ __forceinline__ void convert_v_fp8(unsigned char* ws, LAS unsigned char* lds, int G) {
    const int wave = wave_id(), lane = lane_id();
    for (int i = blockIdx.x * NTHREADS + threadIdx.x; i < 2 * 4 * S_ * 16; i += G * NTHREADS) {
        const int which = i >> 20, head = (i >> 18) & 3, rem = i & ((1 << 18) - 1);
        const float sc = qk_fp8_scale(ws, which, head);
        const u32x4 w = *(const u32x4*)((const bf16_t*)(ws + (which ? WS_K : WS_Q)) + (size_t)(2 * head + 1) * S_ * 128 + (size_t)rem * 8);
        unsigned b0 = 0, b1 = 0;
        b0 = __builtin_amdgcn_cvt_pk_fp8_f32(bflo(w.x) * sc, bfhi(w.x) * sc, b0, false); b0 = __builtin_amdgcn_cvt_pk_fp8_f32(bflo(w.y) * sc, bfhi(w.y) * sc, b0, true);
        b1 = __builtin_amdgcn_cvt_pk_fp8_f32(bflo(w.z) * sc, bfhi(w.z) * sc, b1, false); b1 = __builtin_amdgcn_cvt_pk_fp8_f32(bflo(w.w) * sc, bfhi(w.w) * sc, b1, true);
        u32x2 o; o.x = b0; o.y = b1;
        *(u32x2*)(ws + (which ? WS_K8 : WS_Q8) + (size_t)head * S_ * 128 + (size_t)rem * 8) = o;
    }
    LAS unsigned char* T = lds + wave * 8192;
    for (int job = blockIdx.x * NWAVES + wave; job < 2048; job += G * NWAVES) {
        const int head = job >> 9, tile = (job >> 1) & 255, half = job & 1;
        const float vs = v_fp8_scale(ws, head);
        const bf16_t* src = (const bf16_t*)(ws + WS_V) + ((size_t)head * S_ + (size_t)tile * 64) * 256 + half * 128;
#pragma unroll 4
        for (int i = 0; i < 16; ++i) { const int idx = i * 64 + lane, key = idx >> 4, ch = idx & 15;
            const u32x4 w = *(const u32x4*)(src + (size_t)key * 256 + ch * 8);
            const int kp = key & 31, pos = ((kp >> 2) & 1) * 32 + (key >> 5) * 16 + (kp & 3) + 4 * (kp >> 3);
            unsigned b0 = 0, b1 = 0;
            b0 = __builtin_amdgcn_cvt_pk_fp8_f32(bflo(w.x) * vs, bfhi(w.x) * vs, b0, false); b0 = __builtin_amdgcn_cvt_pk_fp8_f32(bflo(w.y) * vs, bfhi(w.y) * vs, b0, true);
            b1 = __builtin_amdgcn_cvt_pk_fp8_f32(bflo(w.z) * vs, bfhi(w.z) * vs, b1, false); b1 = __builtin_amdgcn_cvt_pk_fp8_f32(bflo(w.w) * vs, bfhi(w.w) * vs, b1, true);
            LAS unsigned char* d = T + (ch * 8) * 64 + pos;
            d[0 * 64] = (unsigned char)b0; d[1 * 64] = (unsigned char)(b0 >> 8); d[2 * 64] = (unsigned char)(b0 >> 16); d[3 * 64] = (unsigned char)(b0 >> 24);
            d[4 * 64] = (unsigned char)b1; d[5 * 64] = (unsigned char)(b1 >> 8); d[6 * 64] = (unsigned char)(b1 >> 16); d[7 * 64] = (unsigned char)(b1 >> 24); }
        LDS_WAIT(); asm volatile("" ::: "memory");
        unsigned char* dst = ws + WS_VT8 + (((size_t)head * 256 + tile) * 256 + half * 128) * 64;
#pragma unroll
        for (int i = 0; i < 8; ++i) { const int idx = i * 64 + lane; *(u32x4*)(dst + (size_t)idx * 16) = *(const LAS u32x4*)(T + idx * 16); }
        LDS_WAIT(); asm volatile("" ::: "memory");
    }
    __syncthreads();
}

constexpr int CW_ATTQ = 8192;
__device__ __forceinline__ void attn_phase(unsigned char* ws, char* lds, volatile LAS unsigned* MISC, int G) {
    const int c = blockIdx.x, hp = (c & 7) >> 1;
    unsigned* qctr = (unsigned*)(ws + WS_CTL) + CW_ATTQ + 64 * hp;
    if (G != 256) {
        for (int L = c; L < 512; L += G) { const int u = L & 7;
            if ((u & 1) == 0) att2::attn_block_b16((const bf16_t*)(ws + WS_Q) + (size_t)u * S_ * 128, (const bf16_t*)(ws + WS_K) + (size_t)u * S_ * 128, (const bf16_t*)(ws + WS_V) + (size_t)(u >> 1) * S_ * 256,
                                                   (bf16_t*)(ws + WS_AO) + (size_t)u * S_ * 256, L >> 3, lds);
            else att2::attn_block(ws + WS_Q8 + (size_t)(u >> 1) * S_ * 128, ws + WS_K8 + (size_t)(u >> 1) * S_ * 128, qk_fp8_shift(ws, u >> 1), ws + WS_VT8 + (size_t)(u >> 1) * 256 * 16384, 1.0f / v_fp8_scale(ws, u >> 1),
                                  (bf16_t*)(ws + WS_AO) + (size_t)u * S_ * 256, L >> 3, lds); }
        return; }
    const int cohort = (c >> 3) & 3; int ndone = 0; bool strips_done = false;
    for (;;) {
        if (!strips_done && ndone == (cohort ? 1 : 0)) { convert_expert_strips(ws, (LAS unsigned char*)lds, c, 256); convert_late_weights(ws, (LAS unsigned char*)lds, G); strips_done = true; }
        if (threadIdx.x == 0) MISC[16] = __hip_atomic_fetch_add(qctr, 1u, __ATOMIC_RELAXED, __HIP_MEMORY_SCOPE_AGENT);
        __syncthreads();
        const unsigned idx = MISC[16];
        __syncthreads();
        if (idx >= 128u) break;
        {
            unsigned char* w2 = kargs()->ws; const int u = (((int)blockIdx.x & 7) & ~1) | (int)(idx & 1u), qb = 63 - (int)(idx >> 1);
            if ((idx & 1u) == 0) att2::attn_block_b16((const bf16_t*)(w2 + WS_Q) + (size_t)u * S_ * 128, (const bf16_t*)(w2 + WS_K) + (size_t)u * S_ * 128, (const bf16_t*)(w2 + WS_V) + (size_t)(u >> 1) * S_ * 256,
                                                      (bf16_t*)(w2 + WS_AO) + (size_t)u * S_ * 256, qb, lds);
            else att2::attn_block(w2 + WS_Q8 + (size_t)(u >> 1) * S_ * 128, w2 + WS_K8 + (size_t)(u >> 1) * S_ * 128, qk_fp8_shift(w2, u >> 1), w2 + WS_VT8 + (size_t)(u >> 1) * 256 * 16384,
                                  1.0f / v_fp8_scale(w2, u >> 1), (bf16_t*)(w2 + WS_AO) + (size_t)u * S_ * 256, qb, lds); }
        ++ndone;
    }
    if (!strips_done) { convert_expert_strips(ws, (LAS unsigned char*)lds, c, 256); convert_late_weights(ws, (LAS unsigned char*)lds, G); }
}

__device__ __forceinline__ void post_mix(unsigned char* ws, int G) {
    CArgs& a = *kargs(); const int wave = wave_id(), lane = lane_id();
    const int gw = blockIdx.x * NWAVES + wave, NGW = G * NWAVES;
    float s1 = 0.f, s2 = 0.f;
    for (int i = lane; i < 128; i += 64) { s1 += a.in[I_LQ1][i] * a.in[I_LK1][i]; s2 += a.in[I_LQ2][i] * a.in[I_LK2][i]; }
    const float lam = __expf(wave_sum(s1)) - __expf(wave_sum(s2)) + LAMBDA_INIT;
    const bf16_t* AO = (const bf16_t*)(ws + WS_AO); const bf16_t* XG = (const bf16_t*)(ws + WS_XG);
    const bf16_t* HL = (const bf16_t*)(ws + WS_HL); const bf16_t* ACUM = (const bf16_t*)(ws + WS_ACUM); const float* CARRY = (const float*)(ws + WS_CARRY);
    const int d = 4 * lane;
    const f32x4 sg = *(const f32x4*)(a.in[I_SUBLN_G] + d);
    signed char* MIX8 = (signed char*)(ws + WS_MIX); float* MIXSCALE = (float*)(ws + WS_MIXSCALE);
    struct RowIn { u32x2 o0[4], o1[4], hl[4], ac[4], xg[4]; f32x4 cr[4]; };
    f32x4 rg[4];
#pragma unroll
    for (int j = 0; j < 4; ++j) rg[j] = *(const f32x4*)(a.in[I_REC_NORM_G] + 4 * lane + 256 * j);
    auto load_row = [&](int t, RowIn& R) {
#pragma unroll
        for (int hh = 0; hh < 4; ++hh) { R.o0[hh] = *(const u32x2*)(AO + ((size_t)(hh * 2 + 0) * S_ + t) * 256 + d); R.o1[hh] = *(const u32x2*)(AO + ((size_t)(hh * 2 + 1) * S_ + t) * 256 + d); }
        const int chunk = t >> 6;
#pragma unroll
        for (int j = 0; j < 4; ++j) { const int c = 4 * lane + 256 * j;
            R.hl[j] = *(const u32x2*)(HL + (size_t)t * 1024 + c); R.ac[j] = *(const u32x2*)(ACUM + (size_t)t * 1024 + c); R.xg[j] = *(const u32x2*)(XG + (size_t)t * 1024 + c); R.cr[j] = *(const f32x4*)(CARRY + (size_t)chunk * 1024 + c); }
    };
    auto finish_row = [&](int t, const RowIn& R) {
        f32x4 av[4]; float am = 0.f;
#pragma unroll
        for (int hh = 0; hh < 4; ++hh) { const u32x2 o0 = R.o0[hh], o1 = R.o1[hh];
            f32x4 v; v[0] = bflo(o0.x) - lam * bflo(o1.x); v[1] = bfhi(o0.x) - lam * bfhi(o1.x); v[2] = bflo(o0.y) - lam * bflo(o1.y); v[3] = bfhi(o0.y) - lam * bfhi(o1.y);
            const float ss = wave_sum((v[0] * v[0] + v[1] * v[1]) + (v[2] * v[2] + v[3] * v[3]));
            const float r = rsqrtf(ss * (1.f / 256.f) + DA_EPS_) * (1.0f - LAMBDA_INIT);
            av[hh] = (f32x4){v[0] * r * sg[0], v[1] * r * sg[1], v[2] * r * sg[2], v[3] * r * sg[3]};
            am = fmaxf(fmaxf(am, fmaxf(fabsf(av[hh][0]), fabsf(av[hh][1]))), fmaxf(fabsf(av[hh][2]), fabsf(av[hh][3]))); }
        f32x4 y[4]; float ss = 0.f;
#pragma unroll
        for (int j = 0; j < 4; ++j) { const u32x2 hl2 = R.hl[j], ac2 = R.ac[j], xg = R.xg[j]; const f32x4 cr = R.cr[j];
            const f32x4 hl = {bflo(hl2.x), bfhi(hl2.x), bflo(hl2.y), bfhi(hl2.y)}, ac = {bflo(ac2.x), bfhi(ac2.x), bflo(ac2.y), bfhi(ac2.y)};
            const f32x4 h = hl + ac * cr;
            y[j][0] = h[0] * gelu_tanh(bflo(xg.x)); y[j][1] = h[1] * gelu_tanh(bfhi(xg.x)); y[j][2] = h[2] * gelu_tanh(bflo(xg.y)); y[j][3] = h[3] * gelu_tanh(bfhi(xg.y));
            ss += (y[j][0] * y[j][0] + y[j][1] * y[j][1]) + (y[j][2] * y[j][2] + y[j][3] * y[j][3]); }
        const float r = rsqrtf(wave_sum(ss) * (1.f / 1024.f) + EPS_);
#pragma unroll
        for (int j = 0; j < 4; ++j) { const f32x4 g = rg[j];
            y[j] = (f32x4){y[j][0] * r * g[0], y[j][1] * r * g[1], y[j][2] * r * g[2], y[j][3] * r * g[3]};
            am = fmaxf(fmaxf(am, fmaxf(fabsf(y[j][0]), fabsf(y[j][1]))), fmaxf(fabsf(y[j][2]), fabsf(y[j][3]))); }
#pragma unroll
        for (int o = 32; o > 0; o >>= 1) am = fmaxf(am, __shfl_xor(am, o));
        const float inv = am > 0.f ? 127.0f / am : 0.f;
#define PM_Q8(V) __builtin_amdgcn_perm(__builtin_amdgcn_perm(__float_as_uint(fmaf(V[3], inv, 12582912.0f)), __float_as_uint(fmaf(V[2], inv, 12582912.0f)), 0x0c0c0400u), \
                                       __builtin_amdgcn_perm(__float_as_uint(fmaf(V[1], inv, 12582912.0f)), __float_as_uint(fmaf(V[0], inv, 12582912.0f)), 0x0c0c0400u), 0x05040100u)
#pragma unroll
        for (int hh = 0; hh < 4; ++hh) *(unsigned*)(MIX8 + (size_t)t * DM + hh * 256 + d) = PM_Q8(av[hh]);
#pragma unroll
        for (int j = 0; j < 4; ++j) *(unsigned*)(MIX8 + (size_t)t * DM + 1024 + 4 * lane + 256 * j) = PM_Q8(y[j]);
#undef PM_Q8
        if (lane == 0) MIXSCALE[t] = am > 0.f ? am * (1.0f / 127.0f) : 1.0f;
    };
    for (int t0 = gw; t0 < S_; t0 += 2 * NGW) {
        const int t1 = t0 + NGW; const bool two = t1 < S_;
        RowIn A, B; load_row(t0, A); load_row(two ? t1 : t0, B);
        finish_row(t0, A); if (two) finish_row(t1, B);
    }
}

__device__ __forceinline__ void ffn_norm_router(unsigned char* ws, LAS unsigned char* lds, int G) {
    CArgs& a = *kargs();
    const int tid = threadIdx.x, wave = __builtin_amdgcn_readfirstlane(tid >> 6), lane = tid & 63, fr = lane & 15, fq = lane >> 4;
    LAS float* XF = (LAS float*)lds;
    LAS float* PL = (LAS float*)lds;
    LAS float* LG = (LAS float*)(lds + 16384);
    LAS int* CNT = (LAS int*)(lds + 16384 + 2048);
    const bf16_t* H = (const bf16_t*)(ws + WS_H); signed char* XQ = (signed char*)(ws + WS_XN); float* TOKSCALE = (float*)(ws + WS_TOKSCALE); const float* WR = a.in[I_W_ROUTER];
    int* TOPE = (int*)(ws + WS_TOPE); float* TOPG = (float*)(ws + WS_TOPG); int* TCNT = (int*)(ws + WS_TCNT);
    for (int tile = blockIdx.x; tile < 1024; tile += G) {
        u32x2 raw[2][8];
#pragma unroll
        for (int rr = 0; rr < 2; ++rr) { const bf16_t* xr = H + ((size_t)tile * 16 + wave * 2 + rr) * DM + 4 * lane;
#pragma unroll
            for (int j = 0; j < 8; ++j) raw[rr][j] = *(const u32x2*)(xr + 256 * j); }
#pragma unroll
        for (int rr = 0; rr < 2; ++rr) { const int row = wave * 2 + rr; const size_t t = (size_t)tile * 16 + row;
            const f32x4* gr = (const f32x4*)a.in[I_NORM_FFN_G] + lane;
            f32x4 v[8]; float s = 0.f;
#pragma unroll
            for (int j = 0; j < 8; ++j) { const u32x2 w = raw[rr][j]; v[j] = (f32x4){bflo(w.x), bfhi(w.x), bflo(w.y), bfhi(w.y)}; s += (v[j].x * v[j].x + v[j].y * v[j].y) + (v[j].z * v[j].z + v[j].w * v[j].w); }
            const float r = rsqrtf(wave_sum(s) * (1.f / 2048.f) + EPS_);
            float am = 0.f;
#pragma unroll
            for (int j = 0; j < 8; ++j) { const f32x4 gg = gr[64 * j]; v[j] = (f32x4){v[j].x * r * gg.x, v[j].y * r * gg.y, v[j].z * r * gg.z, v[j].w * r * gg.w};
                am = fmaxf(fmaxf(am, fmaxf(fabsf(v[j].x), fabsf(v[j].y))), fmaxf(fabsf(v[j].z), fabsf(v[j].w)));
                *(LAS f32x4*)(XF + row * 2052 + 4 * lane + 256 * j) = v[j]; }
#pragma unroll
            for (int o = 1; o < 64; o <<= 1) am = fmaxf(am, __shfl_xor(am, o));
            const float inv = am > 0.f ? 127.0f / am : 0.f;
            unsigned* o4 = (unsigned*)(XQ + t * DM) + lane;
#pragma unroll
            for (int j = 0; j < 8; ++j) { const int q0 = (int)rintf(v[j].x * inv), q1 = (int)rintf(v[j].y * inv), q2 = (int)rintf(v[j].z * inv), q3 = (int)rintf(v[j].w * inv);
                o4[64 * j] = ((unsigned)q0 & 0xffu) | (((unsigned)q1 & 0xffu) << 8) | (((unsigned)q2 & 0xffu) << 16) | (((unsigned)q3 & 0xffu) << 24); }
            if (lane == 0) TOKSCALE[t] = am > 0.f ? am * (1.0f / 127.0f) : 1.0f;
        }
        __syncthreads();
        f32x4 c0 = {0.f, 0.f, 0.f, 0.f}, c1 = {0.f, 0.f, 0.f, 0.f};
#pragma unroll 8
        for (int s = 0; s < 64; ++s) { const int k = 256 * wave + 4 * s + fq;
            const float af = XF[fr * 2052 + k], b0 = WR[(size_t)k * 32 + fr], b1 = WR[(size_t)k * 32 + 16 + fr];
            c0 = __builtin_amdgcn_mfma_f32_16x16x4f32(af, b0, c0, 0, 0, 0); c1 = __builtin_amdgcn_mfma_f32_16x16x4f32(af, b1, c1, 0, 0, 0); }
        __syncthreads();
#pragma unroll
        for (int r = 0; r < 4; ++r) { PL[(wave * 16 + fq * 4 + r) * 32 + fr] = c0[r]; PL[(wave * 16 + fq * 4 + r) * 32 + 16 + fr] = c1[r]; }
        if (tid < 32) CNT[tid] = 0;
        __syncthreads();
        { const int row = tid >> 5, e = tid & 31; float lg = a.in[I_B_ROUTER][e];
#pragma unroll
          for (int w = 0; w < 8; ++w) lg += PL[(w * 16 + row) * 32 + e];
          __syncthreads();
          LG[row * 32 + e] = lg; }
        __syncthreads();
        if (tid < 16) { const int row = tid; const size_t t = (size_t)tile * 16 + row; unsigned mask = 0u; float tv[4]; int te[4];
            for (int k = 0; k < 4; ++k) { float best = -__builtin_inff(); int bi = 0;
                for (int e = 0; e < 32; ++e) { const float x = LG[row * 32 + e]; if (!((mask >> e) & 1u) && x > best) { best = x; bi = e; } }
                mask |= 1u << bi; tv[k] = best; te[k] = bi; }
            float ex[4], sum = 0.f;
            for (int k = 0; k < 4; ++k) { ex[k] = __expf(tv[k] - tv[0]); sum += ex[k]; }
            const float inv = 1.0f / sum;
            for (int k = 0; k < 4; ++k) { TOPE[t * 4 + k] = te[k]; TOPG[t * 4 + k] = ex[k] * inv; __hip_atomic_fetch_add(&CNT[te[k]], 1, __ATOMIC_RELAXED, __HIP_MEMORY_SCOPE_WORKGROUP); }
        }
        __syncthreads();
        if (tid < 32) TCNT[tile * 32 + tid] = CNT[tid];
        __syncthreads();
    }
}

__device__ __forceinline__ void moe_route(unsigned char* ws, LAS unsigned char* lds, int G) {
    const int tid = threadIdx.x, wave = __builtin_amdgcn_readfirstlane(tid >> 6), lane = tid & 63;
    LAS int* TC = (LAS int*)lds;
    LAS int* PS = (LAS int*)(lds + 131072);
    LAS int* PPRE = (LAS int*)(lds + 133120);
    LAS int* TOT = (LAS int*)(lds + 135168);
    LAS int* PADSTART = (LAS int*)(lds + 135296);
    LAS int* SELPOS = (LAS int*)(lds + 135552);
    LAS int* SELTOK = (LAS int*)(lds + 135808);
    const int* TCNT = (const int*)(ws + WS_TCNT); const int* TOPE = (const int*)(ws + WS_TOPE); const float* TOPG = (const float*)(ws + WS_TOPG);
    int* POSOF = (int*)(ws + WS_POSOF); float* ROWGATE = (float*)(ws + WS_ROWGATE); int* TILEEXP = (int*)(ws + WS_TILEEXP); int* NRT = (int*)(ws + WS_NRT);
    int* SRCTOK = (int*)(ws + WS_SRCTOK); const float* TOKSCALE = (const float*)(ws + WS_TOKSCALE); float* ROWSCALE = (float*)(ws + WS_ROWSCALE);
    for (int i = tid; i < 8192; i += NTHREADS) *(LAS u32x4*)(TC + 4 * i) = *(const u32x4*)(TCNT + 4 * i);
    __syncthreads();
    { const int e = tid & 31, part = tid >> 5; int run = 0;
      for (int i = 0; i < 64; ++i) { const int idx = (part * 64 + i) * 32 + e; const int v = TC[idx]; TC[idx] = run; run += v; }
      PS[part * 32 + e] = run; }
    __syncthreads();
    if (tid < 32) { int run = 0; for (int p = 0; p < 16; ++p) { PPRE[p * 32 + tid] = run; run += PS[p * 32 + tid]; } TOT[tid] = run; }
    __syncthreads();
    if (tid == 0) { int run = 0;
        for (int e = 0; e < 32; ++e) { PADSTART[e] = run; const int pad = (TOT[e] + 255) & ~255;
            if (blockIdx.x == 0) for (int rt = run >> 8; rt < (run + pad) >> 8; ++rt) TILEEXP[rt] = e;
            run += pad; }
        PADSTART[32] = run; if (blockIdx.x == 0) NRT[0] = run >> 8; }
    __syncthreads();
    if (blockIdx.x == 0) for (int e = 0; e < 32; ++e) for (int p = PADSTART[e] + TOT[e] + tid; p < PADSTART[e + 1]; p += NTHREADS) SRCTOK[p] = 0;
    const int slot = wave & 3, half = wave >> 2;
    for (int it = 0; half == 0; ++it) {
        const int tile = blockIdx.x + (4 * it + slot) * G; if (tile >= 1024) break;
        const int m = lane, row = m >> 2, k = m & 3; const size_t t = (size_t)tile * 16 + row;
        const int e = TOPE[t * 4 + k]; const float g = TOPG[t * 4 + k]; int rank = 0;
        for (int mm = 0; mm < 64; ++mm) { const int em = __shfl(e, mm); rank += (mm < m && em == e) ? 1 : 0; }
        const int pos = PADSTART[e] + PPRE[(tile >> 6) * 32 + e] + TC[tile * 32 + e] + rank;
        if (half == 0) { ROWGATE[pos] = g; ROWSCALE[pos] = TOKSCALE[t]; POSOF[t * 4 + k] = pos; SRCTOK[pos] = (int)t; }
    }
}

__device__ __forceinline__ void final_combine(unsigned char* ws, int G) {
    CArgs& a = *kargs(); const int wave = wave_id(), lane = lane_id();
    const int gw = blockIdx.x * NWAVES + wave, NGW = G * NWAVES;
    const bf16_t* H = (const bf16_t*)(ws + WS_H); const unsigned char* YB = (const unsigned char*)(ws + WS_YB); const int* POSOF = (const int*)(ws + WS_POSOF);
    f32x4 gg[8];
#pragma unroll
    for (int j = 0; j < 8; ++j) gg[j] = ((const f32x4*)a.in[I_NORM_FINAL_G] + lane)[64 * j];
    for (int t0 = gw; t0 < S_; t0 += 2 * NGW) {
        const int t1 = t0 + NGW; const bool two = t1 < S_; const int tb = two ? t1 : t0;
        int pa[4], pb[4];
#pragma unroll
        for (int k = 0; k < 4; ++k) { pa[k] = POSOF[(size_t)t0 * 4 + k]; pb[k] = POSOF[(size_t)tb * 4 + k]; }
        f32x4 va[8], vb[8];
        { const bf16_t* xa = H + (size_t)t0 * DM + 4 * lane; const bf16_t* xb = H + (size_t)tb * DM + 4 * lane;
#pragma unroll
          for (int j = 0; j < 8; ++j) { va[j] = ld_bf16x4(xa + 256 * j); vb[j] = ld_bf16x4(xb + 256 * j); } }
        unsigned ya[4][8], yb[4][8];
#pragma unroll
        for (int k = 0; k < 4; ++k) { const unsigned* ra = (const unsigned*)(YB + (size_t)pa[k] * DM) + lane; const unsigned* rb = (const unsigned*)(YB + (size_t)pb[k] * DM) + lane;
#pragma unroll
            for (int j = 0; j < 8; ++j) { ya[k][j] = ra[64 * j]; yb[k][j] = rb[64 * j]; } }
#define FC_FINISH(V, Y, T) do {                                                                                                                         \
        _Pragma("unroll") for (int k = 0; k < 4; ++k) _Pragma("unroll") for (int j = 0; j < 8; ++j) { const unsigned y = Y[k][j];                        \
            const auto lo = __builtin_amdgcn_cvt_pk_f32_fp8(y, false), hi = __builtin_amdgcn_cvt_pk_f32_fp8(y, true);                                    \
            V[j].x += lo[0] * (1.0f / YB_SCALE); V[j].y += lo[1] * (1.0f / YB_SCALE); V[j].z += hi[0] * (1.0f / YB_SCALE); V[j].w += hi[1] * (1.0f / YB_SCALE); } \
        float s = 0.f;                                                                                                                                   \
        _Pragma("unroll") for (int j = 0; j < 8; ++j) s += (V[j].x * V[j].x + V[j].y * V[j].y) + (V[j].z * V[j].z + V[j].w * V[j].w);                   \
        const float r = rsqrtf(wave_sum(s) * (1.f / 2048.f) + EPS_);                                                                                    \
        f32x4* o = (f32x4*)(a.out + (size_t)(T) * DM) + lane;                                                                                           \
        _Pragma("unroll") for (int j = 0; j < 8; ++j) o[64 * j] = (f32x4){V[j].x * r * gg[j].x, V[j].y * r * gg[j].y, V[j].z * r * gg[j].z, V[j].w * r * gg[j].w}; } while (0)
        FC_FINISH(va, ya, t0);
        if (two) FC_FINISH(vb, yb, t1);
#undef FC_FINISH
    }
}

__global__ void __launch_bounds__(NTHREADS, 2) fwd_kernel(Args args) {
    extern __shared__ __attribute__((aligned(16))) unsigned char lds_raw[];
    LAS unsigned char* lds = (LAS unsigned char*)lds_raw;
    volatile LAS unsigned* MISC = (volatile LAS unsigned*)(lds + MISC_OFF);
    const int tid = threadIdx.x;
    const int G = gridDim.x, c = blockIdx.x;
    CArgs* ka = kargs();
    unsigned char* ws = ka->ws;
    unsigned* ctl = (unsigned*)(ws + WS_CTL);
    for (int u = tid; u < 64; u += NTHREADS) MISC[u] = 0u;
    __syncthreads();
    const int lo = ka->ph_lo, hi = ka->ph_hi;
    const bool multi = (hi - lo) > 1;
    XcdBarrier bar; bar.bar = ctl + CW_BAR; bar.x = 0; bar.st = nullptr;
    if (multi) bar = xcd_barrier_post(ctl + CW_BAR, MISC + 8);
#define IN(k) (lo <= (k) && (k) < hi)
#define SEAM(k) do { if (IN(k) && IN((k) + 1)) xcd_barrier(bar); } while (0)

    if (IN(0)) { p0_prologue(ws, lds, G); }
    SEAM(0);
    if (IN(1)) {
        pg8::Gemm g{DM / 2, DM / 2, DM / 2}; pg8::DenseOrder O; O.init(ws + WS_XN, ws + WS_WIN, S_, NIN, DM / 2, DM / 2, G, c);
        EpiInProjI8 E{EpiInProj{(bf16_t*)(ws + WS_Q), (bf16_t*)(ws + WS_XR), ctl + CW_VMAX}, (const float*)(ws + WS_INSCALE), (const float*)(ws + WS_SBIN)};
        pg8::gemm_phase<EpiInProjI8, pg8::DenseOrder, true, true>(lds, g, O, E);
    }
    SEAM(1);
    if (IN(2)) { rg_local(ws, lds, c, G); __syncthreads(); convert_v_fp8(ws, lds, G); }
    SEAM(2);
    if (IN(3)) {
        carry_scan(ws, lds, G);
        if (c < 16) {
            pg8::Gemm g{DM, DM, DM}; SmallOrder O{(const char*)(ws + WS_MEMN), (const char*)(ws + WS_WCKV), c};
            EpiSmall E{(bf16_t*)(ws + WS_KM), (bf16_t*)(ws + WS_VT)};
            pg8::gemm_phase<EpiSmall, SmallOrder, true>(lds, g, O, E); }
        attn_phase(ws, (char*)lds_raw, MISC, G);
    }
    SEAM(3);
    if (IN(4)) { post_mix(ws, G); }
    SEAM(4);
    if (IN(5)) {
        pg8::Gemm g{DM / 2, DM / 2, DM / 2}; pg8::DenseOrder O; O.init(ws + WS_MIX, ws + WS_WOUT, S_, DM, DM / 2, DM / 2, G, c);
        EpiResNormI8 E{EpiResNormF32{kargs()->in[I_X], (bf16_t*)(ws + WS_H), (unsigned char*)(ws + WS_XN), (float*)(ws + WS_SSQ)}, (const float*)(ws + WS_MIXSCALE), (const float*)(ws + WS_SBOUT)};
        pg8::gemm_phase<EpiResNormI8, pg8::DenseOrder, true, true>(lds, g, O, E);
    }
    SEAM(5);
    if (IN(7)) {
        pg8::Gemm g{DM / 2, DM / 2, DM / 2}; pg8::DenseOrder O; O.init(ws + WS_XN, ws + WS_WCQ, S_, DM, DM / 2, DM / 2, G, c);
        LAS float* RL = (LAS float*)(lds + 131072);
        { const float* SSQ = (const float*)(ws + WS_SSQ);
          for (int it = tid; it < 8 * 256; it += NTHREADS) { const int ui = it >> 8, row = it & 255; pg8::Unit u;
              if (O.next(ui, u)) { const f32x4* p = (const f32x4*)(SSQ + (size_t)(u.pm * 256 + row) * 32); f32x4 a4 = p[0];
#pragma unroll
                  for (int j = 1; j < 8; ++j) a4 += p[j];
                  RL[it] = rsqrtf(((a4[0] + a4[1]) + (a4[2] + a4[3])) * (1.f / 2048.f) + EPS_); } }
          __syncthreads(); }
        EpiBf16RowScale E{(bf16_t*)(ws + WS_QC), DM, RL, (const float*)(ws + WS_SBCQ)};
        pg8::gemm_phase<EpiBf16RowScale, pg8::DenseOrder, true, false, true>(lds, g, O, E);
    }
    SEAM(7);
    if (IN(8)) {
        pg8::Gemm g{512, DM, DM}; HeadOrderS O{(const char*)(ws + WS_QC), (const char*)(ws + WS_KM), G, c};
        EpiScore E{(bf16_t*)(ws + WS_PC), (float*)(ws + WS_LPART)};
        pg8::gemm_phase<EpiScore, HeadOrderS, true>(lds, g, O, E);
    }
    if (G != 256) SEAM(8);
    if (IN(9)) {
        pg8::Gemm g{256, 1024, 256}; HeadOrderO O{(const char*)(ws + WS_PC), (const char*)(ws + WS_VT), G, c};
        EpiCrossO E{(unsigned char*)(ws + WS_OC), (const float*)(ws + WS_LPART)};
        pg8::gemm_phase<EpiCrossO, HeadOrderO, true>(lds, g, O, E);
    }
    SEAM(9);
    if (IN(10)) {
        pg8::Gemm g{DM / 2, DM / 2, DM / 2}; pg8::DenseOrder O; O.init(ws + WS_OC, ws + WS_WCO, S_, DM, DM / 2, DM / 2, G, c);
        EpiResF32 E{(const bf16_t*)(ws + WS_H), (bf16_t*)(ws + WS_H), (const float*)(ws + WS_SBCO), 1.0f / 16.0f};
        pg8::gemm_phase<EpiResF32, pg8::DenseOrder, true, false, true>(lds, g, O, E);
    }
    SEAM(10);
    if (IN(11)) { ffn_norm_router(ws, lds, G); }
    SEAM(11);
    if (IN(12)) { moe_route(ws, lds, G); }
    SEAM(12);
    if (IN(13)) {
        pg8::Gemm g{DM / 2, DM / 2, DM / 2}; GroupOrderG O{(const char*)(ws + WS_XN), (const char*)(ws + WS_WGU), (const int*)(ws + WS_TILEEXP), (const int*)(ws + WS_SRCTOK), (size_t)4096 * 2048, (size_t)256 * 2048, *(const int*)(ws + WS_NRT), 16, G, c};
        EpiGateUpI8 E{(signed char*)(ws + WS_ACT), kargs()->in[I_B_GU], (const float*)(ws + WS_ROWSCALE), (const float*)(ws + WS_SBGU)};
        pg8::gemm_phase<EpiGateUpI8, GroupOrderG, true, true>(lds, g, O, E);
    }
    SEAM(13);
    if (IN(14)) {
        pg8::Gemm g{DM / 2, DM / 2, DM / 2}; GroupOrder O{(const char*)(ws + WS_ACT), (const char*)(ws + WS_WDN), (const int*)(ws + WS_TILEEXP), (size_t)2048 * 2048, (size_t)256 * 2048, *(const int*)(ws + WS_NRT), 8, G, c};
        EpiDown E{(unsigned char*)(ws + WS_YB), kargs()->in[I_B_DN], (const float*)(ws + WS_ROWGATE), (const float*)(ws + WS_SBDN)};
        pg8::gemm_phase<EpiDown, GroupOrder, true, true>(lds, g, O, E);
    }
    SEAM(14);
    if (IN(15)) { final_combine(ws, G); }
#undef IN
#undef SEAM
}

extern "C" void kernel_launch(void* const* d_in, const int* in_sizes, int n_in, void* d_out, int out_size, void* d_ws, size_t ws_size, hipStream_t stream) {
    static int grid = 0;
    if (grid == 0) {
        if (n_in != 31 || out_size != S_ * DM || ws_size < WS_END) { fprintf(stderr, "kernel_launch: unexpected shapes (n_in %d, out %d, ws %zu); nothing launched\n", n_in, out_size, ws_size); grid = -1; return; }
        int dev = 0, cus = 0, per_cu = 0;
        if (hipGetDevice(&dev) != hipSuccess || hipDeviceGetAttribute(&cus, hipDeviceAttributeMultiprocessorCount, dev) != hipSuccess) { grid = -1; return; }
        if (hipFuncSetAttribute((const void*)fwd_kernel, hipFuncAttributeMaxDynamicSharedMemorySize, LDS_BYTES) != hipSuccess) { fprintf(stderr, "kernel_launch: hipFuncSetAttribute failed\n"); grid = -1; return; }
        if (hipOccupancyMaxActiveBlocksPerMultiprocessor(&per_cu, (const void*)fwd_kernel, NTHREADS, LDS_BYTES) != hipSuccess || per_cu < 1)
            fprintf(stderr, "kernel_launch: occupancy query reports %d workgroups per CU\n", per_cu);
        (void)hipGetLastError();
        grid = cus;
    }
    if (grid < 0) return;
    if (hipMemsetAsync((char*)d_ws + WS_CTL, 0, CTL_ZERO_BYTES, stream) != hipSuccess) return;
    Args a{};
    for (int i = 0; i < 31; ++i) a.in[i] = (const float*)d_in[i];
    a.out = (float*)d_out; a.ws = (unsigned char*)d_ws;
#if MK_N_LAUNCHES == 1
    a.ph_lo = 0; a.ph_hi = N_PHASES;
    hipLaunchKernelGGL(fwd_kernel, dim3(grid), dim3(NTHREADS), LDS_BYTES, stream, a);
#else
    for (int p = 0; p < N_PHASES; ++p) { a.ph_lo = p; a.ph_hi = p + 1; hipLaunchKernelGGL(fwd_kernel, dim3(grid), dim3(NTHREADS), LDS_BYTES, stream, a);
#ifdef PROBE_DUP_MASK
        if ((PROBE_DUP_MASK >> p) & 1) hipLaunchKernelGGL(fwd_kernel, dim3(grid), dim3(NTHREADS), LDS_BYTES, stream, a);
#endif
    }
#endif
}
```

```cpp
#include <hip/hip_runtime.h>
#include <hip/hip_bf16.h>
#include <cstdio>
#include <cstdint>

namespace pg8 {
#define PG8_LAS __attribute__((address_space(3)))
typedef unsigned short bf16_t;
typedef short bf16x8 __attribute__((ext_vector_type(8)));
typedef float f32x4 __attribute__((ext_vector_type(4)));
typedef unsigned u32x4 __attribute__((ext_vector_type(4)));
constexpr int BM = 256, BK = 64, HALF = 128, HTB = HALF * BK * 2  , STAGE_BYTES = 8 * HTB, NXCD = 8, WGM = 8;

__host__ __device__ __forceinline__ int lds_byte(int r, int c) { const int st = (r >> 4) * 2 + (c >> 5), rr = r & 15, cc = c & 31, ob = rr * 64 + cc * 2; return st * 1024 + (ob ^ (((ob >> 9) & 1) << 5)); }
__host__ __device__ __forceinline__ void stage_rc(int b, int& R, int& C) { const int st = b / 1024, sb = b % 1024, swz = sb ^ (((sb >> 9) & 1) << 5); R = (st >> 1) * 16 + swz / 64; C = (st & 1) * 32 + (swz % 64) / 2; }
__host__ __device__ __forceinline__ int perm32(int rho) { const int n = rho >> 4, i = rho & 15; return 8 * (i >> 2) + 4 * n + (i & 3); }

struct Unit { int pm, pn, e; const char* A; const char* B; };
struct Gemm { int K, lda, ldb; };

__device__ __forceinline__ unsigned cvt_pk_bf16(float lo, float hi) { unsigned r; asm volatile("v_cvt_pk_bf16_f32 %0, %1, %2" : "=v"(r) : "v"(lo), "v"(hi)); return r; }

struct DenseOrder {
    const char* A; const char* B; size_t tsA, tsB; int nM, nN, nwg, G, c;
    __device__ void init(const void* A_, const void* B_, int M, int N, int lda, int ldb, int G_, int c_) { A = (const char*)A_; B = (const char*)B_; tsA = (size_t)BM * lda * 2; tsB = (size_t)BM * ldb * 2; nM = M / BM; nN = N / BM; nwg = nM * nN; G = G_; c = c_; }
    __device__ __forceinline__ bool next(int i, Unit& u) const {
        const long L = (long)i * G + c; if (L >= nwg) return false;
        int wgid = (int)L; { const int q = nwg / NXCD, r = nwg % NXCD, xcd = wgid % NXCD, off = wgid / NXCD; wgid = (xcd < r ? xcd * (q + 1) : r * (q + 1) + (xcd - r) * q) + off; }
        const int nig = WGM * nN, gid = wgid / nig, fm = gid * WGM, gsz = (nM - fm) < WGM ? (nM - fm) : WGM;
        u.pm = fm + ((wgid % nig) % gsz); u.pn = (wgid % nig) / gsz; u.e = i; u.A = A + (size_t)u.pm * tsA; u.B = B + (size_t)u.pn * tsB; return true;
    }
};

typedef int i32x4 __attribute__((ext_vector_type(4)));
template <bool I8> struct AccSel { typedef f32x4 type; };
template <> struct AccSel<true> { typedef i32x4 type; };
__device__ __forceinline__ f32x4 mma16(bf16x8 a, bf16x8 b, f32x4 c) { return __builtin_amdgcn_mfma_f32_16x16x32_bf16(a, b, c, 0, 0, 0); }
__device__ __forceinline__ i32x4 mma16(bf16x8 a, bf16x8 b, i32x4 c) { return __builtin_amdgcn_mfma_i32_16x16x64_i8(__builtin_bit_cast(i32x4, a), __builtin_bit_cast(i32x4, b), c, 0, 0, 0); }
typedef int i32x8 __attribute__((ext_vector_type(8)));
__device__ __forceinline__ f32x4 mma16f8(bf16x8 b0, bf16x8 b1, bf16x8 a0, bf16x8 a1, f32x4 c) {
    const i32x4 B0 = __builtin_bit_cast(i32x4, b0), B1 = __builtin_bit_cast(i32x4, b1), A0 = __builtin_bit_cast(i32x4, a0), A1 = __builtin_bit_cast(i32x4, a1);
    const i32x8 B8 = {B0[0], B0[1], B0[2], B0[3], B1[0], B1[1], B1[2], B1[3]}, A8 = {A0[0], A0[1], A0[2], A0[3], A1[0], A1[1], A1[2], A1[3]};
    asm volatile("v_mfma_f32_16x16x128_f8f6f4 %0, %1, %2, %0" : "+v"(c) : "v"(B8), "v"(A8));
    return c;
}
template <class S_> struct IsGather { template <class T> static char f(decltype(&T::rows)); template <class T> static int f(...); static constexpr bool v = sizeof(f<S_>(nullptr)) == 1; };
template <class Epi, class Sched, bool ALIGN_EPI, bool I8 = false, bool F8 = false>
__device__ __forceinline__ void gemm_phase(PG8_LAS unsigned char* lds, const Gemm g, const Sched& S, const Epi& E) {
    const int tid = threadIdx.x, wid = __builtin_amdgcn_readfirstlane(tid >> 6), lane = tid & 63, wr = wid >> 2, wc = wid & 3, fr = lane & 15, fq = lane >> 4;
    const int K = g.K, nt = K / BK;
    unsigned voffA[2], voffB[2];
#pragma unroll
    for (int i = 0; i < 2; ++i) { int R, C; stage_rc(tid * 16 + i * 8192, R, C); const int Rb = Epi::PERM ? ((R & ~31) + perm32(R & 31)) : R;
        voffA[i] = (unsigned)(R * g.lda + C) * 2u; voffB[i] = (unsigned)(Rb * g.ldb + C) * 2u; }
    const size_t kstep = (size_t)(BK * 2);
    const size_t hstepA = (size_t)HALF * g.lda * 2, hstepB = (size_t)HALF * g.ldb * 2;
    const unsigned ldsw = (unsigned)wid * 1024u;
    const int aoff = lds_byte(wr * 64 + fr, fq * 8), boff = lds_byte(wc * 32 + fr, fq * 8);
#define PG8_SA(b, h) (((b) * 2 + (h)) * HTB)
#define PG8_SB(b, h) ((4 + (b) * 2 + (h)) * HTB)
#define PG8_STAGE(bufoff, gbase, voff) do { _Pragma("unroll") for (int _i = 0; _i < 2; ++_i) \
        __builtin_amdgcn_global_load_lds((const unsigned*)((const char*)(gbase) + (voff)[_i]), (PG8_LAS unsigned*)(lds + (bufoff) + ldsw + _i * 8192), 16, 0, 0); } while (0)
#define PG8_STAGE_A(b, h, base, v0, v1) do { if constexpr (GA) { if ((h) == 0) PG8_STAGE(PG8_SA(b, h), base, v0); else PG8_STAGE(PG8_SA(b, h), base, v1); } \
        else PG8_STAGE(PG8_SA(b, h), (h) ? (base) + hstepA : (base), voffA); } while (0)
#define PG8_LDA(dst, b, h) do { _Pragma("unroll") for (int m = 0; m < 4; ++m) _Pragma("unroll") for (int k = 0; k < 2; ++k) dst[m][k] = *(const PG8_LAS bf16x8*)(lds + PG8_SA(b, h) + aoff + m * 2048 + k * 1024); } while (0)
#define PG8_LDB(dst, b, h) do { _Pragma("unroll") for (int n = 0; n < 2; ++n) _Pragma("unroll") for (int k = 0; k < 2; ++k) dst[n][k] = *(const PG8_LAS bf16x8*)(lds + PG8_SB(b, h) + boff + n * 2048 + k * 1024); } while (0)
#define PG8_MMA(ai, bj, At, Bt) do { __builtin_amdgcn_s_setprio(1); _Pragma("unroll") for (int m = 0; m < 4; ++m) _Pragma("unroll") for (int n = 0; n < 2; ++n) { \
        if constexpr (F8) acc[ai][bj][m][n] = mma16f8(Bt[n][0], Bt[n][1], At[m][0], At[m][1], acc[ai][bj][m][n]); \
        else { _Pragma("unroll") for (int k = 0; k < 2; ++k) acc[ai][bj][m][n] = mma16(Bt[n][k], At[m][k], acc[ai][bj][m][n]); } } __builtin_amdgcn_s_setprio(0); } while (0)
#define PG8_WAIT_V(n) asm volatile("s_waitcnt vmcnt(" #n ")" ::: "memory")
#define PG8_WAIT_L(n) asm volatile("s_waitcnt lgkmcnt(" #n ")" ::: "memory")
#define PG8_BAR __builtin_amdgcn_s_barrier()
#define PG8_SCHED __builtin_amdgcn_sched_barrier(0)
    Unit cur, nxt; int ui = 0;
    if (!S.next(0, cur)) return;
    constexpr bool GA = IsGather<Sched>::v;
    unsigned voffA1[2], nvA0[2], nvA1[2];
    int gR[2], gC[2];
    if constexpr (GA) {
#pragma unroll
        for (int i = 0; i < 2; ++i) { stage_rc(tid * 16 + i * 8192, gR[i], gC[i]);
            const int* rw = S.rows + (size_t)cur.pm * 256; voffA[i] = (unsigned)(rw[gR[i]] * g.lda + gC[i]) * 2u; voffA1[i] = (unsigned)(rw[128 + gR[i]] * g.lda + gC[i]) * 2u; nvA0[i] = voffA[i]; nvA1[i] = voffA1[i]; }
    }
    typedef typename AccSel<I8>::type acc_t;
    acc_t acc[2][2][4][2];
#pragma unroll
    for (int a = 0; a < 2; ++a)
#pragma unroll
        for (int b = 0; b < 2; ++b)
#pragma unroll
            for (int m = 0; m < 4; ++m)
#pragma unroll
                for (int n = 0; n < 2; ++n) acc[a][b][m][n] = (acc_t){0, 0, 0, 0};
    bf16x8 At[4][2], B0[2][2], B1[2][2];
    const char* cA = cur.A; const char* cB = cur.B;
    PG8_STAGE(PG8_SB(0, 0), cB, voffB); PG8_STAGE(PG8_SB(0, 1), cB + hstepB, voffB); PG8_STAGE_A(0, 0, cA, voffA, voffA1); PG8_STAGE_A(0, 1, cA, voffA, voffA1);
    if (wr == 1) PG8_BAR;
    PG8_WAIT_V(2); PG8_BAR;
    PG8_STAGE(PG8_SB(1, 0), cB + kstep, voffB); PG8_STAGE_A(1, 0, cA + kstep, voffA, voffA1); PG8_STAGE(PG8_SB(1, 1), cB + hstepB + kstep, voffB);
    PG8_WAIT_V(6); PG8_BAR;
    for (;;) {
        const bool has_next = S.next(ui + 1, nxt);
        const char* nA = has_next ? nxt.A : cA; const char* nB = has_next ? nxt.B : cB;
        if constexpr (GA) { if (has_next) { const int* rw = S.rows + (size_t)nxt.pm * 256;
#pragma unroll
            for (int i = 0; i < 2; ++i) { nvA0[i] = (unsigned)(rw[gR[i]] * g.lda + gC[i]) * 2u; nvA1[i] = (unsigned)(rw[128 + gR[i]] * g.lda + gC[i]) * 2u; } } }
        for (int t = 0; t < nt; t += 2) {
            const bool last = (t == nt - 2);
            const char* a1 = cA + (size_t)(t + 1) * kstep;
            const char* a2 = last ? nA : cA + (size_t)(t + 2) * kstep; const char* b2 = last ? nB : cB + (size_t)(t + 2) * kstep;
            const char* a3 = a2 + kstep; const char* b3 = b2 + kstep;
            unsigned w0[2], w1[2];
#pragma unroll
            for (int i = 0; i < 2; ++i) { w0[i] = (GA && last) ? nvA0[i] : voffA[i]; w1[i] = (GA && last) ? nvA1[i] : voffA1[i]; }
            PG8_LDB(B0, 0, 0); PG8_LDB(B1, 0, 1); PG8_SCHED; PG8_LDA(At, 0, 0); PG8_STAGE_A(1, 1, a1, voffA, voffA1);
            PG8_WAIT_V(8); PG8_WAIT_L(0); PG8_BAR; PG8_MMA(0, 0, At, B0); PG8_MMA(0, 1, At, B1); PG8_BAR; PG8_SCHED;
            PG8_LDA(At, 0, 1); PG8_STAGE(PG8_SB(0, 0), b2, voffB); PG8_STAGE(PG8_SB(0, 1), b2 + hstepB, voffB); PG8_STAGE_A(0, 0, a2, w0, w1);
            PG8_WAIT_V(8); PG8_WAIT_L(0); PG8_BAR; PG8_MMA(1, 0, At, B0); PG8_MMA(1, 1, At, B1); PG8_BAR; PG8_SCHED;
            PG8_LDB(B0, 1, 0); PG8_LDB(B1, 1, 1); PG8_SCHED; PG8_LDA(At, 1, 0); PG8_STAGE_A(0, 1, a2, w0, w1);
            PG8_WAIT_V(8); PG8_WAIT_L(0); PG8_BAR; PG8_MMA(0, 0, At, B0); PG8_MMA(0, 1, At, B1); PG8_BAR; PG8_SCHED;
            PG8_LDA(At, 1, 1); PG8_STAGE(PG8_SB(1, 0), b3, voffB); PG8_STAGE(PG8_SB(1, 1), b3 + hstepB, voffB); PG8_STAGE_A(1, 0, a3, w0, w1);
            PG8_WAIT_V(8); PG8_WAIT_L(0); PG8_BAR; PG8_MMA(1, 0, At, B0); PG8_MMA(1, 1, At, B1); PG8_BAR; PG8_SCHED;
        }
        if constexpr (ALIGN_EPI) { if (wr == 0) PG8_BAR; }
        if constexpr (F8) {
            asm volatile("s_nop 15\n\ts_nop 15" ::: "memory");
#pragma unroll
            for (int a = 0; a < 2; ++a)
#pragma unroll
                for (int b = 0; b < 2; ++b)
#pragma unroll
                    for (int m = 0; m < 4; ++m)
#pragma unroll
                        for (int n = 0; n < 2; ++n) asm volatile("" : "+v"(acc[a][b][m][n]));
        }
        E(acc, cur, wr, wc, fr, fq);
        if (!has_next) break;
#pragma unroll
        for (int a = 0; a < 2; ++a)
#pragma unroll
            for (int b = 0; b < 2; ++b)
#pragma unroll
                for (int m = 0; m < 4; ++m)
#pragma unroll
                    for (int n = 0; n < 2; ++n) acc[a][b][m][n] = (acc_t){0, 0, 0, 0};
        cur = nxt; cA = nA; cB = nB; ++ui;
        if constexpr (GA) {
#pragma unroll
            for (int i = 0; i < 2; ++i) { voffA[i] = nvA0[i]; voffA1[i] = nvA1[i]; } }
        if constexpr (ALIGN_EPI) { if (wr == 1) PG8_BAR; }
    }
    PG8_WAIT_V(0);
    if constexpr (!ALIGN_EPI) { if (wr == 0) PG8_BAR; }
    PG8_BAR;
#undef PG8_SA
#undef PG8_SB
#undef PG8_STAGE
#undef PG8_STAGE_A
#undef PG8_LDA
#undef PG8_LDB
#undef PG8_MMA
#undef PG8_WAIT_V
#undef PG8_WAIT_L
#undef PG8_BAR
#undef PG8_SCHED
}
}

namespace att {
constexpr int D = 128;
constexpr float THR = 8.f;
constexpr bool WSKIP = false;
constexpr float SCALE = 0.08838834764831845f;
constexpr int NW = 8, QBLK = 32, KVBLK = 64, QB = NW * QBLK;
constexpr int SHM_V = KVBLK * D * 2, SHM_K = KVBLK * D * 2;
constexpr int LDS_BYTES = 2 * SHM_V + 2 * SHM_K + NW * 64 * 4;
static_assert(D == 128, "geometry");

using bf16 = __hip_bfloat16;
typedef short bf16x8 __attribute__((ext_vector_type(8)));
typedef short s16x4 __attribute__((ext_vector_type(4)));
typedef float f32x16 __attribute__((ext_vector_type(16)));
typedef float f32x4 __attribute__((ext_vector_type(4)));
typedef unsigned u32x4 __attribute__((ext_vector_type(4)));
template <class A, class Bt> struct same_t { static constexpr bool v = false; };
template <class A> struct same_t<A, A> { static constexpr bool v = true; };

#define KSWZ(row, colB) ((row) * 256 + ((colB) ^ (((row) & 7) << 4)))
#define SBAR() __builtin_amdgcn_sched_barrier(0)
__device__ __forceinline__ int v_st(int k, int c) { const int kk = (k & ~0xC) | ((k & 4) << 1) | ((k & 8) >> 1); return ((kk >> 3) * 4 + (c >> 5)) * 512 + ((kk & 7) * 32 + (c & 31)) * 2; }
__device__ __forceinline__ int v_rd_base(int lane) { return ((lane & 3) << 3) | (((lane >> 2) & 3) << 6) | (((lane >> 4) & 1) << 5) | (((lane >> 5) & 1) << 8); }
constexpr int v_rd_off(int d0, int ks, int half) { return d0 * 512 + ks * 4096 + half * 2048; }
__device__ __forceinline__ int crow(int r, int hi) { return (r & 3) + 8 * (r >> 2) + 4 * hi; }
__device__ __forceinline__ unsigned cvtpk(float lo, float hi) {
    unsigned r; asm volatile("v_cvt_pk_bf16_f32 %0, %1, %2" : "=v"(r) : "v"(lo), "v"(hi)); return r;
}
__device__ __forceinline__ bf16x8 pack8(f32x4 a, f32x4 b) {
    u32x4 w = {cvtpk(a[0], a[1]), cvtpk(a[2], a[3]), cvtpk(b[0], b[1]), cvtpk(b[2], b[3])};
    return *reinterpret_cast<bf16x8*>(&w);
}
template <class T> __device__ __forceinline__ bf16x8 load8(const T* p) {
    if constexpr (same_t<T, float>::v) { return pack8(*(const f32x4*)p, *(const f32x4*)(p + 4)); }
    else { return *reinterpret_cast<const bf16x8*>(p); }
}
__device__ __forceinline__ void mask_tile(f32x16& p0, f32x16& p1, int dq, unsigned W) {
    const float NEG = -__builtin_inff();
#pragma unroll
    for (int r = 0; r < 16; ++r) {
        const int c = (r & 3) + 8 * (r >> 2);
        if ((unsigned)(dq - c) >= W) p0[r] = NEG;
        if ((unsigned)(dq - c - 32) >= W) p1[r] = NEG;
    }
}
__device__ __forceinline__ void partialSM(f32x16& p0, f32x16& p1, float& m_reg, float& mn, float& alpha) {
    float pmax = p0[0]; for (int r = 1; r < 16; ++r) pmax = fmaxf(pmax, p0[r]); for (int r = 0; r < 16; ++r) pmax = fmaxf(pmax, p1[r]);
    { auto rr = __builtin_amdgcn_permlane32_swap(__float_as_uint(pmax), __float_as_uint(pmax), false, false);
      pmax = fmaxf(__uint_as_float(rr[0]), __uint_as_float(rr[1])); }
    constexpr float C2 = 1.4426950408889634f * SCALE;
    if (__builtin_expect(__all((pmax - m_reg) * SCALE <= THR), 1)) { mn = m_reg; alpha = 1.f; }
    else { mn = fmaxf(m_reg, pmax); alpha = __builtin_amdgcn_exp2f((m_reg - mn) * C2); m_reg = mn; }
    const float mnL = -mn * C2;
    for (int r = 0; r < 16; ++r) p0[r] = fmaf(p0[r], C2, mnL); for (int r = 0; r < 16; ++r) p1[r] = fmaf(p1[r], C2, mnL);
    for (int r = 0; r < 16; ++r) p0[r] = __builtin_amdgcn_exp2f(p0[r]);
}
__device__ __forceinline__ void finishSM(f32x16& p0, f32x16& p1, float alpha, float& l_reg, bf16x8& pa0, bf16x8& pa1, bf16x8& pa2, bf16x8& pa3) {
    for (int r = 0; r < 16; ++r) p1[r] = __builtin_amdgcn_exp2f(p1[r]);
    float ps = 0; for (int r = 0; r < 16; ++r) ps += p0[r]; for (int r = 0; r < 16; ++r) ps += p1[r];
    { auto rr = __builtin_amdgcn_permlane32_swap(__float_as_uint(ps), __float_as_uint(ps), false, false);
      ps = __uint_as_float(rr[0]) + __uint_as_float(rr[1]); }
    l_reg = l_reg * alpha + ps;
#define PK4(P, B_, OUT) do { unsigned a0 = cvtpk(P[B_+0], P[B_+1]), a1 = cvtpk(P[B_+2], P[B_+3]);                          \
        unsigned b0 = cvtpk(P[B_+4], P[B_+5]), b1 = cvtpk(P[B_+6], P[B_+7]);                                             \
        auto r0 = __builtin_amdgcn_permlane32_swap(a0, b0, false, false); auto r1 = __builtin_amdgcn_permlane32_swap(a1, b1, false, false); \
        u32x4 w = {r0[0], r1[0], r0[1], r1[1]}; OUT = *reinterpret_cast<bf16x8*>(&w); } while (0)
    PK4(p0, 0, pa0); PK4(p0, 8, pa1); PK4(p1, 0, pa2); PK4(p1, 8, pa3);
#undef PK4
}
template <int KB, bool SK>
__device__ __forceinline__ void qkt(f32x16& p0, f32x16& p1, const char* K_lds, int r32, int hi, const bf16x8* qr, bool act) {
    if (SK && !act) { const float NEG = -__builtin_inff();
#pragma unroll
        for (int r = 0; r < 16; ++r) { p0[r] = NEG; p1[r] = NEG; } return; }
    p0 = f32x16{}; p1 = f32x16{};
    const char* kb[4];
#pragma unroll
    for (int dd = 0; dd < 4; ++dd) kb[dd] = K_lds + KB * SHM_K + KSWZ(r32, (dd * 16 + hi * 8) * 2);
#pragma unroll
    for (int d0 = 0; d0 < 8; ++d0) { const char* a = kb[d0 & 3] + (d0 >> 2) * 128;
        bf16x8 b0 = *reinterpret_cast<const bf16x8*>(a);
        bf16x8 b1 = *reinterpret_cast<const bf16x8*>(a + 32 * 256);
        p0 = __builtin_amdgcn_mfma_f32_32x32x16_bf16(b0, qr[d0], p0, 0, 0, 0);
        p1 = __builtin_amdgcn_mfma_f32_32x32x16_bf16(b1, qr[d0], p1, 0, 0, 0); }
}
template <int VB, bool SK>
__device__ __forceinline__ void pv_tile(f32x16* o, int vb0, bf16x8 pa0, bf16x8 pa1, bf16x8 pa2, bf16x8 pa3, bool act) {
    if (SK && !act) return;
#define TRRD(dst, off) asm volatile("ds_read_b64_tr_b16 %0, %1 offset:%2" : "=&v"(dst) : "v"(vb0), "i"(off) : "memory")
#define PV_D0(d0) do { s16x4 l0, l1, l2, l3, h0, h1, h2, h3; constexpr int b_ = VB * SHM_V + v_rd_off(d0, 0, 0);     \
        TRRD(l0, b_); TRRD(h0, b_ + 2048); TRRD(l1, b_ + 4096); TRRD(h1, b_ + 6144); TRRD(l2, b_ + 8192); TRRD(h2, b_ + 10240); TRRD(l3, b_ + 12288); TRRD(h3, b_ + 14336); \
        asm volatile("s_waitcnt lgkmcnt(0)" ::: "memory"); SBAR();                 \
        o[d0] = __builtin_amdgcn_mfma_f32_32x32x16_bf16(pa0, (bf16x8){l0[0], l0[1], l0[2], l0[3], h0[0], h0[1], h0[2], h0[3]}, o[d0], 0, 0, 0);   \
        o[d0] = __builtin_amdgcn_mfma_f32_32x32x16_bf16(pa1, (bf16x8){l1[0], l1[1], l1[2], l1[3], h1[0], h1[1], h1[2], h1[3]}, o[d0], 0, 0, 0);   \
        o[d0] = __builtin_amdgcn_mfma_f32_32x32x16_bf16(pa2, (bf16x8){l2[0], l2[1], l2[2], l2[3], h2[0], h2[1], h2[2], h2[3]}, o[d0], 0, 0, 0);   \
        o[d0] = __builtin_amdgcn_mfma_f32_32x32x16_bf16(pa3, (bf16x8){l3[0], l3[1], l3[2], l3[3], h3[0], h3[1], h3[2], h3[3]}, o[d0], 0, 0, 0); } while (0)
    PV_D0(0); PV_D0(1); PV_D0(2); PV_D0(3);
#undef PV_D0
#undef TRRD
}

template <class TIn, class TOut> struct BlockRef { const TIn* Q; const TIn* K; const TIn* V; TOut* O; int P0; };
template <class TIn> struct Seam {
    bf16x8 qr[8];
    bf16x8 st_v0, st_v1, st_k0, st_k1; f32x4 sf0, sf1, sf2, sf3;
    f32x4 tq[16];
};
__device__ __forceinline__ int swa_jlo(int P0, int W) { const int lowk = P0 - W + 1; return lowk > 0 ? lowk / KVBLK : 0; }
#define ROW(p, k0, rr) ((p) + (size_t)((k0) + (rr)) * D + sc)
#define VMW() asm volatile("s_waitcnt vmcnt(0)" ::: "memory")
#define VMWN(n) asm volatile("s_waitcnt vmcnt(%0)" :: "i"(n) : "memory")
#define SLOAD_H(Kp, Vp, k0) do { S.st_v0 = load8<TIn>(ROW(Vp, k0, sr)); S.st_v1 = load8<TIn>(ROW(Vp, k0, 32 + sr));              \
                         S.st_k0 = load8<TIn>(ROW(Kp, k0, sr)); S.st_k1 = load8<TIn>(ROW(Kp, k0, 32 + sr)); } while (0)
#define SWRITE_HK(bf) do { *(bf16x8*)(K_lds + (bf) * SHM_K + kws) = S.st_k0; *(bf16x8*)(K_lds + (bf) * SHM_K + kws + 32 * 256) = S.st_k1; } while (0)
#define SWRITE_HV(bf) do { *(bf16x8*)(V_lds + (bf) * SHM_V + vst0) = S.st_v0; *(bf16x8*)(V_lds + (bf) * SHM_V + vst1) = S.st_v1; } while (0)
#define SWRITE_H(bf) do { SWRITE_HV(bf); SWRITE_HK(bf); } while (0)
#define SLOAD_F(p, k0) do { S.sf0 = *(const f32x4*)ROW(p, k0, sr); S.sf1 = *(const f32x4*)(ROW(p, k0, sr) + 4);                \
                            S.sf2 = *(const f32x4*)ROW(p, k0, 32 + sr); S.sf3 = *(const f32x4*)(ROW(p, k0, 32 + sr) + 4); } while (0)
#define SWRITE_KF(bf) do { *(bf16x8*)(K_lds + (bf) * SHM_K + kws) = pack8(S.sf0, S.sf1); *(bf16x8*)(K_lds + (bf) * SHM_K + kws + 32 * 256) = pack8(S.sf2, S.sf3); } while (0)
#define SWRITE_VF(bf) do { *(bf16x8*)(V_lds + (bf) * SHM_V + vst0) = pack8(S.sf0, S.sf1); *(bf16x8*)(V_lds + (bf) * SHM_V + vst1) = pack8(S.sf2, S.sf3); } while (0)
template <class TIn, class TOut>
__device__ __forceinline__ void causal_swa_prime(const BlockRef<TIn, TOut>& cur, int W, char* lds, Seam<TIn>& S) {
    constexpr bool F32 = same_t<TIn, float>::v;
    const int tid = threadIdx.x, wid = __builtin_amdgcn_readfirstlane(tid >> 6), lane = tid & 63, r32 = lane & 31, hi = lane >> 5;
    const int sr = tid >> 4, sc = (tid & 15) * 8, kws = KSWZ(sr, sc * 2); char* K_lds = lds + 2 * SHM_V;
    const int kb0 = swa_jlo(cur.P0, W) * KVBLK;
    for (int d0 = 0; d0 < 8; ++d0) S.qr[d0] = load8<TIn>(cur.Q + (size_t)(wid * QBLK + r32) * D + d0 * 16 + hi * 8);
    if constexpr (F32) { SLOAD_F((const float*)cur.K, kb0); VMW(); SWRITE_KF(0); SBAR(); SLOAD_F((const float*)cur.V, kb0); }
    else { SLOAD_H(cur.K, cur.V, kb0); VMW(); SWRITE_HK(0); }
    __syncthreads();
}
template <class TIn, class TOut>
__device__ __forceinline__ void causal_swa_block(const BlockRef<TIn, TOut>& cur, const BlockRef<TIn, TOut>& nxt, int skv, int W, char* lds, Seam<TIn>& S) {
    constexpr bool F32 = same_t<TIn, float>::v;
    const int tid = threadIdx.x, wid = __builtin_amdgcn_readfirstlane(tid >> 6), lane = tid & 63, r32 = lane & 31, hi = lane >> 5;
    const int j_lo = swa_jlo(cur.P0, W);
    int j_hi = (cur.P0 + QB - 1) / KVBLK + 1; if (j_hi > skv / KVBLK) j_hi = skv / KVBLK;
    const int NT = j_hi - j_lo;
    const int kbn = swa_jlo(nxt.P0, W) * KVBLK;
    const int qlo = cur.P0 + wid * QBLK, qm = qlo + r32 - 4 * hi;
    char* V_lds = lds; char* K_lds = lds + 2 * SHM_V;
    float* ws = (float*)(lds + 2 * SHM_V + 2 * SHM_K) + wid * 64; float* li_l = ws, * al_l = ws + 32;
    float m_reg = -1e30f, l_reg = 0; f32x16 o[4] = {};
    const int sr = tid >> 4, sc = (tid & 15) * 8, vst0 = v_st(sr, sc), vst1 = v_st(32 + sr, sc), kws = KSWZ(sr, sc * 2);
    const int vb0 = (int)(uintptr_t)V_lds + v_rd_base(lane);
    const TIn* Kh = cur.K; const TIn* Vh = cur.V;
#define RESC(a) do { if (__any((a) < 1.f)) { if (hi == 0) al_l[r32] = (a); asm volatile("s_waitcnt lgkmcnt(0)" ::: "memory");              \
                     for (int d_ = 0; d_ < 4; ++d_) for (int r = 0; r < 16; ++r) o[d_][r] *= al_l[crow(r, hi)]; } } while (0)
#define KBASE(t) ((j_lo + (t)) * KVBLK)
#define ACT(t) (KBASE(t) <= qlo + QBLK - 1 && KBASE(t) + KVBLK - 1 >= qlo - W + 1)
#define MASKT(P0_, P1_, t) do { const int kb_ = KBASE(t); if ((!SK || ACT(t)) && (kb_ + KVBLK - 1 > qlo || kb_ <= qlo + QBLK - 1 - W)) mask_tile(P0_, P1_, qm - kb_, (unsigned)W); } while (0)
    constexpr int NQL = F32 ? 16 : 8;
    constexpr bool SK = WSKIP && !F32;
#define SEAM_K0() do { VMWN(NQL); if constexpr (F32) { SWRITE_KF(0); SBAR(); SLOAD_F((const float*)nxt.V, kbn); } else { SWRITE_HK(0); } SBAR(); } while (0)
    f32x16 pA0, pA1, pB0, pB1; float mnA, mnB, alA, alB; bf16x8 pa0, pa1, pa2, pa3;
    if constexpr (F32) { VMW(); SWRITE_VF(0); SBAR(); } else { SWRITE_HV(0); SBAR(); }
    if (NT > 1) { if constexpr (F32) SLOAD_F((const float*)Kh, KBASE(1)); else SLOAD_H(Kh, Vh, KBASE(1)); }
    SBAR(); qkt<0, SK>(pA0, pA1, K_lds, r32, hi, S.qr, ACT(0));
    if constexpr (F32) { if (NT > 1) { VMW(); SWRITE_KF(1); SBAR(); SLOAD_F((const float*)Vh, KBASE(1)); } }
    MASKT(pA0, pA1, 0); partialSM(pA0, pA1, m_reg, mnA, alA);
    if (NT > 1) { VMW(); if constexpr (F32) { SWRITE_VF(1); SBAR(); if (NT > 2) SLOAD_F((const float*)Kh, KBASE(2)); } else SWRITE_H(1); }
    __syncthreads();
#define HALF_STEP(PX0, PX1, mnX, alX, PY0, PY1, alY, t, KB, VB, SB) do {                                                      \
        SBAR(); qkt<KB, SK>(PX0, PX1, K_lds, r32, hi, S.qr, ACT(t));                                             \
        finishSM(PY0, PY1, alY, l_reg, pa0, pa1, pa2, pa3); SBAR();                                                           \
        if ((t) + 1 < NT) { if constexpr (F32) { VMW(); SWRITE_KF(SB); SBAR(); SLOAD_F((const float*)Vh, KBASE((t) + 1)); }  \
                            else { SLOAD_H(Kh, Vh, KBASE((t) + 1)); } SBAR(); }                                               \
        pv_tile<VB, SK>(o, vb0, pa0, pa1, pa2, pa3, ACT((t) - 1)); MASKT(PX0, PX1, (t)); partialSM(PX0, PX1, m_reg, mnX, alX);                                        \
        __syncthreads();                                                                                                      \
        if ((t) + 1 < NT) { VMW(); if constexpr (F32) { SWRITE_VF(SB); SBAR(); if ((t) + 2 < NT) SLOAD_F((const float*)Kh, KBASE((t) + 2)); } \
                            else { SWRITE_H(SB); } }                                                                          \
        RESC(alX); __syncthreads(); } while (0)
    for (int t = 1; t + 1 < NT; t += 2) {
        HALF_STEP(pB0, pB1, mnB, alB, pA0, pA1, alA, t, 1, 0, 0);
        HALF_STEP(pA0, pA1, mnA, alA, pB0, pB1, alB, t + 1, 0, 1, 1);
    }
    const bool even = (NT & 1) == 0;
    if (even) { SBAR(); qkt<1, SK>(pB0, pB1, K_lds, r32, hi, S.qr, ACT(NT - 1)); SBAR(); }
#define QROW(e) (nxt.Q + (size_t)(wid * QBLK + r32) * D + ((e) >> 1) * 16 + hi * 8 + ((e) & 1) * 4)
    if constexpr (F32) { SLOAD_F((const float*)nxt.K, kbn); SBAR();
#pragma unroll
        for (int e = 0; e < 8; ++e) S.tq[e] = *(const f32x4*)QROW(e); }
    else { SLOAD_H(nxt.K, nxt.V, kbn); SBAR();
#pragma unroll
        for (int d0 = 0; d0 < 8; ++d0) S.qr[d0] = load8<TIn>(nxt.Q + (size_t)(wid * QBLK + r32) * D + d0 * 16 + hi * 8); }
    SBAR();
    finishSM(pA0, pA1, alA, l_reg, pa0, pa1, pa2, pa3); SBAR();
    if constexpr (F32) {
#pragma unroll
        for (int e = 8; e < 16; ++e) S.tq[e] = *(const f32x4*)QROW(e); SBAR(); }
#undef QROW
    pv_tile<0, SK>(o, vb0, pa0, pa1, pa2, pa3, ACT(even ? NT - 2 : NT - 1));
    if (even) { MASKT(pB0, pB1, NT - 1); partialSM(pB0, pB1, m_reg, mnB, alB); __syncthreads(); RESC(alB);
        finishSM(pB0, pB1, alB, l_reg, pa0, pa1, pa2, pa3); SBAR(); pv_tile<1, SK>(o, vb0, pa0, pa1, pa2, pa3, ACT(NT - 1)); }
    SBAR(); SEAM_K0();
    if (hi == 0) li_l[r32] = l_reg; asm volatile("s_waitcnt lgkmcnt(0)" ::: "memory");
    float rli[16];
#pragma unroll
    for (int r = 0; r < 16; ++r) rli[r] = __builtin_amdgcn_rcpf(li_l[crow(r, hi)]);
    TOut* Ow = cur.O + (size_t)(wid * QBLK) * D;
#pragma unroll
    for (int r = 0; r < 16; ++r) { const int orow = crow(r, hi);
#pragma unroll
        for (int d0 = 0; d0 < 4; ++d0) { const float v = o[d0][r] * rli[r];
            if constexpr (same_t<TOut, float>::v) { Ow[(size_t)orow * D + d0 * 32 + r32] = v; }
            else { const float vn = __shfl_xor(v, 1);
                   if ((r32 & 1) == 0) *(unsigned*)(Ow + (size_t)orow * D + d0 * 32 + r32) = cvtpk(v, vn); } } }
    if constexpr (F32) {
#pragma unroll
        for (int d0 = 0; d0 < 8; ++d0) S.qr[d0] = pack8(S.tq[2 * d0], S.tq[2 * d0 + 1]); }
    __syncthreads();
#undef RESC
#undef KBASE
#undef ACT
#undef MASKT
#undef SEAM_K0
#undef HALF_STEP
}
#undef ROW
#undef VMW
#undef VMWN
#undef SLOAD_H
#undef SWRITE_HK
#undef SWRITE_HV
#undef SWRITE_H
#undef SLOAD_F
#undef SWRITE_KF
#undef SWRITE_VF

}

namespace att2 {
typedef unsigned short bf16_t;
using att::bf16x8; using att::s16x4; using att::f32x16; using att::f32x4; using att::u32x4; using att::cvtpk; using att::crow; using att::v_rd_base;
constexpr int OFF_K = 0  , OFF_V = 49152  , OFF_ML = 147456, OFF_AL = 149504, LDS_END = 150528;
constexpr float SCALE = 0.08838834764831845f, THR = 1.2f, THR16 = 8.f, C2 = 1.4426950408889634f * SCALE, PSH = 7.0f;
__device__ __forceinline__ int v_st256(int k, int c) { const int kk = (k & ~0xC) | ((k & 4) << 1) | ((k & 8) >> 1); return ((kk >> 3) * 8 + (c >> 5)) * 512 + ((kk & 7) * 32 + (c & 31)) * 2; }
#define A2_TRRD(dst, addr, off) asm volatile("ds_read_b64_tr_b16 %0, %1 offset:%2" : "=&v"(dst) : "v"(addr), "i"(off) : "memory")
#define A2_PK4(P, B_, OUT) do { unsigned a0_ = cvtpk(P[B_+0], P[B_+1]), a1_ = cvtpk(P[B_+2], P[B_+3]); unsigned b0_ = cvtpk(P[B_+4], P[B_+5]), b1_ = cvtpk(P[B_+6], P[B_+7]);  \
        auto r0_ = __builtin_amdgcn_permlane32_swap(a0_, b0_, false, false); auto r1_ = __builtin_amdgcn_permlane32_swap(a1_, b1_, false, false); \
        u32x4 w_ = {r0_[0], r1_[0], r0_[1], r1_[1]}; OUT = *reinterpret_cast<bf16x8*>(&w_); } while (0)

__device__ __forceinline__ void attn_block_b16(const bf16_t* __restrict__ Qg, const bf16_t* __restrict__ Kg, const bf16_t* __restrict__ Vg, bf16_t* __restrict__ Og, int qb, char* lds) {
    int tid = threadIdx.x; asm volatile("" : "+v"(tid));
    const int wid = __builtin_amdgcn_readfirstlane(tid >> 6), lane = tid & 63, r32 = lane & 31, hi = lane >> 5;
    const int P0 = qb * 256, NT = 4 * qb + 4, qlo = P0 + 32 * wid, qm = qlo + r32 - 4 * hi, NTW = (qlo >> 6) + 1;
    char* K_lds = lds + OFF_K; char* V_lds = lds + OFF_V;
    float* Ll = (float*)(lds + OFF_ML) + wid * 32; float* al_l = (float*)(lds + OFF_AL) + wid * 32;
    typedef __attribute__((address_space(3))) unsigned lds_u32;
    const int krow = lane >> 4, kslot = lane & 15;
    unsigned koff[2];
#pragma unroll
    for (int i = 0; i < 2; ++i) { const int r = 8 * wid + 4 * i + krow; koff[i] = (unsigned)(r * 256 + ((kslot ^ (r & 7)) << 4)); }
    unsigned voff[4];
#pragma unroll
    for (int i = 0; i < 4; ++i) { const int q = 64 * i + lane, stl = q >> 5, kk = 8 * wid + ((q & 31) >> 2), jj = q & 3;
        const int k = (kk & ~0xC) | ((kk & 4) << 1) | ((kk & 8) >> 1); voff[i] = (unsigned)(k * 512 + (stl * 32 + jj * 8) * 2); }
    const lds_u32* kdst = (const lds_u32*)((__attribute__((address_space(3))) char*)K_lds + wid * 2048);
    const lds_u32* vdst = (const lds_u32*)((__attribute__((address_space(3))) char*)V_lds + wid * 4096);
#define A2_DMAK(i) __builtin_amdgcn_global_load_lds((const unsigned*)(kgn + koff[i]), (lds_u32*)((__attribute__((address_space(3))) char*)kdst + bn2 * 16384 + (i) * 1024), 16, 0, 0)
#define A2_DMAV(i) __builtin_amdgcn_global_load_lds((const unsigned*)(vgn + voff[i]), (lds_u32*)((__attribute__((address_space(3))) char*)vdst + bn2 * 32768 + (i) * 1024), 16, 0, 0)
#define A2_DMA(k0, bf) do { const char* kg_ = (const char*)(Kg + (size_t)(k0) * 128); const char* vg_ = (const char*)(Vg + (size_t)(k0) * 256);                       \
        _Pragma("unroll") for (int i = 0; i < 2; ++i) __builtin_amdgcn_global_load_lds((const unsigned*)(kg_ + koff[i]), (lds_u32*)((__attribute__((address_space(3))) char*)kdst + (bf) * 16384 + i * 1024), 16, 0, 0); \
        _Pragma("unroll") for (int i = 0; i < 4; ++i) __builtin_amdgcn_global_load_lds((const unsigned*)(vg_ + voff[i]), (lds_u32*)((__attribute__((address_space(3))) char*)vdst + (bf) * 32768 + i * 1024), 16, 0, 0); } while (0)
    bf16x8 qf[8];
#pragma unroll
    for (int d0 = 0; d0 < 8; ++d0) qf[d0] = *(const bf16x8*)(Qg + (size_t)(qlo + r32) * 128 + d0 * 16 + hi * 8);
#define A2_BAR(n) do { asm volatile("s_waitcnt vmcnt(" #n ")" ::: "memory"); asm volatile("s_waitcnt lgkmcnt(0)" ::: "memory"); __builtin_amdgcn_s_barrier(); asm volatile("" ::: "memory"); } while (0)
    A2_DMA(0, 0); A2_DMA(64, 1);
    A2_BAR(6);
    float m_reg = -1e30f, l_reg = 0.f;
    f32x16 o[8];
#pragma unroll
    for (int d = 0; d < 8; ++d) o[d] = f32x16{};
    const int vrd0 = (int)(uintptr_t)V_lds + v_rd_base(lane);
    int buf = 0;
    int t = 0;
    for (; t < NTW; ++t) {
        const int kb = t * 64; const int bn2 = buf == 0 ? 2 : buf - 1;
        const bool more = t + 2 < NT;
        const char* kgn = (const char*)(Kg + (size_t)(kb + 128) * 128); const char* vgn = (const char*)(Vg + (size_t)(kb + 128) * 256);
        __builtin_amdgcn_sched_barrier(0);
        {
        bf16x8 pa0, pa1, pa2, pa3;
        const bool mset = m_reg > -1e29f; const float a0 = mset ? -m_reg : 0.f;
        f32x16 p0, p1;
#pragma unroll
        for (int r = 0; r < 16; ++r) { p0[r] = a0; p1[r] = a0; }
        {
            const int kp = (int)(uintptr_t)K_lds + buf * 16384;
            const int kad0 = kp + KSWZ(r32, 0 + hi * 16), kad1 = kp + KSWZ(r32, 32 + hi * 16), kad2 = kp + KSWZ(r32, 64 + hi * 16), kad3 = kp + KSWZ(r32, 96 + hi * 16);
            bf16x8 ka, kb_, kc;
#define A2_KRD(AD, OFF, X0) asm volatile("ds_read_b128 %0, %1 offset:%2" : "=&v"(X0) : "v"(AD), "i"(OFF) : "memory")
#define A2_KMM(P, d0, X0) do { P = __builtin_amdgcn_mfma_f32_32x32x16_bf16(X0, qf[d0], P, 0, 0, 0); __builtin_amdgcn_sched_barrier(0); } while (0)
#define A2_KLW(n) do { asm volatile("s_waitcnt lgkmcnt(" #n ")" ::: "memory"); __builtin_amdgcn_sched_barrier(0); } while (0)
            A2_KRD(kad0, 0, ka); A2_KRD(kad1, 0, kb_); A2_KRD(kad2, 0, kc);
            A2_KLW(2); A2_KMM(p0, 0, ka); A2_KRD(kad3, 0, ka);
            A2_KLW(2); A2_KMM(p0, 1, kb_); A2_KRD(kad0, 128, kb_);
            A2_KLW(2); A2_KMM(p0, 2, kc); A2_KRD(kad1, 128, kc);
            A2_KLW(2); A2_KMM(p0, 3, ka); A2_KRD(kad2, 128, ka);
            A2_KLW(2); A2_KMM(p0, 4, kb_); A2_KRD(kad3, 128, kb_);
            A2_KLW(2); A2_KMM(p0, 5, kc); A2_KRD(kad0, 8192, kc);
            A2_KLW(2); A2_KMM(p0, 6, ka); A2_KRD(kad1, 8192, ka);
            A2_KLW(2); A2_KMM(p0, 7, kb_); A2_KRD(kad2, 8192, kb_);
            A2_KLW(2); A2_KMM(p1, 0, kc); A2_KRD(kad3, 8192, kc);
            A2_KLW(2); A2_KMM(p1, 1, ka); A2_KRD(kad0, 8320, ka);
            A2_KLW(2); A2_KMM(p1, 2, kb_); A2_KRD(kad1, 8320, kb_);
            A2_KLW(2); A2_KMM(p1, 3, kc); A2_KRD(kad2, 8320, kc);
            A2_KLW(2); A2_KMM(p1, 4, ka); A2_KRD(kad3, 8320, ka);
            A2_KLW(2); A2_KMM(p1, 5, kb_);
            A2_KLW(1); A2_KMM(p1, 6, kc);
            A2_KLW(0); A2_KMM(p1, 7, ka);
#undef A2_KRD
#undef A2_KMM
#undef A2_KLW
        }
        if (kb + 63 > qlo) {
            const int dq = qm - kb; const float NEG = -__builtin_inff();
#pragma unroll
            for (int r = 0; r < 16; ++r) { const int c = (r & 3) + 8 * (r >> 2); if (dq - c < 0) p0[r] = NEG; if (dq - c - 32 < 0) p1[r] = NEG; }
        }
        {
            float pmax = fmaxf(fmaxf(fmaxf(p0[0], p0[1]), fmaxf(p0[2], p0[3])), fmaxf(fmaxf(p0[4], p0[5]), fmaxf(p0[6], p0[7])));
            pmax = fmaxf(pmax, fmaxf(fmaxf(fmaxf(p0[8], p0[9]), fmaxf(p0[10], p0[11])), fmaxf(fmaxf(p0[12], p0[13]), fmaxf(p0[14], p0[15]))));
            float pmx1 = fmaxf(fmaxf(fmaxf(p1[0], p1[1]), fmaxf(p1[2], p1[3])), fmaxf(fmaxf(p1[4], p1[5]), fmaxf(p1[6], p1[7])));
            pmx1 = fmaxf(pmx1, fmaxf(fmaxf(fmaxf(p1[8], p1[9]), fmaxf(p1[10], p1[11])), fmaxf(fmaxf(p1[12], p1[13]), fmaxf(p1[14], p1[15]))));
            pmax = fmaxf(pmax, pmx1);
            { auto rr = __builtin_amdgcn_permlane32_swap(__float_as_uint(pmax), __float_as_uint(pmax), false, false); pmax = fmaxf(__uint_as_float(rr[0]), __uint_as_float(rr[1])); }
            float alpha = 1.f;
            if (!__builtin_expect(__all(mset && pmax <= THR16 * 1.4426950408889634f), 1)) {
                const float mn = fmaxf(m_reg, pmax - a0), dl = -a0 - mn; alpha = __builtin_amdgcn_exp2f(m_reg - mn); m_reg = mn;
#pragma unroll
                for (int r = 0; r < 16; ++r) { p0[r] += dl; p1[r] += dl; } }
#pragma unroll
            for (int r = 0; r < 16; ++r) { p0[r] = __builtin_amdgcn_exp2f(p0[r]); p1[r] = __builtin_amdgcn_exp2f(p1[r]); }
            if (__any(alpha < 1.f)) {
                if (hi == 0) al_l[r32] = alpha;
                asm volatile("s_waitcnt lgkmcnt(0)" ::: "memory");
#pragma unroll
                for (int r = 0; r < 16; ++r) { const float ar = (al_l + 4 * hi)[(r & 3) + 8 * (r >> 2)];
#pragma unroll
                    for (int d = 0; d < 8; ++d) o[d][r] *= ar; }
            }
            float ps = ((p0[0] + p0[1]) + (p0[2] + p0[3])) + ((p0[4] + p0[5]) + (p0[6] + p0[7]));
            ps += ((p0[8] + p0[9]) + (p0[10] + p0[11])) + ((p0[12] + p0[13]) + (p0[14] + p0[15]));
            float ps1 = ((p1[0] + p1[1]) + (p1[2] + p1[3])) + ((p1[4] + p1[5]) + (p1[6] + p1[7]));
            ps1 += ((p1[8] + p1[9]) + (p1[10] + p1[11])) + ((p1[12] + p1[13]) + (p1[14] + p1[15]));
            ps += ps1;
            { auto rr = __builtin_amdgcn_permlane32_swap(__float_as_uint(ps), __float_as_uint(ps), false, false); ps = __uint_as_float(rr[0]) + __uint_as_float(rr[1]); }
            l_reg = l_reg * alpha + ps;
            A2_PK4(p0, 0, pa0); A2_PK4(p0, 8, pa1); A2_PK4(p1, 0, pa2); A2_PK4(p1, 8, pa3);
        }
        {
            const int vb = vrd0 + buf * 32768;
            s16x4 a0, a1, a2, a3, b0, b1, b2, b3, c0, c1, c2, c3;
#define A2_RD(h, d0, L0, H0, L1, H1) do { A2_TRRD(L0, vb, (h) * 16384 + (d0) * 512); A2_TRRD(H0, vb, (h) * 16384 + (d0) * 512 + 4096); A2_TRRD(L1, vb, (h) * 16384 + (d0) * 512 + 8192); A2_TRRD(H1, vb, (h) * 16384 + (d0) * 512 + 12288); } while (0)
#define A2_MM(PA, PB, d0, L0, H0, L1, H1) do { o[d0] = __builtin_amdgcn_mfma_f32_32x32x16_bf16(PA, (bf16x8){L0[0], L0[1], L0[2], L0[3], H0[0], H0[1], H0[2], H0[3]}, o[d0], 0, 0, 0);   \
                                               o[d0] = __builtin_amdgcn_mfma_f32_32x32x16_bf16(PB, (bf16x8){L1[0], L1[1], L1[2], L1[3], H1[0], H1[1], H1[2], H1[3]}, o[d0], 0, 0, 0); } while (0)
#define A2_LW(n) do { asm volatile("s_waitcnt lgkmcnt(" #n ")" ::: "memory"); __builtin_amdgcn_sched_barrier(0); } while (0)
#define A2_SB __builtin_amdgcn_sched_barrier(0)
            A2_RD(0, 0, a0, a1, a2, a3); A2_RD(0, 1, b0, b1, b2, b3);
            A2_RD(0, 2, c0, c1, c2, c3); A2_LW(8); A2_MM(pa0, pa1, 0, a0, a1, a2, a3); if (more) A2_DMAK(0); A2_SB;
            A2_RD(0, 3, a0, a1, a2, a3); A2_LW(8); A2_MM(pa0, pa1, 1, b0, b1, b2, b3); if (more) A2_DMAK(1); A2_SB;
            A2_RD(0, 4, b0, b1, b2, b3); A2_LW(8); A2_MM(pa0, pa1, 2, c0, c1, c2, c3); if (more) A2_DMAV(0); A2_SB;
            A2_RD(0, 5, c0, c1, c2, c3); A2_LW(8); A2_MM(pa0, pa1, 3, a0, a1, a2, a3); if (more) A2_DMAV(1); A2_SB;
            A2_RD(0, 6, a0, a1, a2, a3); A2_LW(8); A2_MM(pa0, pa1, 4, b0, b1, b2, b3); if (more) A2_DMAV(2); A2_SB;
            A2_RD(0, 7, b0, b1, b2, b3); A2_LW(8); A2_MM(pa0, pa1, 5, c0, c1, c2, c3); if (more) A2_DMAV(3); A2_SB;
            A2_RD(1, 0, c0, c1, c2, c3); A2_LW(8); A2_MM(pa0, pa1, 6, a0, a1, a2, a3); A2_SB;
            A2_RD(1, 1, a0, a1, a2, a3); A2_LW(8); A2_MM(pa0, pa1, 7, b0, b1, b2, b3); A2_SB;
            A2_RD(1, 2, b0, b1, b2, b3); A2_LW(8); A2_MM(pa2, pa3, 0, c0, c1, c2, c3); A2_SB;
            A2_RD(1, 3, c0, c1, c2, c3); A2_LW(8); A2_MM(pa2, pa3, 1, a0, a1, a2, a3); A2_SB;
            A2_RD(1, 4, a0, a1, a2, a3); A2_LW(8); A2_MM(pa2, pa3, 2, b0, b1, b2, b3); A2_SB;
            A2_RD(1, 5, b0, b1, b2, b3); A2_LW(8); A2_MM(pa2, pa3, 3, c0, c1, c2, c3); A2_SB;
            A2_RD(1, 6, c0, c1, c2, c3); A2_LW(8); A2_MM(pa2, pa3, 4, a0, a1, a2, a3); A2_SB;
            A2_RD(1, 7, a0, a1, a2, a3); A2_LW(8); A2_MM(pa2, pa3, 5, b0, b1, b2, b3); A2_SB;
            A2_LW(4); A2_MM(pa2, pa3, 6, c0, c1, c2, c3); A2_SB;
            A2_LW(0); A2_MM(pa2, pa3, 7, a0, a1, a2, a3);
#undef A2_RD
#undef A2_MM
#undef A2_LW
#undef A2_SB
        }
        }
        __builtin_amdgcn_sched_barrier(0);
        if (t + 2 < NT) A2_BAR(6); else A2_BAR(0);
        buf = buf == 2 ? 0 : buf + 1;
    }
    for (; t < NT; ++t) {
        const int kb = t * 64; const int bn2 = buf == 0 ? 2 : buf - 1; const bool more = t + 2 < NT;
        const char* kgn = (const char*)(Kg + (size_t)(kb + 128) * 128); const char* vgn = (const char*)(Vg + (size_t)(kb + 128) * 256);
        if (more) { A2_DMAK(0); A2_DMAK(1); A2_DMAV(0); A2_DMAV(1); A2_DMAV(2); A2_DMAV(3); }
        if (t + 2 < NT) A2_BAR(6); else A2_BAR(0);
        buf = buf == 2 ? 0 : buf + 1;
    }
    if (hi == 0) Ll[r32] = l_reg;
    asm volatile("s_waitcnt lgkmcnt(0)" ::: "memory");
    int tid2 = threadIdx.x; asm volatile("" : "+v"(tid2));
    const int e32 = tid2 & 31, ehi = (tid2 >> 5) & 1;
    float f[16];
#pragma unroll
    for (int r = 0; r < 16; ++r) f[r] = __builtin_amdgcn_rcpf((Ll + 4 * ehi)[(r & 3) + 8 * (r >> 2)]);
    {
        char* ob = (char*)(Og + (size_t)(qlo + 4 * ehi) * 256 + e32);
#pragma unroll
        for (int d0 = 0; d0 < 8; ++d0)
#pragma unroll
            for (int r = 0; r < 16; ++r) { const int rc = (r & 3) + 8 * (r >> 2); const float v = o[d0][r] * f[r], vn = __shfl_xor(v, 1);
                if ((e32 & 1) == 0) *(unsigned*)(ob + (rc * 256 + 32 * d0) * 2) = cvtpk(v, vn); }
    }
    __syncthreads();
#undef A2_DMA
#undef A2_DMAK
#undef A2_DMAV
#undef A2_BAR
}
typedef int i32x8 __attribute__((ext_vector_type(8)));
typedef int i32x4_ __attribute__((ext_vector_type(4)));
__device__ __forceinline__ void attn_block(const unsigned char* __restrict__ Q8, const unsigned char* __restrict__ K8, int jsh, const unsigned char* __restrict__ V8, float vinv, bf16_t* __restrict__ Og, int qb, char* lds) {
    int tid = threadIdx.x; asm volatile("" : "+v"(tid));
    const int wid = __builtin_amdgcn_readfirstlane(tid >> 6), lane = tid & 63, r32 = lane & 31, hi = lane >> 5;
    const int P0 = qb * 256, NT = 4 * qb + 4, qlo = P0 + 32 * wid, qm = qlo + r32 - 4 * hi, NTW = (qlo >> 6) + 1;
    char* K_lds = lds + OFF_K; char* V_lds = lds + OFF_V;
    float* Ll = (float*)(lds + OFF_ML) + wid * 32; float* al_l = (float*)(lds + OFF_AL) + wid * 32;
    typedef __attribute__((address_space(3))) unsigned lds_u32;
    unsigned koff;
    { const int q = wid * 64 + lane, r = q >> 3, sl = q & 7; koff = (unsigned)(r * 128 + ((sl ^ ((r >> 1) & 7)) << 4)); }
    unsigned voff[2];
#pragma unroll
    for (int i = 0; i < 2; ++i) { const int q = (2 * wid + i) * 64 + lane, dv = q >> 2, sl = q & 3; voff[i] = (unsigned)(dv * 64 + ((sl ^ ((dv >> 2) & 3)) << 4)); }
    const lds_u32* kdst = (const lds_u32*)((__attribute__((address_space(3))) char*)K_lds + wid * 1024);
    const lds_u32* vdst = (const lds_u32*)((__attribute__((address_space(3))) char*)V_lds + wid * 2048);
#define A2_DMAK() __builtin_amdgcn_global_load_lds((const unsigned*)(kgn + koff), (lds_u32*)((__attribute__((address_space(3))) char*)kdst + bn2 * 8192), 16, 0, 0)
#define A2_DMAV(i) __builtin_amdgcn_global_load_lds((const unsigned*)(vgn + voff[i]), (lds_u32*)((__attribute__((address_space(3))) char*)vdst + bn2 * 16384 + (i) * 1024), 16, 0, 0)
#define A2_DMA(tt, bf) do { const char* kg_ = (const char*)(K8 + (size_t)(tt) * 8192); const char* vg_ = (const char*)(V8 + (size_t)(tt) * 16384);                       \
        __builtin_amdgcn_global_load_lds((const unsigned*)(kg_ + koff), (lds_u32*)((__attribute__((address_space(3))) char*)kdst + (bf) * 8192), 16, 0, 0); \
        _Pragma("unroll") for (int i = 0; i < 2; ++i) __builtin_amdgcn_global_load_lds((const unsigned*)(vg_ + voff[i]), (lds_u32*)((__attribute__((address_space(3))) char*)vdst + (bf) * 16384 + i * 1024), 16, 0, 0); } while (0)
    i32x8 qf0, qf1;
    { const i32x4_* qp = (const i32x4_*)(Q8 + (size_t)(qlo + r32) * 128 + hi * 32); const i32x4_ a = qp[0], b = qp[1], c_ = qp[4], d = qp[5];
      qf0 = (i32x8){a[0], a[1], a[2], a[3], b[0], b[1], b[2], b[3]}; qf1 = (i32x8){c_[0], c_[1], c_[2], c_[3], d[0], d[1], d[2], d[3]}; }
    const int scq = (127 - jsh) & 0xff;
#define A2_BAR(n) do { asm volatile("s_waitcnt vmcnt(" #n ")" ::: "memory"); asm volatile("s_waitcnt lgkmcnt(0)" ::: "memory"); __builtin_amdgcn_s_barrier(); asm volatile("" ::: "memory"); } while (0)
    A2_DMA(0, 0); A2_DMA(1, 1);
    A2_BAR(3);
    float m_reg = -1e30f, l_reg = 0.f;
    f32x16 a0v = f32x16{};
    f32x16 o[8];
#pragma unroll
    for (int d = 0; d < 8; ++d) o[d] = f32x16{};
    const int vrd0 = (int)(uintptr_t)V_lds + r32 * 64 + (((2 * hi) ^ ((r32 >> 2) & 3)) << 4);
    const int sc1 = 0x7f7f7f7f;
    int buf = 0;
    int t = 0;
    for (; t < NTW; ++t) {
        const int kb = t * 64; const int bn2 = buf == 0 ? 2 : buf - 1;
        const bool more = t + 2 < NT;
        const char* kgn = (const char*)(K8 + (size_t)(t + 2) * 8192); const char* vgn = (const char*)(V8 + (size_t)(t + 2) * 16384);
        __builtin_amdgcn_sched_barrier(0);
        {
        i32x8 pf;
        const bool mset = m_reg > -1e29f; const float a0 = mset ? PSH - m_reg : 0.f;
        f32x16 p0, p1;
        {
            const int ka_ = (int)(uintptr_t)K_lds + buf * 8192 + r32 * 128 + (((2 * hi) ^ ((r32 >> 1) & 7)) << 4);
            const int kb1 = ka_ ^ 16, kc0 = ka_ ^ 64, kc1 = ka_ ^ 80;
            i32x4_ x0, x1, y0, y1, z0, z1, w0, w1;
            asm volatile("ds_read_b128 %0, %1" : "=&v"(x0) : "v"(ka_) : "memory"); asm volatile("ds_read_b128 %0, %1" : "=&v"(x1) : "v"(kb1) : "memory");
            asm volatile("ds_read_b128 %0, %1" : "=&v"(y0) : "v"(kc0) : "memory"); asm volatile("ds_read_b128 %0, %1" : "=&v"(y1) : "v"(kc1) : "memory");
            asm volatile("ds_read_b128 %0, %1 offset:4096" : "=&v"(z0) : "v"(ka_) : "memory"); asm volatile("ds_read_b128 %0, %1 offset:4096" : "=&v"(z1) : "v"(kb1) : "memory");
            asm volatile("ds_read_b128 %0, %1 offset:4096" : "=&v"(w0) : "v"(kc0) : "memory"); asm volatile("ds_read_b128 %0, %1 offset:4096" : "=&v"(w1) : "v"(kc1) : "memory");
            asm volatile("s_waitcnt lgkmcnt(6)" ::: "memory"); __builtin_amdgcn_sched_barrier(0);
            p0 = __builtin_amdgcn_mfma_scale_f32_32x32x64_f8f6f4((i32x8){x0[0], x0[1], x0[2], x0[3], x1[0], x1[1], x1[2], x1[3]}, qf0, a0v, 0, 0, 0, scq, 0, sc1); __builtin_amdgcn_sched_barrier(0);
            asm volatile("s_waitcnt lgkmcnt(2)" ::: "memory"); __builtin_amdgcn_sched_barrier(0);
            p1 = __builtin_amdgcn_mfma_scale_f32_32x32x64_f8f6f4((i32x8){z0[0], z0[1], z0[2], z0[3], z1[0], z1[1], z1[2], z1[3]}, qf0, a0v, 0, 0, 0, scq, 0, sc1); __builtin_amdgcn_sched_barrier(0);
            p0 = __builtin_amdgcn_mfma_scale_f32_32x32x64_f8f6f4((i32x8){y0[0], y0[1], y0[2], y0[3], y1[0], y1[1], y1[2], y1[3]}, qf1, p0, 0, 0, 0, scq, 0, sc1); __builtin_amdgcn_sched_barrier(0);
            asm volatile("s_waitcnt lgkmcnt(0)" ::: "memory"); __builtin_amdgcn_sched_barrier(0);
            p1 = __builtin_amdgcn_mfma_scale_f32_32x32x64_f8f6f4((i32x8){w0[0], w0[1], w0[2], w0[3], w1[0], w1[1], w1[2], w1[3]}, qf1, p1, 0, 0, 0, scq, 0, sc1); asm volatile("" : "+v"(p0), "+v"(p1)); __builtin_amdgcn_sched_barrier(0);
        }
        if (kb + 63 > qlo) {
            const int dq = qm - kb; const float NEG = -__builtin_inff();
#pragma unroll
            for (int r = 0; r < 16; ++r) { const int c = (r & 3) + 8 * (r >> 2); if (dq - c < 0) p0[r] = NEG; if (dq - c - 32 < 0) p1[r] = NEG; }
        }
        {
            float pmax = fmaxf(fmaxf(fmaxf(p0[0], p0[1]), fmaxf(p0[2], p0[3])), fmaxf(fmaxf(p0[4], p0[5]), fmaxf(p0[6], p0[7])));
            pmax = fmaxf(pmax, fmaxf(fmaxf(fmaxf(p0[8], p0[9]), fmaxf(p0[10], p0[11])), fmaxf(fmaxf(p0[12], p0[13]), fmaxf(p0[14], p0[15]))));
            float pmx1 = fmaxf(fmaxf(fmaxf(p1[0], p1[1]), fmaxf(p1[2], p1[3])), fmaxf(fmaxf(p1[4], p1[5]), fmaxf(p1[6], p1[7])));
            pmx1 = fmaxf(pmx1, fmaxf(fmaxf(fmaxf(p1[8], p1[9]), fmaxf(p1[10], p1[11])), fmaxf(fmaxf(p1[12], p1[13]), fmaxf(p1[14], p1[15]))));
            pmax = fmaxf(pmax, pmx1);
            { auto rr = __builtin_amdgcn_permlane32_swap(__float_as_uint(pmax), __float_as_uint(pmax), false, false); pmax = fmaxf(__uint_as_float(rr[0]), __uint_as_float(rr[1])); }
            float alpha = 1.f;
            if (!__builtin_expect(__all(mset && pmax <= PSH + THR * 1.4426950408889634f), 1)) {
                const float mn = fmaxf(m_reg, pmax - a0), dl = (PSH - mn) - a0; alpha = __builtin_amdgcn_exp2f(m_reg - mn); m_reg = mn;
#pragma unroll
                for (int r = 0; r < 16; ++r) a0v[r] = PSH - mn;
#pragma unroll
                for (int r = 0; r < 16; ++r) { p0[r] += dl; p1[r] += dl; } }
#pragma unroll
            for (int r = 0; r < 16; ++r) { p0[r] = __builtin_amdgcn_exp2f(p0[r]); p1[r] = __builtin_amdgcn_exp2f(p1[r]); }
            if (__any(alpha < 1.f)) {
                if (hi == 0) al_l[r32] = alpha;
                asm volatile("s_waitcnt lgkmcnt(0)" ::: "memory");
#pragma unroll
                for (int r = 0; r < 16; ++r) { const float ar = (al_l + 4 * hi)[(r & 3) + 8 * (r >> 2)];
#pragma unroll
                    for (int d = 0; d < 8; ++d) o[d][r] *= ar; }
            }
            float ps = ((p0[0] + p0[1]) + (p0[2] + p0[3])) + ((p0[4] + p0[5]) + (p0[6] + p0[7]));
            ps += ((p0[8] + p0[9]) + (p0[10] + p0[11])) + ((p0[12] + p0[13]) + (p0[14] + p0[15]));
            float ps1 = ((p1[0] + p1[1]) + (p1[2] + p1[3])) + ((p1[4] + p1[5]) + (p1[6] + p1[7]));
            ps1 += ((p1[8] + p1[9]) + (p1[10] + p1[11])) + ((p1[12] + p1[13]) + (p1[14] + p1[15]));
            ps += ps1;
            { auto rr = __builtin_amdgcn_permlane32_swap(__float_as_uint(ps), __float_as_uint(ps), false, false); ps = __uint_as_float(rr[0]) + __uint_as_float(rr[1]); }
            l_reg = l_reg * alpha + ps;
#pragma unroll
            for (int i = 0; i < 4; ++i) { int w = 0; w = __builtin_amdgcn_cvt_pk_fp8_f32(p0[4 * i], p0[4 * i + 1], w, false); w = __builtin_amdgcn_cvt_pk_fp8_f32(p0[4 * i + 2], p0[4 * i + 3], w, true); pf[i] = w;
                                          int u = 0; u = __builtin_amdgcn_cvt_pk_fp8_f32(p1[4 * i], p1[4 * i + 1], u, false); u = __builtin_amdgcn_cvt_pk_fp8_f32(p1[4 * i + 2], p1[4 * i + 3], u, true); pf[4 + i] = u; }
            asm volatile("" : "+v"(pf)); __builtin_amdgcn_sched_barrier(0);
        }
        {
            const int va = vrd0 + buf * 16384, vx = va ^ 16;
            i32x4_ a0, a1, b0, b1, c0, c1;
#define A2_RD(d0, X0, X1) do { asm volatile("ds_read_b128 %0, %1 offset:%2" : "=&v"(X0) : "v"(va), "i"((d0) * 2048) : "memory"); asm volatile("ds_read_b128 %0, %1 offset:%2" : "=&v"(X1) : "v"(vx), "i"((d0) * 2048) : "memory"); } while (0)
#define A2_MM(d0, X0, X1) do { o[d0] = __builtin_amdgcn_mfma_scale_f32_32x32x64_f8f6f4(pf, (i32x8){X0[0], X0[1], X0[2], X0[3], X1[0], X1[1], X1[2], X1[3]}, o[d0], 0, 0, 0, sc1, 0, sc1); asm volatile("" : "+v"(o[d0])); } while (0)
#define A2_LW(n) do { asm volatile("s_waitcnt lgkmcnt(" #n ")" ::: "memory"); __builtin_amdgcn_sched_barrier(0); } while (0)
#define A2_SB __builtin_amdgcn_sched_barrier(0)
            A2_RD(0, a0, a1); A2_RD(1, b0, b1);
            A2_RD(2, c0, c1); A2_LW(4); A2_MM(0, a0, a1); if (more) A2_DMAK(); A2_SB;
            A2_RD(3, a0, a1); A2_LW(4); A2_MM(1, b0, b1); A2_SB;
            A2_RD(4, b0, b1); A2_LW(4); A2_MM(2, c0, c1); if (more) A2_DMAV(0); A2_SB;
            A2_RD(5, c0, c1); A2_LW(4); A2_MM(3, a0, a1); if (more) A2_DMAV(1); A2_SB;
            A2_RD(6, a0, a1); A2_LW(4); A2_MM(4, b0, b1); A2_SB;
            A2_RD(7, b0, b1); A2_LW(4); A2_MM(5, c0, c1); A2_SB;
            A2_LW(2); A2_MM(6, a0, a1); A2_SB;
            A2_LW(0); A2_MM(7, b0, b1);
#undef A2_RD
#undef A2_MM
#undef A2_LW
#undef A2_SB
        }
        }
        __builtin_amdgcn_sched_barrier(0);
        if (t + 2 < NT) A2_BAR(3); else A2_BAR(0);
        buf = buf == 2 ? 0 : buf + 1;
    }
    for (; t < NT; ++t) {
        const int kb = t * 64; const int bn2 = buf == 0 ? 2 : buf - 1; const bool more = t + 2 < NT;
        const char* kgn = (const char*)(K8 + (size_t)(t + 2) * 8192); const char* vgn = (const char*)(V8 + (size_t)(t + 2) * 16384);
        if (more) { A2_DMAK(); A2_DMAV(0); A2_DMAV(1); }
        if (t + 2 < NT) A2_BAR(3); else A2_BAR(0);
        buf = buf == 2 ? 0 : buf + 1;
    }
    if (hi == 0) Ll[r32] = l_reg;
    asm volatile("s_waitcnt lgkmcnt(0)" ::: "memory");
    int tid2 = threadIdx.x; asm volatile("" : "+v"(tid2));
    const int e32 = tid2 & 31, ehi = (tid2 >> 5) & 1;
    float f[16];
#pragma unroll
    for (int r = 0; r < 16; ++r) f[r] = vinv * __builtin_amdgcn_rcpf((Ll + 4 * ehi)[(r & 3) + 8 * (r >> 2)]);
    {
        char* ob = (char*)(Og + (size_t)(qlo + 4 * ehi) * 256 + e32);
#pragma unroll
        for (int d0 = 0; d0 < 8; ++d0)
#pragma unroll
            for (int r = 0; r < 16; ++r) { const int rc = (r & 3) + 8 * (r >> 2); const float v = o[d0][r] * f[r], vn = __shfl_xor(v, 1);
                if ((e32 & 1) == 0) *(unsigned*)(ob + (rc * 256 + 32 * d0) * 2) = cvtpk(v, vn); }
    }
    __syncthreads();
#undef A2_DMA
#undef A2_DMAK
#undef A2_DMAV
#undef A2_BAR
}
#undef A2_TRRD
#undef A2_PK4
}

constexpr int S_ = 16384, DM = 2048, NIN = 5120, AW = 1024, RW = 1024, NMEM = 256, NE = 32, TOPK = 4, DFF = 2048;
constexpr int NWAVES = 8, NTHREADS = 512;
constexpr float EPS_ = 1e-6f, DA_EPS_ = 1e-5f, LAMBDA_INIT = 0.2f;
constexpr int MPAD_TILES = 288;
#ifndef MK_N_LAUNCHES
#define MK_N_LAUNCHES 1
#endif
constexpr int N_PHASES = 16;
#ifndef MK_NCV
#define MK_NCV 0
#endif
constexpr int NCV = MK_NCV;

constexpr size_t MiB = 1u << 20;
constexpr size_t WS_CTL = 0, CTL_ZERO_BYTES = 1 * MiB;
constexpr size_t WS_SMALL = 1 * MiB;
constexpr size_t WS_LPART = WS_SMALL + 0 * MiB;
constexpr size_t WS_ACH = WS_SMALL + 1 * MiB;
constexpr size_t WS_HCH = WS_SMALL + 2 * MiB;
constexpr size_t WS_CARRY = WS_SMALL + 3 * MiB;
constexpr size_t WS_TOPE = WS_SMALL + 4 * MiB;
constexpr size_t WS_TOPG = WS_TOPE + 256 * 1024;
constexpr size_t WS_POSOF = WS_TOPG + 256 * 1024;
constexpr size_t WS_TCNT = WS_POSOF + 256 * 1024;
constexpr size_t WS_ROWGATE = WS_SMALL + 5 * MiB;
constexpr size_t WS_TILEEXP = WS_ROWGATE + 512 * 1024;
constexpr size_t WS_NRT = WS_TILEEXP + 4096;
constexpr size_t WS_WRGT = WS_SMALL + 6 * MiB;
constexpr size_t WS_MEMN = WS_SMALL + 7 * MiB;
constexpr size_t WS_KM = WS_SMALL + 8 * MiB;
constexpr size_t WS_VT = WS_SMALL + 9 * MiB;
constexpr size_t WS_SBGU = WS_SMALL + 10 * MiB;
constexpr size_t WS_SBDN = WS_SMALL + 10 * MiB + 512 * 1024;
constexpr size_t WS_SBIN = WS_SMALL + 16 * MiB;
constexpr size_t WS_SBOUT = WS_SMALL + 18 * MiB;
constexpr size_t WS_MIXSCALE = WS_SMALL + 19 * MiB;
constexpr size_t WS_SBCQ = WS_SMALL + 20 * MiB, WS_SBCO = WS_SMALL + 21 * MiB;
constexpr size_t WS_SRCTOK = WS_SMALL + 23 * MiB;
constexpr size_t WS_INSCALE = WS_SMALL + 17 * MiB;
constexpr size_t WS_ROWSCALE = WS_SMALL + 11 * MiB;
constexpr size_t WS_TOKSCALE = WS_SMALL + 12 * MiB;
constexpr size_t WS_SSQ = WS_SMALL + 13 * MiB;
constexpr size_t WS_WIN = 32 * MiB, WS_WOUT = 52 * MiB, WS_WCQ = 60 * MiB, WS_WCKV = 68 * MiB, WS_WCO = 84 * MiB;
constexpr size_t WS_WGU = 128 * MiB, WS_WDN = 640 * MiB;
constexpr size_t WS_XN = 896 * MiB;
constexpr size_t WS_Q = 960 * MiB, WS_K = 992 * MiB, WS_V = 1024 * MiB;
constexpr size_t WS_XR = 1056 * MiB, WS_XG = 1088 * MiB;
constexpr size_t WS_AO = 1120 * MiB;
constexpr size_t WS_HL = 1184 * MiB, WS_ACUM = 1248 * MiB;
constexpr size_t WS_MIX = 1312 * MiB;
constexpr size_t WS_H = 1376 * MiB;
constexpr size_t WS_QC = 1504 * MiB;
constexpr size_t WS_PC = 1568 * MiB;
constexpr size_t WS_OC = 1600 * MiB;
constexpr size_t WS_XS = 1664 * MiB, WS_ACT = 1952 * MiB, WS_YB = 2240 * MiB;
constexpr float ACT_QSCALE = 16.0f / 127.0f;
constexpr size_t WS_END = 2528 * MiB;
constexpr int CW_VMAX = 12288;
constexpr int CW_BAR = 4096;

constexpr int SCR_BYTES = 159744;
constexpr int MISC_OFF = SCR_BYTES;
constexpr int LDS_BYTES = 163840;

#define GAS __attribute__((address_space(1)))
#define LAS __attribute__((address_space(3)))
typedef unsigned short bf16_t;
typedef unsigned u32x4 __attribute__((ext_vector_type(4)));
typedef unsigned u32x2 __attribute__((ext_vector_type(2)));
typedef float f32x4 __attribute__((ext_vector_type(4)));
typedef short bf16x8 __attribute__((ext_vector_type(8)));
#define LDS_WAIT() asm volatile("s_waitcnt lgkmcnt(0)" ::: "memory")
#define VM_WAIT() asm volatile("s_waitcnt vmcnt(0)" ::: "memory")
__device__ __forceinline__ unsigned pk2(float lo, float hi) { return pg8::cvt_pk_bf16(lo, hi); }
__device__ __forceinline__ float bflo(unsigned w) { return __uint_as_float(w << 16); }
__device__ __forceinline__ float bfhi(unsigned w) { return __uint_as_float(w & 0xffff0000u); }
__device__ __forceinline__ f32x4 ld_bf16x4(const bf16_t* p) { const u32x2 w = *(const u32x2*)p; return (f32x4){bflo(w.x), bfhi(w.x), bflo(w.y), bfhi(w.y)}; }
__device__ __forceinline__ void st_bf16x4(bf16_t* p, f32x4 v) { u32x2 w; w.x = pk2(v[0], v[1]); w.y = pk2(v[2], v[3]); *(u32x2*)p = w; }
__device__ __forceinline__ float bf1(bf16_t h) { return __uint_as_float((unsigned)h << 16); }

#define XB_TMO      128
#define XB_XCNT(j)  (256  + 64 * (j))
#define XB_XSUB(j)  (1280 + 64 * (j))
#define XB_XGEN(j)  (2304 + 64 * (j))
#define XB_TOP      3328
#define XB_TOPGEN   3392
#define XCD_BAR_WORDS 3456
#define XB_SPIN_CAP (1u << 18)

__device__ __forceinline__ unsigned xb_ld(unsigned* p)              { return __hip_atomic_load(p, __ATOMIC_RELAXED, __HIP_MEMORY_SCOPE_AGENT); }
__device__ __forceinline__ unsigned xb_add(unsigned* p, unsigned v) { return __hip_atomic_fetch_add(p, v, __ATOMIC_RELAXED, __HIP_MEMORY_SCOPE_AGENT); }
__device__ __forceinline__ unsigned xb_xcc_id() { return (unsigned)__builtin_amdgcn_s_getreg((3 << 11) | 20) & 0xFu; }
#define XB_SPIN(cond, bar) do { unsigned _sp = 0; while (cond) { __builtin_amdgcn_s_sleep(1); \
    if ((++_sp & 255u) == 0u) { if (xb_ld(&(bar)[XB_TMO])) break; if (_sp > XB_SPIN_CAP) { atomicAdd(&(bar)[XB_TMO], 1u); break; } } } } while (0)

struct XcdBarrier {
    unsigned* bar; unsigned x;
    volatile LAS unsigned* st;
};
__device__ __forceinline__ XcdBarrier xcd_barrier_post(unsigned* bar, volatile LAS unsigned* st) {
    XcdBarrier b; b.bar = bar; b.x = xb_xcc_id(); b.st = st;
    if (threadIdx.x == 0) (void)xb_add(&bar[XB_XCNT(b.x)], 1u);
    return b;
}
__device__ __forceinline__ void xcd_barrier_complete(unsigned* bar, unsigned x, unsigned& nloc, unsigned& nx) {
    const unsigned G = gridDim.x * gridDim.y * gridDim.z;
    unsigned sum, cnt, mine, sp = 0u;
    for (;;) {
        sum = 0u; cnt = 0u; mine = 0u;
#pragma unroll
        for (unsigned j = 0; j < 16; ++j) { const unsigned c = xb_ld(&bar[XB_XCNT(j)]); sum += c; cnt += (c > 0u) ? 1u : 0u; mine = (j == x) ? c : mine; }
        if (sum == G) break;
        __builtin_amdgcn_s_sleep(1);
        if ((++sp & 255u) == 0u) { if (xb_ld(&bar[XB_TMO])) break; if (sp > XB_SPIN_CAP) { atomicAdd(&bar[XB_TMO], 1u); break; } }
    }
    nloc = mine > 0u ? mine : 1u; nx = cnt > 0u ? cnt : 1u;
}
__device__ __forceinline__ void xcd_barrier(const XcdBarrier& b) {
    asm volatile("s_waitcnt vmcnt(0)" ::: "memory");
    __syncthreads();
    if (threadIdx.x == 0) {
        unsigned* bar = b.bar;
        __builtin_amdgcn_s_waitcnt(0);
        unsigned nloc = b.st[0], nx = b.st[1];
        if (nloc == 0u) { xcd_barrier_complete(bar, b.x, nloc, nx); b.st[0] = nloc; b.st[1] = nx; }
        const unsigned old = xb_add(&bar[XB_XSUB(b.x)], 1u);
        const unsigned gen = old / nloc;
        if (old + 1u == (gen + 1u) * nloc) {
            __builtin_amdgcn_fence(__ATOMIC_RELEASE, "agent");
            asm volatile("s_waitcnt vmcnt(0)" ::: "memory");
            const unsigned og = xb_add(&bar[XB_TOP], 1u);
            const unsigned tg = og / nx;
            if (og + 1u == (tg + 1u) * nx) xb_add(&bar[XB_TOPGEN], 1u);
            else XB_SPIN(xb_ld(&bar[XB_TOPGEN]) == tg, bar);
            __builtin_amdgcn_fence(__ATOMIC_ACQUIRE, "agent");
            xb_add(&bar[XB_XGEN(b.x)], 1u);
            asm volatile("s_waitcnt vmcnt(0)" ::: "memory");
        } else {
            XB_SPIN(xb_ld(&bar[XB_XGEN(b.x)]) == gen, bar);
            __builtin_amdgcn_fence(__ATOMIC_ACQUIRE, "agent");
            asm volatile("s_waitcnt vmcnt(0)" ::: "memory");
        }
    }
    __syncthreads();
}

__device__ __forceinline__ float wave_sum(float v) {
#pragma unroll
    for (int o = 1; o < 64; o <<= 1) v += __shfl_xor(v, o);
    return v;
}
__device__ __forceinline__ float sigmoidf_(float x) { return __builtin_amdgcn_rcpf(1.0f + __builtin_amdgcn_exp2f(-1.4426950408889634f * x)); }
__device__ __forceinline__ float gelu_tanh(float x) { const float u = 0.7978845608028654f * (x + 0.044715f * x * x * x); return 0.5f * x * (1.0f + tanhf(u)); }

__device__ __forceinline__ void p0_transpose_item(const float* W, int K, int N, bf16_t* WT, int k0, int n0, int drow0, LAS float* scr, int lane, const float* kscale = nullptr) {
#pragma unroll 8
    for (int i = 0; i < 32; ++i) { const int kk = 2 * i + (lane >> 5); float wv = W[(size_t)(k0 + kk) * N + n0 + (lane & 31)]; if (kscale) wv *= kscale[k0 + kk]; scr[kk * 33 + (lane & 31)] = wv; }
    LDS_WAIT(); asm volatile("" ::: "memory");
    const int c = lane & 7;
#pragma unroll
    for (int j = 0; j < 4; ++j) { const int n = (lane >> 3) + 8 * j; const LAS float* s = scr + (8 * c) * 33 + n;
        u32x4 o; o.x = pk2(s[0 * 33], s[1 * 33]); o.y = pk2(s[2 * 33], s[3 * 33]); o.z = pk2(s[4 * 33], s[5 * 33]); o.w = pk2(s[6 * 33], s[7 * 33]);
        *(u32x4*)(WT + (size_t)(drow0 + n) * K + k0 + 8 * c) = o; }
    LDS_WAIT(); asm volatile("" ::: "memory");
}
__device__ __forceinline__ void rms_row_bf16(const float* xrow, const float* g, bf16_t* orow, int lane) {
    const f32x4* xr = (const f32x4*)xrow + lane; const f32x4* gr = (const f32x4*)g + lane;
    f32x4 v[8]; float s = 0.f;
#pragma unroll
    for (int j = 0; j < 8; ++j) { v[j] = xr[64 * j]; s += (v[j].x * v[j].x + v[j].y * v[j].y) + (v[j].z * v[j].z + v[j].w * v[j].w); }
    const float r = rsqrtf(wave_sum(s) * (1.f / 2048.f) + EPS_);
    u32x2* o8 = (u32x2*)orow + lane;
#pragma unroll
    for (int j = 0; j < 8; ++j) { const f32x4 gg = gr[64 * j]; u32x2 o; o.x = pk2(v[j].x * r * gg.x, v[j].y * r * gg.y); o.y = pk2(v[j].z * r * gg.z, v[j].w * r * gg.w); o8[64 * j] = o; }
}

__device__ __forceinline__ void rms_row_i8(f32x4 (&v)[8], const float* g, signed char* orow, float* scale_out, int lane) {
    const f32x4* gr = (const f32x4*)g + lane;
    float s = 0.f;
#pragma unroll
    for (int j = 0; j < 8; ++j) s += (v[j].x * v[j].x + v[j].y * v[j].y) + (v[j].z * v[j].z + v[j].w * v[j].w);
    const float r = rsqrtf(wave_sum(s) * (1.f / 2048.f) + 1e-6f);
    float am = 0.f;
#pragma unroll
    for (int j = 0; j < 8; ++j) { const f32x4 gg = gr[64 * j]; v[j].x *= r * gg.x; v[j].y *= r * gg.y; v[j].z *= r * gg.z; v[j].w *= r * gg.w;
        am = fmaxf(fmaxf(am, fmaxf(fabsf(v[j].x), fabsf(v[j].y))), fmaxf(fabsf(v[j].z), fabsf(v[j].w))); }
#pragma unroll
    for (int o = 32; o > 0; o >>= 1) am = fmaxf(am, __shfl_xor(am, o));
    const float inv = am > 0.f ? 127.0f / am : 0.f;
    unsigned* o4 = (unsigned*)orow + lane;
#pragma unroll
    for (int j = 0; j < 8; ++j) {
        const unsigned f0 = __float_as_uint(fmaf(v[j].x, inv, 12582912.0f)), f1 = __float_as_uint(fmaf(v[j].y, inv, 12582912.0f)), f2 = __float_as_uint(fmaf(v[j].z, inv, 12582912.0f)), f3 = __float_as_uint(fmaf(v[j].w, inv, 12582912.0f));
        o4[64 * j] = __builtin_amdgcn_perm(__builtin_amdgcn_perm(f3, f2, 0x0c0c0400u), __builtin_amdgcn_perm(f1, f0, 0x0c0c0400u), 0x05040100u); }
    if (lane == 0) *scale_out = am > 0.f ? am * (1.0f / 127.0f) : 1.0f;
}

struct Args { const float* in[31]; float* out; unsigned char* ws; int ph_lo, ph_hi; };
typedef const __attribute__((address_space(4))) Args CArgs;
__device__ __forceinline__ CArgs* kargs() { CArgs* p = (CArgs*)__builtin_amdgcn_kernarg_segment_ptr(); asm volatile("" : "+s"(p)); return p; }
__device__ __forceinline__ int lane_id() { int t = threadIdx.x; asm volatile("" : "+v"(t)); return t & 63; }
__device__ __forceinline__ int wave_id() { return __builtin_amdgcn_readfirstlane(threadIdx.x >> 6); }
enum { I_X = 0, I_MEM, I_NORM_MIX_G, I_W_IN, I_CONV_W, I_CONV_B, I_W_RG_A, I_B_RG_A, I_W_RG_X, I_B_RG_X, I_RG_LAMBDA, I_REC_NORM_G, I_LQ1, I_LK1, I_LQ2, I_LK2, I_SUBLN_G, I_W_OUT,
       I_NORM_CROSS_G, I_NORM_MEM_G, I_W_CQ, I_W_CKV, I_W_CO, I_NORM_FFN_G, I_W_ROUTER, I_B_ROUTER, I_W_GU, I_B_GU, I_W_DN, I_B_DN, I_NORM_FINAL_G };

__device__ __forceinline__ void convert_expert_strips(unsigned char* ws, LAS unsigned char* lds, int first, int stride, int end = 6144) {
    asm volatile("" : "+s"(first), "+s"(stride), "+s"(end));
    CArgs& a = *kargs(); const int wave = wave_id(), lane = lane_id();
    LAS float* CM = (LAS float*)(lds + 8 * 16384);
    const int cg = lane & 7, kl = lane >> 3, kbase = 256 * wave + 32 * kl;
    constexpr int NST_GU = 32 * 128, NST_DN = 32 * 64, NST = NST_GU + NST_DN;
    const float* wgu = a.in[I_W_GU]; const float* wdn = a.in[I_W_DN];
    unsigned H[4][16];
    f32x4 v[32];
#define CS_DECODE(st) const bool g_ = (st) < NST_GU; const int s2_ = g_ ? (st) : (st) - NST_GU; const int e_ = g_ ? (s2_ >> 7) : (s2_ >> 6), nb_ = g_ ? (s2_ & 127) : (s2_ & 63), n0_ = 32 * nb_, N_ = g_ ? 4096 : 2048
#define CS_LOAD(st) do { CS_DECODE(st); const float* p_ = (g_ ? wgu : wdn) + ((size_t)e_ * 2048 + kbase) * N_ + n0_ + 4 * cg;                                       \
        _Pragma("unroll") for (int i = 0; i < 32; ++i) v[i] = *(const f32x4*)(p_ + (size_t)i * N_); } while (0)
#define CS_PACK(par) do { f32x4 m_ = {0.f, 0.f, 0.f, 0.f};                                                                                                             \
        _Pragma("unroll") for (int i = 0; i < 32; ++i) { m_[0] = fmaxf(m_[0], fabsf(v[i][0])); m_[1] = fmaxf(m_[1], fabsf(v[i][1])); m_[2] = fmaxf(m_[2], fabsf(v[i][2])); m_[3] = fmaxf(m_[3], fabsf(v[i][3])); } \
        _Pragma("unroll") for (int c = 0; c < 4; ++c) { m_[c] = fmaxf(m_[c], __shfl_xor(m_[c], 8)); m_[c] = fmaxf(m_[c], __shfl_xor(m_[c], 16)); m_[c] = fmaxf(m_[c], __shfl_xor(m_[c], 32)); } \
        if (kl == 0) *(LAS f32x4*)(CM + (par) * 256 + wave * 32 + 4 * cg) = m_;                                                                                       \
        _Pragma("unroll") for (int c = 0; c < 4; ++c) _Pragma("unroll") for (int i = 0; i < 16; ++i) H[c][i] = pk2(v[2 * i][c], v[2 * i + 1][c]); } while (0)
#define CS_STORE(st, par) do { CS_DECODE(st); (void)n0_;                                                                                                              \
        const int j_ = n0_ & 2047, up_ = n0_ >> 11, drow0_ = (g_ ? 256 * (j_ >> 7) + 128 * up_ + (j_ & 127) : n0_) + 4 * cg;                                       \
        signed char* W8_ = (signed char*)(ws + (g_ ? WS_WGU : WS_WDN)); float* SB_ = (float*)(ws + (g_ ? WS_SBGU : WS_SBDN));                                        \
        f32x4 cm_ = *(const LAS f32x4*)(CM + (par) * 256 + 4 * cg);                                                                                                   \
        _Pragma("unroll") for (int w = 1; w < 8; ++w) { const f32x4 o_ = *(const LAS f32x4*)(CM + (par) * 256 + w * 32 + 4 * cg); cm_[0] = fmaxf(cm_[0], o_[0]); cm_[1] = fmaxf(cm_[1], o_[1]); cm_[2] = fmaxf(cm_[2], o_[2]); cm_[3] = fmaxf(cm_[3], o_[3]); } \
        _Pragma("unroll") for (int c = 0; c < 4; ++c) { const float inv_ = cm_[c] > 0.f ? 127.0f / cm_[c] : 0.f;                                                         \
            u32x4* dst_ = (u32x4*)(W8_ + ((size_t)e_ * N_ + drow0_ + c) * 2048 + kbase);                                                                              \
            _Pragma("unroll") for (int q = 0; q < 2; ++q) { u32x4 o_;                                                                                                 \
                _Pragma("unroll") for (int d = 0; d < 4; ++d) { const unsigned h0_ = H[c][8 * q + 2 * d], h1_ = H[c][8 * q + 2 * d + 1];                                \
                    const unsigned f0_ = __float_as_uint(fmaf(bflo(h0_), inv_, 12582912.0f)), f1_ = __float_as_uint(fmaf(bfhi(h0_), inv_, 12582912.0f));                \
                    const unsigned f2_ = __float_as_uint(fmaf(bflo(h1_), inv_, 12582912.0f)), f3_ = __float_as_uint(fmaf(bfhi(h1_), inv_, 12582912.0f));                \
                    o_[d] = __builtin_amdgcn_perm(__builtin_amdgcn_perm(f3_, f2_, 0x0c0c0400u), __builtin_amdgcn_perm(f1_, f0_, 0x0c0c0400u), 0x05040100u); }           \
                dst_[q] = o_; }                                                                                                                                       \
            if (wave == 0 && kl == 0) SB_[(size_t)e_ * N_ + drow0_ + c] = cm_[c] > 0.f ? cm_[c] * (1.0f / 127.0f) : 1.0f; } } while (0)
    if (end > NST) end = NST;
    int st = first, par = 0;
    if (st < end) { CS_LOAD(st); CS_PACK(0); }
    while (st < end) {
        const int sn = st + stride;
        if (sn < end) CS_LOAD(sn);
        __builtin_amdgcn_sched_barrier(0);
        __syncthreads();
        CS_STORE(st, par);
        __builtin_amdgcn_sched_barrier(0);
        if (sn < end) CS_PACK(par ^ 1);
        st = sn; par ^= 1;
    }
    __syncthreads();
#undef CS_DECODE
#undef CS_LOAD
#undef CS_PACK
#undef CS_STORE
}

template <bool F8 = false>
__device__ __forceinline__ void convert_strips_i8(const float* win, int N, signed char* dst8, float* sbo, LAS unsigned char* lds, int first, int stride, const float* kscale = nullptr, int end = 1 << 30) {
    const int wave = wave_id(), lane = lane_id();
    LAS float* CM = (LAS float*)(lds + 8 * 16384);
    const int cg = lane & 7, kl = lane >> 3, kbase = 256 * wave + 32 * kl;
    if (end > N / 32) end = N / 32;
    for (int st = first; st < end; st += stride) {
        const int n0 = 32 * st; const float* p_ = win + (size_t)kbase * N + n0 + 4 * cg;
        f32x4 v[32]; f32x4 m_ = {0.f, 0.f, 0.f, 0.f};
#pragma unroll
        for (int i = 0; i < 32; ++i) v[i] = *(const f32x4*)(p_ + (size_t)i * N);
        if (kscale) {
#pragma unroll
            for (int i = 0; i < 32; ++i) v[i] *= kscale[kbase + i]; }
#pragma unroll
        for (int i = 0; i < 32; ++i) { m_[0] = fmaxf(m_[0], fabsf(v[i][0])); m_[1] = fmaxf(m_[1], fabsf(v[i][1])); m_[2] = fmaxf(m_[2], fabsf(v[i][2])); m_[3] = fmaxf(m_[3], fabsf(v[i][3])); }
#pragma unroll
        for (int c = 0; c < 4; ++c) { m_[c] = fmaxf(m_[c], __shfl_xor(m_[c], 8)); m_[c] = fmaxf(m_[c], __shfl_xor(m_[c], 16)); m_[c] = fmaxf(m_[c], __shfl_xor(m_[c], 32)); }
        if (kl == 0) *(LAS f32x4*)(CM + wave * 32 + 4 * cg) = m_;
        __syncthreads();
        f32x4 cm_ = *(const LAS f32x4*)(CM + 4 * cg);
#pragma unroll
        for (int w = 1; w < 8; ++w) { const f32x4 o_ = *(const LAS f32x4*)(CM + w * 32 + 4 * cg); cm_[0] = fmaxf(cm_[0], o_[0]); cm_[1] = fmaxf(cm_[1], o_[1]); cm_[2] = fmaxf(cm_[2], o_[2]); cm_[3] = fmaxf(cm_[3], o_[3]); }
#pragma unroll
        for (int c = 0; c < 4; ++c) { constexpr float QMAX = F8 ? 240.0f : 127.0f; const float inv_ = cm_[c] > 0.f ? QMAX / cm_[c] : 0.f;
            u32x4* dst_ = (u32x4*)(dst8 + (size_t)(n0 + 4 * cg + c) * 2048 + kbase);
#pragma unroll
            for (int q = 0; q < 2; ++q) { u32x4 o_;
#pragma unroll
                for (int d = 0; d < 4; ++d) { const int i0 = 16 * q + 4 * d;
                    if constexpr (F8) { unsigned w_ = 0; w_ = __builtin_amdgcn_cvt_pk_fp8_f32(v[i0][c] * inv_, v[i0 + 1][c] * inv_, w_, false); w_ = __builtin_amdgcn_cvt_pk_fp8_f32(v[i0 + 2][c] * inv_, v[i0 + 3][c] * inv_, w_, true); o_[d] = w_; continue; }
                    const unsigned f0_ = __float_as_uint(fmaf(v[i0][c], inv_, 12582912.0f)), f1_ = __float_as_uint(fmaf(v[i0 + 1][c], inv_, 12582912.0f));
                    const unsigned f2_ = __float_as_uint(fmaf(v[i0 + 2][c], inv_, 12582912.0f)), f3_ = __float_as_uint(fmaf(v[i0 + 3][c], inv_, 12582912.0f));
                    o_[d] = __builtin_amdgcn_perm(__builtin_amdgcn_perm(f3_, f2_, 0x0c0c0400u), __builtin_amdgcn_perm(f1_, f0_, 0x0c0c0400u), 0x05040100u); }
                dst_[q] = o_; }
            if (wave == 0 && kl == 0) sbo[n0 + 4 * cg + c] = cm_[c] > 0.f ? cm_[c] * (1.0f / QMAX) : 1.0f; }
        __syncthreads();
    }
}

__device__ __forceinline__ void convert_late_weights(unsigned char* ws, LAS unsigned char* lds, int G);
__device__ __forceinline__ void p0_prologue(unsigned char* ws, LAS unsigned char* lds, int G) {
    CArgs& a = *kargs(); const int wave = wave_id(), lane = lane_id();
    LAS float* scr = (LAS float*)(lds + wave * 16384);
    const int gw = blockIdx.x * NWAVES + wave, NGW = G * NWAVES;
    constexpr int I_IN = 32 * 160, I_SQ = 32 * 64, I_KV = 32 * 128, I_GU = 32 * 32 * 128, I_DN = 32 * 32 * 64, I_RG = 128;
    constexpr int NITEMS = I_IN + 3 * I_SQ + I_KV + I_GU + I_DN + I_RG;
    const bool late_here = (G != 256);
    if (late_here) convert_expert_strips(ws, lds, blockIdx.x, G);
    if (late_here) convert_late_weights(ws, lds, G);
    convert_strips_i8(a.in[I_W_IN], 5120, (signed char*)(ws + WS_WIN), (float*)(ws + WS_SBIN), lds, blockIdx.x, G);
    for (int it = gw + I_GU + I_DN; it < NITEMS; it += NGW) {
        int r = it - I_GU - I_DN;
        if (r < I_IN) continue; r -= I_IN;
        if (r < I_SQ) continue; r -= I_SQ;
        if (r < I_SQ) continue; r -= I_SQ;
        if (r < I_KV) { const int kb = r >> 7, nb = r & 127; p0_transpose_item(a.in[I_W_CKV], 2048, 4096, (bf16_t*)(ws + WS_WCKV), 64 * kb, 32 * nb, 32 * nb, scr, lane); continue; } r -= I_KV;
        if (r < I_SQ) continue; r -= I_SQ;
        { const int mat = r >> 6, n = (r >> 3) & 7, sub = r & 7, kb = sub >> 2, nb = sub & 3;
          p0_transpose_item((mat ? a.in[I_W_RG_X] : a.in[I_W_RG_A]) + n * 16384, 128, 128, (bf16_t*)(ws + WS_WRGT) + (mat * 8 + n) * 16384, 64 * kb, 32 * nb, 32 * nb, scr, lane); }
    }
    for (int m = gw; m < S_; m += 2 * NGW) { const int m1 = m + NGW; const bool two = m1 < S_;
        f32x4 va[8], vb[8]; const f32x4* xa = (const f32x4*)(a.in[I_X] + (size_t)m * DM) + lane; const f32x4* xb = (const f32x4*)(a.in[I_X] + (size_t)(two ? m1 : m) * DM) + lane;
#pragma unroll
        for (int j = 0; j < 8; ++j) { va[j] = xa[64 * j]; vb[j] = xb[64 * j]; }
        rms_row_i8(va, a.in[I_NORM_MIX_G], (signed char*)(ws + WS_XN) + (size_t)m * DM, (float*)(ws + WS_INSCALE) + m, lane);
        if (two) rms_row_i8(vb, a.in[I_NORM_MIX_G], (signed char*)(ws + WS_XN) + (size_t)m1 * DM, (float*)(ws + WS_INSCALE) + m1, lane); }
    for (int m = gw; m < NMEM; m += NGW) rms_row_bf16(a.in[I_MEM] + (size_t)m * DM, a.in[I_NORM_MEM_G], (bf16_t*)(ws + WS_MEMN) + (size_t)m * DM, lane);
}

__device__ __forceinline__ void store_bf16_tile(const f32x4 (&acc)[2][2][4][2], bf16_t* b0, bf16_t* b1, size_t pitch, float sc, int wr, int wc, int fr, int fq, float sc0 = 1.f) {
    const int r0 = wr * 64 + fr, cc = wc * 32 + 8 * fq;
#pragma unroll
    for (int ai = 0; ai < 2; ++ai)
#pragma unroll
        for (int m = 0; m < 4; ++m) { const size_t ro = (size_t)(r0 + ai * 128 + m * 16) * pitch + cc;
#pragma unroll
            for (int bj = 0; bj < 2; ++bj) { const float sb = bj ? sc : sc * sc0; const f32x4 v0 = acc[ai][bj][m][0] * sb, v1 = acc[ai][bj][m][1] * sb;
                u32x4 w; w.x = pk2(v0[0], v0[1]); w.y = pk2(v0[2], v0[3]); w.z = pk2(v1[0], v1[1]); w.w = pk2(v1[2], v1[3]);
                *(u32x4*)((bj ? b1 : b0) + ro) = w; } }
}
struct EpiInProj {
    static constexpr bool PERM = true;
    bf16_t *Q, *XR; unsigned* vmax;
    __device__ __forceinline__ void operator()(const f32x4 (&acc)[2][2][4][2], const pg8::Unit& u, int wr, int wc, int fr, int fq) const {
        const int pn = u.pn; bf16_t *b0, *b1; size_t pitch;
        if (pn < 12) {
            float m = 0.f;
#pragma unroll
            for (int ai = 0; ai < 2; ++ai)
#pragma unroll
                for (int bj = 0; bj < 2; ++bj)
#pragma unroll
                    for (int mm = 0; mm < 4; ++mm)
#pragma unroll
                        for (int n = 0; n < 2; ++n) { if (bj == 0 && pn < 8) continue; const f32x4 v = acc[ai][bj][mm][n]; m = fmaxf(fmaxf(m, fmaxf(fabsf(v[0]), fabsf(v[1]))), fmaxf(fabsf(v[2]), fabsf(v[3]))); }
#pragma unroll
            for (int o = 32; o > 0; o >>= 1) m = fmaxf(m, __shfl_xor(m, o));
            if ((threadIdx.x & 63) == 0) atomicMax(vmax + (pn < 8 ? 4 + 4 * (pn >> 2) : 0) + (pn & 3), __float_as_uint(m * 1.00390625f));
        }
        if (pn < 8) { bf16_t* T = Q + (size_t)(pn >> 2) * ((WS_K - WS_Q) / 2); const int hh = pn & 3; pitch = 128;
            b0 = T + ((size_t)(hh * 2 + 0) * S_ + (size_t)u.pm * 256) * 128; b1 = T + ((size_t)(hh * 2 + 1) * S_ + (size_t)u.pm * 256) * 128; }
        else if (pn < 12) { bf16_t* T = Q + (size_t)2 * ((WS_K - WS_Q) / 2); const int hh = pn & 3; pitch = 256;
            b0 = T + ((size_t)hh * S_ + (size_t)u.pm * 256) * 256; b1 = b0 + 128; }
        else { bf16_t* T = XR + (size_t)((pn - 12) >> 2) * ((WS_XG - WS_XR) / 2) + (pn & 3) * 256; pitch = 1024; b0 = T + (size_t)u.pm * 256 * 1024; b1 = b0 + 128; }
        store_bf16_tile(acc, b0, b1, pitch, 1.f, wr, wc, fr, fq, pn < 4 ? 0.12751743f   : 1.f);
    }
};
struct EpiInProjI8 {
    static constexpr bool PERM = true;
    EpiInProj base; const float* rowscale; const float* colscale;
    __device__ __forceinline__ void operator()(const pg8::i32x4 (&acc)[2][2][4][2], const pg8::Unit& u, int wr, int wc, int fr, int fq) const {
        f32x4 f[2][2][4][2];
        const float* rs = rowscale + (size_t)u.pm * 256 + wr * 64 + fr; const float* cs = colscale + (size_t)u.pn * 256 + wc * 32 + 8 * fq;
        f32x4 c4[2][2];
#pragma unroll
        for (int bj = 0; bj < 2; ++bj)
#pragma unroll
            for (int n = 0; n < 2; ++n) c4[bj][n] = *(const f32x4*)(cs + 128 * bj + 4 * n);
#pragma unroll
        for (int ai = 0; ai < 2; ++ai)
#pragma unroll
            for (int m = 0; m < 4; ++m) { const float r = rs[ai * 128 + m * 16];
#pragma unroll
                for (int bj = 0; bj < 2; ++bj)
#pragma unroll
                    for (int n = 0; n < 2; ++n) { const pg8::i32x4 a = acc[ai][bj][m][n]; const f32x4 c = c4[bj][n];
                        f[ai][bj][m][n] = (f32x4){(float)a[0] * (r * c[0]), (float)a[1] * (r * c[1]), (float)a[2] * (r * c[2]), (float)a[3] * (r * c[3])}; } }
        base(f, u, wr, wc, fr, fq);
    }
};
struct EpiSmall {
    static constexpr bool PERM = true;
    bf16_t *KM, *VT;
    __device__ __forceinline__ void operator()(const f32x4 (&acc)[2][2][4][2], const pg8::Unit& u, int wr, int wc, int fr, int fq) const {
        if (u.e == 0) { bf16_t* b0 = KM + u.pn * 256; store_bf16_tile(acc, b0, b0 + 128, 2048, 1.f, wr, wc, fr, fq); }
        else { bf16_t* b0 = VT + (size_t)u.pm * 256 * 256; store_bf16_tile(acc, b0, b0 + 128, 256, 1.f, wr, wc, fr, fq); }
    }
};
struct SmallOrder {
    const char* memn; const char* wckv; int c;
    __device__ __forceinline__ bool next(int i, pg8::Unit& u) const {
        if (i > 0 || c >= 16) return false;
        const int idx = c & 7; u.e = c >> 3;
        if (u.e == 0) { u.pm = 0; u.pn = idx; u.A = memn; u.B = wckv + (size_t)idx * 256 * 2048 * 2; }
        else { u.pm = idx; u.pn = 0; u.A = wckv + (size_t)(2048 + idx * 256) * 2048 * 2; u.B = memn; }
        return true;
    }
};
struct EpiBf16Plain {
    static constexpr bool PERM = true;
    bf16_t* O; int ldc;
    __device__ __forceinline__ void operator()(const f32x4 (&acc)[2][2][4][2], const pg8::Unit& u, int wr, int wc, int fr, int fq) const {
        bf16_t* b0 = O + (size_t)u.pm * 256 * ldc + u.pn * 256; store_bf16_tile(acc, b0, b0 + 128, (size_t)ldc, 1.f, wr, wc, fr, fq);
    }
};
struct EpiResF32 {
    static constexpr bool PERM = false;
    const bf16_t* res; bf16_t* out; const float* cs; float mul;
    __device__ __forceinline__ void operator()(const f32x4 (&acc)[2][2][4][2], const pg8::Unit& u, int wr, int wc, int fr, int fq) const {
        const int row0 = u.pm * 256 + wr * 64 + fr, col0 = u.pn * 256 + wc * 32 + 4 * fq;
#pragma unroll
        for (int ai = 0; ai < 2; ++ai)
#pragma unroll
            for (int m = 0; m < 4; ++m) { const size_t ro = (size_t)(row0 + ai * 128 + m * 16) * DM + col0;
#pragma unroll
                for (int bj = 0; bj < 2; ++bj)
#pragma unroll
                    for (int n = 0; n < 2; ++n) { const size_t p = ro + bj * 128 + 16 * n; const f32x4 r = ld_bf16x4(res + p); const f32x4 c4 = *(const f32x4*)(cs + col0 + bj * 128 + 16 * n) * mul; st_bf16x4(out + p, r + acc[ai][bj][m][n] * c4); } }
    }
};
struct EpiResNormF32 {
    static constexpr bool PERM = false;
    const float* res; bf16_t* out; unsigned char* HB; float* SSQ;
    __device__ __forceinline__ void operator()(const f32x4 (&acc)[2][2][4][2], const pg8::Unit& u, int wr, int wc, int fr, int fq) const {
        const int row0 = u.pm * 256 + wr * 64 + fr, col0 = u.pn * 256 + wc * 32 + 4 * fq;
#pragma unroll
        for (int ai = 0; ai < 2; ++ai)
#pragma unroll
            for (int m = 0; m < 4; ++m) { const int row = row0 + ai * 128 + m * 16; const size_t ro = (size_t)row * DM + col0; float ss = 0.f;
#pragma unroll
                for (int bj = 0; bj < 2; ++bj)
#pragma unroll
                    for (int n = 0; n < 2; ++n) { const size_t p = ro + bj * 128 + 16 * n; const f32x4 v = *(const f32x4*)(res + p) + acc[ai][bj][m][n]; st_bf16x4(out + p, v);
                        { const f32x4 q = {__builtin_amdgcn_fmed3f(v[0], -448.f, 448.f), __builtin_amdgcn_fmed3f(v[1], -448.f, 448.f), __builtin_amdgcn_fmed3f(v[2], -448.f, 448.f), __builtin_amdgcn_fmed3f(v[3], -448.f, 448.f)};
                          unsigned hb = 0; hb = __builtin_amdgcn_cvt_pk_fp8_f32(q[0], q[1], hb, false); hb = __builtin_amdgcn_cvt_pk_fp8_f32(q[2], q[3], hb, true); *(unsigned*)(HB + p) = hb; } ss += (v[0] * v[0] + v[1] * v[1]) + (v[2] * v[2] + v[3] * v[3]); }
                ss += __shfl_xor(ss, 16); ss += __shfl_xor(ss, 32);
                if (fq == 0) SSQ[(size_t)row * 32 + u.pn * 4 + wc] = ss; }
    }
};
struct EpiResNormI8 {
    static constexpr bool PERM = false;
    EpiResNormF32 base; const float* rowscale; const float* colscale;
    __device__ __forceinline__ void operator()(const pg8::i32x4 (&acc)[2][2][4][2], const pg8::Unit& u, int wr, int wc, int fr, int fq) const {
        f32x4 f[2][2][4][2];
        const float* rs = rowscale + (size_t)u.pm * 256 + wr * 64 + fr; const float* cs = colscale + (size_t)u.pn * 256 + wc * 32 + 4 * fq;
        f32x4 c4[2][2];
#pragma unroll
        for (int bj = 0; bj < 2; ++bj)
#pragma unroll
            for (int n = 0; n < 2; ++n) c4[bj][n] = *(const f32x4*)(cs + 128 * bj + 16 * n);
#pragma unroll
        for (int ai = 0; ai < 2; ++ai)
#pragma unroll
            for (int m = 0; m < 4; ++m) { const float r = rs[ai * 128 + m * 16];
#pragma unroll
                for (int bj = 0; bj < 2; ++bj)
#pragma unroll
                    for (int n = 0; n < 2; ++n) { const pg8::i32x4 a = acc[ai][bj][m][n]; const f32x4 c = c4[bj][n];
                        f[ai][bj][m][n] = (f32x4){(float)a[0] * (r * c[0]), (float)a[1] * (r * c[1]), (float)a[2] * (r * c[2]), (float)a[3] * (r * c[3])}; } }
        base(f, u, wr, wc, fr, fq);
    }
};
struct EpiBf16RowScale {
    static constexpr bool PERM = true;
    bf16_t* O; int ldc; const LAS float* rl; const float* cs;
    __device__ __forceinline__ void operator()(const f32x4 (&acc)[2][2][4][2], const pg8::Unit& u, int wr, int wc, int fr, int fq) const {
        bf16_t* b0 = O + (size_t)u.pm * 256 * ldc + u.pn * 256; const int r0 = wr * 64 + fr, cc = wc * 32 + 8 * fq;
#pragma unroll
        for (int ai = 0; ai < 2; ++ai)
#pragma unroll
            for (int m = 0; m < 4; ++m) { const int r = r0 + ai * 128 + m * 16; const float sc = rl[u.e * 256 + r]; const size_t ro = (size_t)r * ldc + cc;
#pragma unroll
                for (int bj = 0; bj < 2; ++bj) { const f32x4 c0 = *(const f32x4*)(cs + u.pn * 256 + bj * 128 + cc), c1 = *(const f32x4*)(cs + u.pn * 256 + bj * 128 + cc + 4); const f32x4 v0 = acc[ai][bj][m][0] * sc * c0, v1 = acc[ai][bj][m][1] * sc * c1;
                    u32x4 w; w.x = pk2(v0[0], v0[1]); w.y = pk2(v0[2], v0[3]); w.z = pk2(v1[0], v1[1]); w.w = pk2(v1[2], v1[3]);
                    *(u32x4*)(b0 + ro + bj * 128) = w; } }
    }
};
struct HeadOrderS {
    const char* QC; const char* KM; int G, c;
    __device__ __forceinline__ bool next(int i, pg8::Unit& u) const {
        const int L = i * G + c; if (L >= 256) return false;
        u.e = L & 3; u.pm = L >> 2; u.pn = 0; u.A = QC + ((size_t)u.pm * 256 * 2048 + u.e * 512) * 2; u.B = KM + (size_t)u.e * 512 * 2; return true;
    }
};
struct EpiScore {
    static constexpr bool PERM = true;
    bf16_t* PC; float* LPART;
    __device__ __forceinline__ void operator()(const f32x4 (&acc)[2][2][4][2], const pg8::Unit& u, int wr, int wc, int fr, int fq) const {
        constexpr float C2 = 1.4426950408889634f * 0.044194173824159216f;
        const int r0 = u.pm * 256 + wr * 64 + fr, cc = u.e * 256 + wc * 32 + 8 * fq;
#pragma unroll
        for (int ai = 0; ai < 2; ++ai)
#pragma unroll
            for (int m = 0; m < 4; ++m) { const int row = r0 + ai * 128 + m * 16; float ps = 0.f;
#pragma unroll
                for (int bj = 0; bj < 2; ++bj) { f32x4 v0 = acc[ai][bj][m][0], v1 = acc[ai][bj][m][1];
#pragma unroll
                    for (int i = 0; i < 4; ++i) { v0[i] = __builtin_amdgcn_exp2f(v0[i] * C2); v1[i] = __builtin_amdgcn_exp2f(v1[i] * C2); }
                    u32x4 w; w.x = pk2(v0[0], v0[1]); w.y = pk2(v0[2], v0[3]); w.z = pk2(v1[0], v1[1]); w.w = pk2(v1[2], v1[3]);
                    ps += (bflo(w.x) + bfhi(w.x)) + (bflo(w.y) + bfhi(w.y)) + (bflo(w.z) + bfhi(w.z)) + (bflo(w.w) + bfhi(w.w));
                    *(u32x4*)(PC + (size_t)row * 1024 + cc + bj * 128) = w; }
                ps += __shfl_xor(ps, 16); ps += __shfl_xor(ps, 32);
                if (fq == 0) LPART[((size_t)row * 4 + u.e) * 4 + wc] = ps; }
    }
};
struct HeadOrderO {
    const char* PC; const char* VT; int G, c;
    __device__ __forceinline__ bool next(int i, pg8::Unit& u) const {
        int L = i * G + c; if (L >= 512) return false;
        if (G == 256) L = 8 * (c >> 2) + 4 * i + (c & 3);
        u.e = L & 3; u.pn = (L >> 2) & 1; u.pm = L >> 3; u.A = PC + ((size_t)u.pm * 256 * 1024 + u.e * 256) * 2; u.B = VT + ((size_t)(u.e * 512 + u.pn * 256) * 256) * 2; return true;
    }
};
struct EpiCrossO {
    static constexpr bool PERM = true;
    unsigned char* OC; const float* LPART;
    __device__ __forceinline__ void operator()(const f32x4 (&acc)[2][2][4][2], const pg8::Unit& u, int wr, int wc, int fr, int fq) const {
        const int r0 = u.pm * 256 + wr * 64 + fr, cc = u.e * 512 + u.pn * 256 + wc * 32 + 8 * fq;
#pragma unroll
        for (int ai = 0; ai < 2; ++ai)
#pragma unroll
            for (int m = 0; m < 4; ++m) { const int row = r0 + ai * 128 + m * 16; const f32x4 lp = *(const f32x4*)(LPART + ((size_t)row * 4 + u.e) * 4);
                const float inv = 16.0f * __builtin_amdgcn_rcpf((lp[0] + lp[1]) + (lp[2] + lp[3]));
#pragma unroll
                for (int bj = 0; bj < 2; ++bj) { f32x4 v0 = acc[ai][bj][m][0] * inv, v1 = acc[ai][bj][m][1] * inv;
#pragma unroll
                    for (int i = 0; i < 4; ++i) { v0[i] = __builtin_amdgcn_fmed3f(v0[i], -448.f, 448.f); v1[i] = __builtin_amdgcn_fmed3f(v1[i], -448.f, 448.f); }
                    u32x2 w; w.x = 0; w.y = 0;
                    w.x = __builtin_amdgcn_cvt_pk_fp8_f32(v0[0], v0[1], w.x, false); w.x = __builtin_amdgcn_cvt_pk_fp8_f32(v0[2], v0[3], w.x, true);
                    w.y = __builtin_amdgcn_cvt_pk_fp8_f32(v1[0], v1[1], w.y, false); w.y = __builtin_amdgcn_cvt_pk_fp8_f32(v1[2], v1[3], w.y, true);
                    *(u32x2*)(OC + (size_t)row * 2048 + cc + bj * 128) = w; } }
    }
};
struct GroupOrder {
    const char* A; const char* W; const int* texp; size_t wstride, tstride; int nrt, NT, G, c;
    __device__ __forceinline__ bool next(int i, pg8::Unit& u) const {
        const int L = i * G + c; if (L >= nrt * NT) return false;
        const int rt = L / NT; u.pm = rt; u.pn = L - rt * NT; u.e = texp[rt];
        u.A = A + (size_t)rt * tstride; u.B = W + (size_t)u.e * wstride + (size_t)u.pn * tstride; return true;
    }
};
struct GroupOrderG {
    const char* A; const char* W; const int* texp; const int* rows; size_t wstride, tstride; int nrt, NT, G, c;
    __device__ __forceinline__ bool next(int i, pg8::Unit& u) const {
        const int L = i * G + c; if (L >= nrt * NT) return false;
        const int rt = L / NT; u.pm = rt; u.pn = L - rt * NT; u.e = texp[rt];
        u.A = A; u.B = W + (size_t)u.e * wstride + (size_t)u.pn * tstride; return true;
    }
};
struct EpiGateUp {
    static constexpr bool PERM = true;
    bf16_t* ACT; const float* bgu;
    __device__ __forceinline__ void operator()(const f32x4 (&acc)[2][2][4][2], const pg8::Unit& u, int wr, int wc, int fr, int fq) const {
        const int r0 = u.pm * 256 + wr * 64 + fr, j0 = u.pn * 128 + wc * 32 + 8 * fq;
        const float* bg = bgu + (size_t)u.e * 4096 + j0; float g8[8], u8[8];
#pragma unroll
        for (int i = 0; i < 8; ++i) { g8[i] = bg[i]; u8[i] = bg[2048 + i]; }
#pragma unroll
        for (int ai = 0; ai < 2; ++ai)
#pragma unroll
            for (int m = 0; m < 4; ++m) { const int row = r0 + ai * 128 + m * 16; float o[8];
#pragma unroll
                for (int i = 0; i < 8; ++i) { float gt = acc[ai][0][m][i >> 2][i & 3] + g8[i], up = acc[ai][1][m][i >> 2][i & 3] + u8[i];
                    gt = fminf(gt, 7.0f); up = fminf(fmaxf(up, -7.0f), 7.0f);
                    o[i] = (up + 1.0f) * gt * sigmoidf_(1.702f * gt); }
                u32x4 w; w.x = pk2(o[0], o[1]); w.y = pk2(o[2], o[3]); w.z = pk2(o[4], o[5]); w.w = pk2(o[6], o[7]);
                *(u32x4*)(ACT + (size_t)row * 2048 + j0) = w; }
    }
};
struct EpiGateUpI8 {
    static constexpr bool PERM = true;
    signed char* ACT; const float* bgu; const float* rowscale; const float* sb;
    __device__ __forceinline__ void operator()(const pg8::i32x4 (&acc)[2][2][4][2], const pg8::Unit& u, int wr, int wc, int fr, int fq) const {
        const int r0 = u.pm * 256 + wr * 64 + fr, cw = wc * 32 + 8 * fq, j0 = u.pn * 128 + cw;
        const float* bg = bgu + (size_t)u.e * 4096 + j0; const float* sp = sb + (size_t)u.e * 4096 + u.pn * 256 + cw; float g8[8], u8[8], sg8[8], su8[8];
#pragma unroll
        for (int i = 0; i < 8; ++i) { g8[i] = bg[i]; u8[i] = bg[2048 + i]; sg8[i] = sp[i]; su8[i] = sp[128 + i]; }
#pragma unroll
        for (int ai = 0; ai < 2; ++ai)
#pragma unroll
            for (int m = 0; m < 4; ++m) { const int row = r0 + ai * 128 + m * 16; const float rs = rowscale[row]; float o[8];
#pragma unroll
                for (int i = 0; i < 8; ++i) { float gt = (float)acc[ai][0][m][i >> 2][i & 3] * (rs * sg8[i]) + g8[i], up = (float)acc[ai][1][m][i >> 2][i & 3] * (rs * su8[i]) + u8[i];
                    gt = fminf(gt, 7.0f); up = fminf(fmaxf(up, -7.0f), 7.0f);
                    o[i] = (up + 1.0f) * gt * sigmoidf_(1.702f * gt); }
                unsigned q[8];
#pragma unroll
                for (int i = 0; i < 8; ++i) q[i] = (unsigned)(int)rintf(fminf(fmaxf(o[i] * (1.0f / ACT_QSCALE), -127.0f), 127.0f)) & 0xffu;
                u32x2 w; w.x = q[0] | (q[1] << 8) | (q[2] << 16) | (q[3] << 24); w.y = q[4] | (q[5] << 8) | (q[6] << 16) | (q[7] << 24);
                *(u32x2*)(ACT + (size_t)row * 2048 + j0) = w; }
    }
};
constexpr float YB_SCALE = 32.0f;
struct EpiDown {
    static constexpr bool PERM = true;
    unsigned char* YB; const float* bdn; const float* rowgate; const float* sb;
    __device__ __forceinline__ void operator()(const pg8::i32x4 (&acc)[2][2][4][2], const pg8::Unit& u, int wr, int wc, int fr, int fq) const {
        const int r0 = u.pm * 256 + wr * 64 + fr, c0 = u.pn * 256 + wc * 32 + 8 * fq;
        float b8[2][8], s8[2][8];
#pragma unroll
        for (int bj = 0; bj < 2; ++bj)
#pragma unroll
            for (int i = 0; i < 8; ++i) { b8[bj][i] = bdn[(size_t)u.e * 2048 + c0 + bj * 128 + i] * YB_SCALE; s8[bj][i] = sb[(size_t)u.e * 2048 + c0 + bj * 128 + i] * (ACT_QSCALE * YB_SCALE); }
#pragma unroll
        for (int ai = 0; ai < 2; ++ai)
#pragma unroll
            for (int m = 0; m < 4; ++m) { const int row = r0 + ai * 128 + m * 16; const float g = rowgate[row];
#pragma unroll
                for (int bj = 0; bj < 2; ++bj) { float o[8];
#pragma unroll
                    for (int i = 0; i < 8; ++i) o[i] = __builtin_amdgcn_fmed3f(((float)acc[ai][bj][m][i >> 2][i & 3] * s8[bj][i] + b8[bj][i]) * g, -448.0f, 448.0f);
                    u32x2 w; w.x = 0; w.y = 0;
                    w.x = __builtin_amdgcn_cvt_pk_fp8_f32(o[0], o[1], w.x, false); w.x = __builtin_amdgcn_cvt_pk_fp8_f32(o[2], o[3], w.x, true);
                    w.y = __builtin_amdgcn_cvt_pk_fp8_f32(o[4], o[5], w.y, false); w.y = __builtin_amdgcn_cvt_pk_fp8_f32(o[6], o[7], w.y, true);
                    *(u32x2*)(YB + (size_t)row * 2048 + c0 + bj * 128) = w; } }
    }
};
__device__ __forceinline__ void rg_local(unsigned char* ws, LAS unsigned char* lds, int ubeg, int ustride) {
    CArgs& a = *kargs();
    const int tid = threadIdx.x, wave = __builtin_amdgcn_readfirstlane(tid >> 6), lane = tid & 63, fr = lane & 15, fq = lane >> 4;
    LAS bf16_t* XCB = (LAS bf16_t*)lds;
    LAS float* XCF = (LAS float*)(lds + 17408);
    LAS float* AF = (LAS float*)(lds + 17408 + 32768);
    LAS float* BF = (LAS float*)(lds + 17408 + 65536);
    LAS float* QA = (LAS float*)(lds + 17408 + 98304);
    LAS float* QH = QA + 512;
    const bf16_t* XR = (const bf16_t*)(ws + WS_XR); const bf16_t* WRGT = (const bf16_t*)(ws + WS_WRGT);
    bf16_t* HL = (bf16_t*)(ws + WS_HL); bf16_t* ACUM = (bf16_t*)(ws + WS_ACUM); float* ACH = (float*)(ws + WS_ACH); float* HCH = (float*)(ws + WS_HCH);
    int n_cur = -1; f32x4 w0, w1, w2, w3, bb; float ba = 0.f, bx = 0.f, sp8 = 0.f; bf16x8 br[4], bi[4];
    const int c4 = (tid & 31) * 4, tg = tid >> 5, d0 = 16 * wave;
    u32x2 xr[7];
#define RG_LOADX(uu) do { const int t0_ = 64 * ((uu) >> 3), ch_ = 128 * ((uu) & 7) + c4;                                                              \
        _Pragma("unroll") for (int i = 0; i < 7; ++i) { const int tt = t0_ + 4 * tg - 3 + i; xr[i] = tt >= 0 ? *(const u32x2*)(XR + (size_t)tt * 1024 + ch_) : (u32x2){0u, 0u}; } } while (0)
    if (ubeg < 2048) RG_LOADX(ubeg);
    for (int u = ubeg; u < 2048; u += ustride) {
        const int j = u >> 3, n = u & 7, t0 = 64 * j, cb = 128 * n;
        if (n != n_cur) { n_cur = n; const int ch = cb + c4;
            w0 = *(const f32x4*)(a.in[I_CONV_W] + ch); w1 = *(const f32x4*)(a.in[I_CONV_W] + 1024 + ch); w2 = *(const f32x4*)(a.in[I_CONV_W] + 2048 + ch); w3 = *(const f32x4*)(a.in[I_CONV_W] + 3072 + ch);
            bb = *(const f32x4*)(a.in[I_CONV_B] + ch);
            const int chd = cb + d0 + fr; ba = a.in[I_B_RG_A][chd]; bx = a.in[I_B_RG_X][chd]; sp8 = 8.0f * log1pf(__expf(-a.in[I_RG_LAMBDA][chd]));
#pragma unroll
            for (int s = 0; s < 4; ++s) { br[s] = *(const bf16x8*)(WRGT + ((size_t)(0 * 8 + n) * 128 + d0 + fr) * 128 + 32 * s + 8 * fq); bi[s] = *(const bf16x8*)(WRGT + ((size_t)(1 * 8 + n) * 128 + d0 + fr) * 128 + 32 * s + 8 * fq); } }
        {
            f32x4 x[7];
#pragma unroll
            for (int i = 0; i < 7; ++i) x[i] = (f32x4){bflo(xr[i].x), bfhi(xr[i].x), bflo(xr[i].y), bfhi(xr[i].y)};
#pragma unroll
            for (int i = 0; i < 4; ++i) { const f32x4 xc = bb + w0 * x[i] + w1 * x[i + 1] + w2 * x[i + 2] + w3 * x[i + 3]; const int t = 4 * tg + i;
                *(LAS f32x4*)(XCF + t * 128 + c4) = xc; u32x2 pk; pk.x = pk2(xc[0], xc[1]); pk.y = pk2(xc[2], xc[3]); *(LAS u32x2*)(XCB + t * 136 + c4) = pk; }
            if (u + ustride < 2048) RG_LOADX(u + ustride);
        }
        __syncthreads();
        {
            f32x4 ar[4], ai[4];
#pragma unroll
            for (int m = 0; m < 4; ++m) { ar[m] = (f32x4){0.f, 0.f, 0.f, 0.f}; ai[m] = (f32x4){0.f, 0.f, 0.f, 0.f}; }
#pragma unroll
            for (int s = 0; s < 4; ++s) {
#pragma unroll
                for (int m = 0; m < 4; ++m) { const bf16x8 af = *(const LAS bf16x8*)(XCB + (16 * m + fr) * 136 + 32 * s + 8 * fq);
                    ar[m] = __builtin_amdgcn_mfma_f32_16x16x32_bf16(af, br[s], ar[m], 0, 0, 0); ai[m] = __builtin_amdgcn_mfma_f32_16x16x32_bf16(af, bi[s], ai[m], 0, 0, 0); }
            }
            const int d = d0 + fr;
#pragma unroll
            for (int m = 0; m < 4; ++m)
#pragma unroll
                for (int r = 0; r < 4; ++r) { const int t = 16 * m + 4 * fq + r;
                    const float rg = sigmoidf_(ar[m][r] + ba), ig = sigmoidf_(ai[m][r] + bx), la = -sp8 * rg, y = -2.0f * la;
                    const float em = (y > 0.5f) ? -expm1f(-y) : y * (1.0f + y * (-0.5f + y * (0.16666667f + y * (-0.041666668f + y * (0.0083333338f + y * -0.0013888889f)))));
                    AF[t * 128 + d] = __expf(la); BF[t * 128 + d] = sqrtf(em) * (ig * XCF[t * 128 + d]); }
        }
        __syncthreads();
        {
            const int c = tid & 127, q = tid >> 7; float hv[16], pv[16]; float h = 0.f, P = 1.f;
#pragma unroll
            for (int i = 0; i < 16; ++i) { const float av = AF[(16 * q + i) * 128 + c]; h = av * h + BF[(16 * q + i) * 128 + c]; P *= av; hv[i] = h; pv[i] = P; }
            QA[q * 128 + c] = P; QH[q * 128 + c] = h;
            __syncthreads();
            float hin = 0.f, pin = 1.f;
            for (int qq = 0; qq < q; ++qq) { const float qa = QA[qq * 128 + c]; hin = qa * hin + QH[qq * 128 + c]; pin *= qa; }
#pragma unroll
            for (int i = 0; i < 16; ++i) { const float hh = hv[i] + pv[i] * hin, pp = pv[i] * pin;
                BF[(16 * q + i) * 128 + c] = hh; AF[(16 * q + i) * 128 + c] = pp;
                if (q == 3 && i == 15) { ACH[(size_t)j * 1024 + cb + c] = pp; HCH[(size_t)j * 1024 + cb + c] = hh; } }
        }
        __syncthreads();
        {
            const int c4 = (tid & 31) * 4, r = tid >> 5;
#pragma unroll
            for (int p = 0; p < 4; ++p) { const int t = r + 16 * p; const size_t g = (size_t)(t0 + t) * 1024 + cb + c4;
                const f32x4 hh = *(const LAS f32x4*)(BF + t * 128 + c4), pp = *(const LAS f32x4*)(AF + t * 128 + c4);
                u32x2 o; o.x = pk2(hh[0], hh[1]); o.y = pk2(hh[2], hh[3]); *(u32x2*)(HL + g) = o;
                o.x = pk2(pp[0], pp[1]); o.y = pk2(pp[2], pp[3]); *(u32x2*)(ACUM + g) = o; }
        }
        __syncthreads();
    }
}

#undef RG_LOADX
__device__ __forceinline__ void carry_scan(unsigned char* ws, LAS unsigned char* lds, int G) {
    const int tid = threadIdx.x, wave = __builtin_amdgcn_readfirstlane(tid >> 6), lane = tid & 63;
    const float* ACH = (const float*)(ws + WS_ACH); const float* HCH = (const float*)(ws + WS_HCH); float* CARRY = (float*)(ws + WS_CARRY);
    LAS f32x4* WTA = (LAS f32x4*)lds; LAS f32x4* WTH = (LAS f32x4*)(lds + 64);
    for (int cg = blockIdx.x; cg < 256; cg += G) {
        f32x4 A4 = {1.f, 1.f, 1.f, 1.f}, H4 = {0.f, 0.f, 0.f, 0.f};
        if (tid < 256) { A4 = *(const f32x4*)(ACH + (size_t)tid * 1024 + 4 * cg); H4 = *(const f32x4*)(HCH + (size_t)tid * 1024 + 4 * cg); }
#pragma unroll
        for (int off = 1; off < 64; off <<= 1) {
            f32x4 pa, ph;
#pragma unroll
            for (int i = 0; i < 4; ++i) { pa[i] = __shfl_up(A4[i], off); ph[i] = __shfl_up(H4[i], off); }
            if (lane >= off) { H4 = A4 * ph + H4; A4 = A4 * pa; }
        }
        if (tid < 256 && lane == 63) { WTA[wave] = A4; WTH[wave] = H4; }
        __syncthreads();
        if (tid < 256) {
            f32x4 ph = {0.f, 0.f, 0.f, 0.f};
            for (int w = 0; w < wave; ++w) { const f32x4 ta = WTA[w], th = WTH[w]; ph = ta * ph + th; }
            const f32x4 hinc = A4 * ph + H4;
            if (tid + 1 < 256) *(f32x4*)(CARRY + (size_t)(tid + 1) * 1024 + 4 * cg) = hinc;
            if (tid == 0) *(f32x4*)(CARRY + 4 * cg) = (f32x4){0.f, 0.f, 0.f, 0.f};
        }
        __syncthreads();
    }
}

__device__ __forceinline__ void convert_late_weights(unsigned char* ws, LAS unsigned char* lds, int G) {
    CArgs& a = *kargs(); const int wave = wave_id(), lane = lane_id();
    LAS float* scr = (LAS float*)(lds + wave * 16384);
    const int gw = blockIdx.x * NWAVES + wave, NGW = G * NWAVES;
    convert_strips_i8(a.in[I_W_OUT], 2048, (signed char*)(ws + WS_WOUT), (float*)(ws + WS_SBOUT), lds, blockIdx.x, G);
    convert_strips_i8<true>(a.in[I_W_CQ], 2048, (signed char*)(ws + WS_WCQ), (float*)(ws + WS_SBCQ), lds, ((int)blockIdx.x + G - 64) % G, G, a.in[I_NORM_CROSS_G]);
    convert_strips_i8<true>(a.in[I_W_CO], 2048, (signed char*)(ws + WS_WCO), (float*)(ws + WS_SBCO), lds, ((int)blockIdx.x + G - 128) % G, G);
    __syncthreads();
}
constexpr size_t WS_VT8 = WS_ACT;
__device__ __forceinline__ float v_fp8_scale(const unsigned char* ws, int head) { const float am = __uint_as_float(((const unsigned*)(ws + WS_CTL))[CW_VMAX + head]); return am > 0.f ? 240.0f / am : 1.0f; }
constexpr size_t WS_Q8 = WS_VT8 + 16 * MiB, WS_K8 = WS_VT8 + 24 * MiB;
__device__ __forceinline__ float fp8_amax_scale(const unsigned char* ws, int word) { const float am = __uint_as_float(((const unsigned*)(ws + WS_CTL))[CW_VMAX + word]); return am > 0.f ? 240.0f / am : 1.0f; }
__device__ __forceinline__ int qk_fp8_shift(const unsigned char* ws, int head) { int e; (void)frexpf(fp8_amax_scale(ws, 4 + head) * fp8_amax_scale(ws, 8 + head) * (1.0f / 0.12751743f), &e); return e - 1; }
__device__ __forceinline__ float qk_fp8_scale(const unsigned char* ws, int which, int head) {
    const float sk = fp8_amax_scale(ws, 8 + head); if (which) return sk;
    return 0.12751743f * ldexpf(1.0f, qk_fp8_shift(ws, head)) / sk; }
__device__ __forceinline__ void convert_v_fp8(unsigned char* ws, LAS unsigned char* lds, int G) {
    const int wave = wave_id(), lane = lane_id();
    for (int i = blockIdx.x * NTHREADS + threadIdx.x; i < 2 * 4 * S_ * 16; i += G * NTHREADS) {
        const int which = i >> 20, head = (i >> 18) & 3, rem = i & ((1 << 18) - 1);
        const float sc = qk_fp8_scale(ws, which, head);
        const u32x4 w = *(const u32x4*)((const bf16_t*)(ws + (which ? WS_K : WS_Q)) + (size_t)(2 * head + 1) * S_ * 128 + (size_t)rem * 8);
        unsigned b0 = 0, b1 = 0;
        b0 = __builtin_amdgcn_cvt_pk_fp8_f32(bflo(w.x) * sc, bfhi(w.x) * sc, b0, false); b0 = __builtin_amdgcn_cvt_pk_fp8_f32(bflo(w.y) * sc, bfhi(w.y) * sc, b0, true);
        b1 = __builtin_amdgcn_cvt_pk_fp8_f32(bflo(w.z) * sc, bfhi(w.z) * sc, b1, false); b1 = __builtin_amdgcn_cvt_pk_fp8_f32(bflo(w.w) * sc, bfhi(w.w) * sc, b1, true);
        u32x2 o; o.x = b0; o.y = b1;
        *(u32x2*)(ws + (which ? WS_K8 : WS_Q8) + (size_t)head * S_ * 128 + (size_t)rem * 8) = o;
    }
    LAS unsigned char* T = lds + wave * 8192;
    for (int job = blockIdx.x * NWAVES + wave; job < 2048; job += G * NWAVES) {
        const int head = job >> 9, tile = (job >> 1) & 255, half = job & 1;
        const float vs = v_fp8_scale(ws, head);
        const bf16_t* src = (const bf16_t*)(ws + WS_V) + ((size_t)head * S_ + (size_t)tile * 64) * 256 + half * 128;
#pragma unroll 4
        for (int i = 0; i < 16; ++i) { const int idx = i * 64 + lane, key = idx >> 4, ch = idx & 15;
            const u32x4 w = *(const u32x4*)(src + (size_t)key * 256 + ch * 8);
            const int kp = key & 31, pos = ((kp >> 2) & 1) * 32 + (key >> 5) * 16 + (kp & 3) + 4 * (kp >> 3);
            unsigned b0 = 0, b1 = 0;
            b0 = __builtin_amdgcn_cvt_pk_fp8_f32(bflo(w.x) * vs, bfhi(w.x) * vs, b0, false); b0 = __builtin_amdgcn_cvt_pk_fp8_f32(bflo(w.y) * vs, bfhi(w.y) * vs, b0, true);
            b1 = __builtin_amdgcn_cvt_pk_fp8_f32(bflo(w.z) * vs, bfhi(w.z) * vs, b1, false); b1 = __builtin_amdgcn_cvt_pk_fp8_f32(bflo(w.w) * vs, bfhi(w.w) * vs, b1, true);
            LAS unsigned char* d = T + (ch * 8) * 64 + pos;
            d[0 * 64] = (unsigned char)b0; d[1 * 64] = (unsigned char)(b0 >> 8); d[2 * 64] = (unsigned char)(b0 >> 16); d[3 * 64] = (unsigned char)(b0 >> 24);
            d[4 * 64] = (unsigned char)b1; d[5 * 64] = (unsigned char)(b1 >> 8); d[6 * 64] = (unsigned char)(b1 >> 16); d[7 * 64] = (unsigned char)(b1 >> 24); }
        LDS_WAIT(); asm volatile("" ::: "memory");
        unsigned char* dst = ws + WS_VT8 + (((size_t)head * 256 + tile) * 256 + half * 128) * 64;
#pragma unroll
        for (int i = 0; i < 8; ++i) { const int idx = i * 64 + lane; *(u32x4*)(dst + (size_t)idx * 16) = *(const LAS u32x4*)(T + idx * 16); }
        LDS_WAIT(); asm volatile("" ::: "memory");
    }
    __syncthreads();
}

constexpr int CW_SQ = 12352;
constexpr int CW_ATTQ = 8192;
__device__ __forceinline__ void attn_phase(unsigned char* ws, char* lds, volatile LAS unsigned* MISC, int G) {
    const int c = blockIdx.x, hp = (c & 7) >> 1;
    unsigned* qctr = (unsigned*)(ws + WS_CTL) + CW_ATTQ + 64 * hp;
    if (G != 256) {
        for (int L = c; L < 512; L += G) { const int u = L & 7;
            if ((u & 1) == 0) att2::attn_block_b16((const bf16_t*)(ws + WS_Q) + (size_t)u * S_ * 128, (const bf16_t*)(ws + WS_K) + (size_t)u * S_ * 128, (const bf16_t*)(ws + WS_V) + (size_t)(u >> 1) * S_ * 256,
                                                   (bf16_t*)(ws + WS_AO) + (size_t)u * S_ * 256, L >> 3, lds);
            else att2::attn_block(ws + WS_Q8 + (size_t)(u >> 1) * S_ * 128, ws + WS_K8 + (size_t)(u >> 1) * S_ * 128, qk_fp8_shift(ws, u >> 1), ws + WS_VT8 + (size_t)(u >> 1) * 256 * 16384, 1.0f / v_fp8_scale(ws, u >> 1),
                                  (bf16_t*)(ws + WS_AO) + (size_t)u * S_ * 256, L >> 3, lds); }
        return; }
    constexpr unsigned NSTRIP_E = 6144u, NSTRIP = NSTRIP_E + 192u;
    unsigned* sq = (unsigned*)(ws + WS_CTL) + CW_SQ;
    bool sq_empty = false;
    auto convert_run = [&](int n) {
        if (sq_empty || n <= 0) return;
        if (threadIdx.x == 0) MISC[17] = __hip_atomic_fetch_add(sq, (unsigned)n, __ATOMIC_RELAXED, __HIP_MEMORY_SCOPE_AGENT);
        __syncthreads();
        const unsigned s0 = MISC[17];
        __syncthreads();
        if (s0 >= NSTRIP) { sq_empty = true; return; }
        unsigned s1 = s0 + (unsigned)n; if (s1 >= NSTRIP) { s1 = NSTRIP; sq_empty = true; }
        unsigned char* w2 = kargs()->ws;
        if (s0 < NSTRIP_E) convert_expert_strips(w2, (LAS unsigned char*)lds, (int)s0, 1, (int)(s1 < NSTRIP_E ? s1 : NSTRIP_E));
        if (s1 > NSTRIP_E) { CArgs& a = *kargs(); const int l0 = (int)(s0 > NSTRIP_E ? s0 - NSTRIP_E : 0u), l1 = (int)(s1 - NSTRIP_E);
            if (l0 < 64) convert_strips_i8(a.in[I_W_OUT], 2048, (signed char*)(w2 + WS_WOUT), (float*)(w2 + WS_SBOUT), (LAS unsigned char*)lds, l0, 1, nullptr, l1 < 64 ? l1 : 64);
            if (l0 < 128 && l1 > 64) convert_strips_i8<true>(a.in[I_W_CQ], 2048, (signed char*)(w2 + WS_WCQ), (float*)(w2 + WS_SBCQ), (LAS unsigned char*)lds, (l0 > 64 ? l0 : 64) - 64, 1, a.in[I_NORM_CROSS_G], (l1 < 128 ? l1 : 128) - 64);
            if (l1 > 128) convert_strips_i8<true>(a.in[I_W_CO], 2048, (signed char*)(w2 + WS_WCO), (float*)(w2 + WS_SBCO), (LAS unsigned char*)lds, (l0 > 128 ? l0 : 128) - 128, 1, nullptr, l1 - 128);
            __syncthreads(); }
    };
    const int cohort = (c >> 3) & 3; int ndone = 0;
    if (cohort == 0) convert_run(24);
    for (;;) {
        if (threadIdx.x == 0) MISC[16] = __hip_atomic_fetch_add(qctr, 1u, __ATOMIC_RELAXED, __HIP_MEMORY_SCOPE_AGENT);
        __syncthreads();
        const unsigned idx = MISC[16];
        __syncthreads();
        if (idx >= 128u) break;
        const int qb = 63 - (int)(idx >> 1);
        {
            unsigned char* w2 = kargs()->ws; const int u = (((int)blockIdx.x & 7) & ~1) | (int)(idx & 1u);
            if ((idx & 1u) == 0) att2::attn_block_b16((const bf16_t*)(w2 + WS_Q) + (size_t)u * S_ * 128, (const bf16_t*)(w2 + WS_K) + (size_t)u * S_ * 128, (const bf16_t*)(w2 + WS_V) + (size_t)(u >> 1) * S_ * 256,
                                                      (bf16_t*)(w2 + WS_AO) + (size_t)u * S_ * 256, qb, lds);
            else att2::attn_block(w2 + WS_Q8 + (size_t)(u >> 1) * S_ * 128, w2 + WS_K8 + (size_t)(u >> 1) * S_ * 128, qk_fp8_shift(w2, u >> 1), w2 + WS_VT8 + (size_t)(u >> 1) * 256 * 16384,
                                  1.0f / v_fp8_scale(w2, u >> 1), (bf16_t*)(w2 + WS_AO) + (size_t)u * S_ * 256, qb, lds); }
        ++ndone;
        if (ndone == 1) { if (cohort != 0) { const int tw = (4 * qb + 4) * ((idx & 1u) ? 2 : 3) / 3; convert_run(48 - tw / 8); } }
        else convert_run(4);
    }
    while (!sq_empty) convert_run(8);
}

__device__ __forceinline__ void post_mix(unsigned char* ws, int G) {
    CArgs& a = *kargs(); const int wave = wave_id(), lane = lane_id();
    const int gw = blockIdx.x * NWAVES + wave, NGW = G * NWAVES;
    float s1 = 0.f, s2 = 0.f;
    for (int i = lane; i < 128; i += 64) { s1 += a.in[I_LQ1][i] * a.in[I_LK1][i]; s2 += a.in[I_LQ2][i] * a.in[I_LK2][i]; }
    const float lam = __expf(wave_sum(s1)) - __expf(wave_sum(s2)) + LAMBDA_INIT;
    const bf16_t* AO = (const bf16_t*)(ws + WS_AO); const bf16_t* XG = (const bf16_t*)(ws + WS_XG);
    const bf16_t* HL = (const bf16_t*)(ws + WS_HL); const bf16_t* ACUM = (const bf16_t*)(ws + WS_ACUM); const float* CARRY = (const float*)(ws + WS_CARRY);
    const int d = 4 * lane;
    const f32x4 sg = *(const f32x4*)(a.in[I_SUBLN_G] + d);
    signed char* MIX8 = (signed char*)(ws + WS_MIX); float* MIXSCALE = (float*)(ws + WS_MIXSCALE);
    struct RowIn { u32x2 o0[4], o1[4], hl[4], ac[4], xg[4]; f32x4 cr[4]; };
    f32x4 rg[4];
#pragma unroll
    for (int j = 0; j < 4; ++j) rg[j] = *(const f32x4*)(a.in[I_REC_NORM_G] + 4 * lane + 256 * j);
    auto load_row = [&](int t, RowIn& R) {
#pragma unroll
        for (int hh = 0; hh < 4; ++hh) { R.o0[hh] = *(const u32x2*)(AO + ((size_t)(hh * 2 + 0) * S_ + t) * 256 + d); R.o1[hh] = *(const u32x2*)(AO + ((size_t)(hh * 2 + 1) * S_ + t) * 256 + d); }
        const int chunk = t >> 6;
#pragma unroll
        for (int j = 0; j < 4; ++j) { const int c = 4 * lane + 256 * j;
            R.hl[j] = *(const u32x2*)(HL + (size_t)t * 1024 + c); R.ac[j] = *(const u32x2*)(ACUM + (size_t)t * 1024 + c); R.xg[j] = *(const u32x2*)(XG + (size_t)t * 1024 + c); R.cr[j] = *(const f32x4*)(CARRY + (size_t)chunk * 1024 + c); }
    };
    auto finish_row = [&](int t, const RowIn& R) {
        f32x4 av[4]; float am = 0.f;
#pragma unroll
        for (int hh = 0; hh < 4; ++hh) { const u32x2 o0 = R.o0[hh], o1 = R.o1[hh];
            f32x4 v; v[0] = bflo(o0.x) - lam * bflo(o1.x); v[1] = bfhi(o0.x) - lam * bfhi(o1.x); v[2] = bflo(o0.y) - lam * bflo(o1.y); v[3] = bfhi(o0.y) - lam * bfhi(o1.y);
            const float ss = wave_sum((v[0] * v[0] + v[1] * v[1]) + (v[2] * v[2] + v[3] * v[3]));
            const float r = rsqrtf(ss * (1.f / 256.f) + DA_EPS_) * (1.0f - LAMBDA_INIT);
            av[hh] = (f32x4){v[0] * r * sg[0], v[1] * r * sg[1], v[2] * r * sg[2], v[3] * r * sg[3]};
            am = fmaxf(fmaxf(am, fmaxf(fabsf(av[hh][0]), fabsf(av[hh][1]))), fmaxf(fabsf(av[hh][2]), fabsf(av[hh][3]))); }
        f32x4 y[4]; float ss = 0.f;
#pragma unroll
        for (int j = 0; j < 4; ++j) { const u32x2 hl2 = R.hl[j], ac2 = R.ac[j], xg = R.xg[j]; const f32x4 cr = R.cr[j];
            const f32x4 hl = {bflo(hl2.x), bfhi(hl2.x), bflo(hl2.y), bfhi(hl2.y)}, ac = {bflo(ac2.x), bfhi(ac2.x), bflo(ac2.y), bfhi(ac2.y)};
            const f32x4 h = hl + ac * cr;
            y[j][0] = h[0] * gelu_tanh(bflo(xg.x)); y[j][1] = h[1] * gelu_tanh(bfhi(xg.x)); y[j][2] = h[2] * gelu_tanh(bflo(xg.y)); y[j][3] = h[3] * gelu_tanh(bfhi(xg.y));
            ss += (y[j][0] * y[j][0] + y[j][1] * y[j][1]) + (y[j][2] * y[j][2] + y[j][3] * y[j][3]); }
        const float r = rsqrtf(wave_sum(ss) * (1.f / 1024.f) + EPS_);
#pragma unroll
        for (int j = 0; j < 4; ++j) { const f32x4 g = rg[j];
            y[j] = (f32x4){y[j][0] * r * g[0], y[j][1] * r * g[1], y[j][2] * r * g[2], y[j][3] * r * g[3]};
            am = fmaxf(fmaxf(am, fmaxf(fabsf(y[j][0]), fabsf(y[j][1]))), fmaxf(fabsf(y[j][2]), fabsf(y[j][3]))); }
#pragma unroll
        for (int o = 32; o > 0; o >>= 1) am = fmaxf(am, __shfl_xor(am, o));
        const float inv = am > 0.f ? 127.0f / am : 0.f;
#define PM_Q8(V) __builtin_amdgcn_perm(__builtin_amdgcn_perm(__float_as_uint(fmaf(V[3], inv, 12582912.0f)), __float_as_uint(fmaf(V[2], inv, 12582912.0f)), 0x0c0c0400u), \
                                       __builtin_amdgcn_perm(__float_as_uint(fmaf(V[1], inv, 12582912.0f)), __float_as_uint(fmaf(V[0], inv, 12582912.0f)), 0x0c0c0400u), 0x05040100u)
#pragma unroll
        for (int hh = 0; hh < 4; ++hh) *(unsigned*)(MIX8 + (size_t)t * DM + hh * 256 + d) = PM_Q8(av[hh]);
#pragma unroll
        for (int j = 0; j < 4; ++j) *(unsigned*)(MIX8 + (size_t)t * DM + 1024 + 4 * lane + 256 * j) = PM_Q8(y[j]);
#undef PM_Q8
        if (lane == 0) MIXSCALE[t] = am > 0.f ? am * (1.0f / 127.0f) : 1.0f;
    };
    for (int t0 = gw; t0 < S_; t0 += 2 * NGW) {
        const int t1 = t0 + NGW; const bool two = t1 < S_;
        RowIn A, B; load_row(t0, A); load_row(two ? t1 : t0, B);
        finish_row(t0, A); if (two) finish_row(t1, B);
    }
}

__device__ __forceinline__ void ffn_norm_router(unsigned char* ws, LAS unsigned char* lds, int G) {
    CArgs& a = *kargs();
    const int tid = threadIdx.x, wave = __builtin_amdgcn_readfirstlane(tid >> 6), lane = tid & 63, fr = lane & 15, fq = lane >> 4;
    LAS float* XF = (LAS float*)lds;
    LAS float* PL = (LAS float*)lds;
    LAS float* LG = (LAS float*)(lds + 16384);
    LAS int* CNT = (LAS int*)(lds + 16384 + 2048);
    const bf16_t* H = (const bf16_t*)(ws + WS_H); signed char* XQ = (signed char*)(ws + WS_XN); float* TOKSCALE = (float*)(ws + WS_TOKSCALE); const float* WR = a.in[I_W_ROUTER];
    int* TOPE = (int*)(ws + WS_TOPE); float* TOPG = (float*)(ws + WS_TOPG); int* TCNT = (int*)(ws + WS_TCNT);
    for (int tile = blockIdx.x; tile < 1024; tile += G) {
        u32x2 raw[2][8];
#pragma unroll
        for (int rr = 0; rr < 2; ++rr) { const bf16_t* xr = H + ((size_t)tile * 16 + wave * 2 + rr) * DM + 4 * lane;
#pragma unroll
            for (int j = 0; j < 8; ++j) raw[rr][j] = *(const u32x2*)(xr + 256 * j); }
#pragma unroll
        for (int rr = 0; rr < 2; ++rr) { const int row = wave * 2 + rr; const size_t t = (size_t)tile * 16 + row;
            const f32x4* gr = (const f32x4*)a.in[I_NORM_FFN_G] + lane;
            f32x4 v[8]; float s = 0.f;
#pragma unroll
            for (int j = 0; j < 8; ++j) { const u32x2 w = raw[rr][j]; v[j] = (f32x4){bflo(w.x), bfhi(w.x), bflo(w.y), bfhi(w.y)}; s += (v[j].x * v[j].x + v[j].y * v[j].y) + (v[j].z * v[j].z + v[j].w * v[j].w); }
            const float r = rsqrtf(wave_sum(s) * (1.f / 2048.f) + EPS_);
            float am = 0.f;
#pragma unroll
            for (int j = 0; j < 8; ++j) { const f32x4 gg = gr[64 * j]; v[j] = (f32x4){v[j].x * r * gg.x, v[j].y * r * gg.y, v[j].z * r * gg.z, v[j].w * r * gg.w};
                am = fmaxf(fmaxf(am, fmaxf(fabsf(v[j].x), fabsf(v[j].y))), fmaxf(fabsf(v[j].z), fabsf(v[j].w)));
                *(LAS f32x4*)(XF + row * 2052 + 4 * lane + 256 * j) = v[j]; }
#pragma unroll
            for (int o = 1; o < 64; o <<= 1) am = fmaxf(am, __shfl_xor(am, o));
            const float inv = am > 0.f ? 127.0f / am : 0.f;
            unsigned* o4 = (unsigned*)(XQ + t * DM) + lane;
#pragma unroll
            for (int j = 0; j < 8; ++j) { const int q0 = (int)rintf(v[j].x * inv), q1 = (int)rintf(v[j].y * inv), q2 = (int)rintf(v[j].z * inv), q3 = (int)rintf(v[j].w * inv);
                o4[64 * j] = ((unsigned)q0 & 0xffu) | (((unsigned)q1 & 0xffu) << 8) | (((unsigned)q2 & 0xffu) << 16) | (((unsigned)q3 & 0xffu) << 24); }
            if (lane == 0) TOKSCALE[t] = am > 0.f ? am * (1.0f / 127.0f) : 1.0f;
        }
        __syncthreads();
        f32x4 c0 = {0.f, 0.f, 0.f, 0.f}, c1 = {0.f, 0.f, 0.f, 0.f};
#pragma unroll 8
        for (int s = 0; s < 64; ++s) { const int k = 256 * wave + 4 * s + fq;
            const float af = XF[fr * 2052 + k], b0 = WR[(size_t)k * 32 + fr], b1 = WR[(size_t)k * 32 + 16 + fr];
            c0 = __builtin_amdgcn_mfma_f32_16x16x4f32(af, b0, c0, 0, 0, 0); c1 = __builtin_amdgcn_mfma_f32_16x16x4f32(af, b1, c1, 0, 0, 0); }
        __syncthreads();
#pragma unroll
        for (int r = 0; r < 4; ++r) { PL[(wave * 16 + fq * 4 + r) * 32 + fr] = c0[r]; PL[(wave * 16 + fq * 4 + r) * 32 + 16 + fr] = c1[r]; }
        if (tid < 32) CNT[tid] = 0;
        __syncthreads();
        { const int row = tid >> 5, e = tid & 31; float lg = a.in[I_B_ROUTER][e];
#pragma unroll
          for (int w = 0; w < 8; ++w) lg += PL[(w * 16 + row) * 32 + e];
          __syncthreads();
          LG[row * 32 + e] = lg; }
        __syncthreads();
        if (tid < 16) { const int row = tid; const size_t t = (size_t)tile * 16 + row; unsigned mask = 0u; float tv[4]; int te[4];
            for (int k = 0; k < 4; ++k) { float best = -__builtin_inff(); int bi = 0;
                for (int e = 0; e < 32; ++e) { const float x = LG[row * 32 + e]; if (!((mask >> e) & 1u) && x > best) { best = x; bi = e; } }
                mask |= 1u << bi; tv[k] = best; te[k] = bi; }
            float ex[4], sum = 0.f;
            for (int k = 0; k < 4; ++k) { ex[k] = __expf(tv[k] - tv[0]); sum += ex[k]; }
            const float inv = 1.0f / sum;
            for (int k = 0; k < 4; ++k) { TOPE[t * 4 + k] = te[k]; TOPG[t * 4 + k] = ex[k] * inv; __hip_atomic_fetch_add(&CNT[te[k]], 1, __ATOMIC_RELAXED, __HIP_MEMORY_SCOPE_WORKGROUP); }
        }
        __syncthreads();
        if (tid < 32) TCNT[tile * 32 + tid] = CNT[tid];
        __syncthreads();
    }
}

__device__ __forceinline__ void moe_route(unsigned char* ws, LAS unsigned char* lds, int G) {
    const int tid = threadIdx.x, wave = __builtin_amdgcn_readfirstlane(tid >> 6), lane = tid & 63;
    LAS int* TC = (LAS int*)lds;
    LAS int* PS = (LAS int*)(lds + 131072);
    LAS int* PPRE = (LAS int*)(lds + 133120);
    LAS int* TOT = (LAS int*)(lds + 135168);
    LAS int* PADSTART = (LAS int*)(lds + 135296);
    LAS int* SELPOS = (LAS int*)(lds + 135552);
    LAS int* SELTOK = (LAS int*)(lds + 135808);
    const int* TCNT = (const int*)(ws + WS_TCNT); const int* TOPE = (const int*)(ws + WS_TOPE); const float* TOPG = (const float*)(ws + WS_TOPG);
    int* POSOF = (int*)(ws + WS_POSOF); float* ROWGATE = (float*)(ws + WS_ROWGATE); int* TILEEXP = (int*)(ws + WS_TILEEXP); int* NRT = (int*)(ws + WS_NRT);
    int* SRCTOK = (int*)(ws + WS_SRCTOK); const float* TOKSCALE = (const float*)(ws + WS_TOKSCALE); float* ROWSCALE = (float*)(ws + WS_ROWSCALE);
    for (int i = tid; i < 8192; i += NTHREADS) *(LAS u32x4*)(TC + 4 * i) = *(const u32x4*)(TCNT + 4 * i);
    __syncthreads();
    { const int e = tid & 31, part = tid >> 5; int run = 0;
      for (int i = 0; i < 64; ++i) { const int idx = (part * 64 + i) * 32 + e; const int v = TC[idx]; TC[idx] = run; run += v; }
      PS[part * 32 + e] = run; }
    __syncthreads();
    if (tid < 32) { int run = 0; for (int p = 0; p < 16; ++p) { PPRE[p * 32 + tid] = run; run += PS[p * 32 + tid]; } TOT[tid] = run; }
    __syncthreads();
    if (tid == 0) { int run = 0;
        for (int e = 0; e < 32; ++e) { PADSTART[e] = run; const int pad = (TOT[e] + 255) & ~255;
            if (blockIdx.x == 0) for (int rt = run >> 8; rt < (run + pad) >> 8; ++rt) TILEEXP[rt] = e;
            run += pad; }
        PADSTART[32] = run; if (blockIdx.x == 0) NRT[0] = run >> 8; }
    __syncthreads();
    if (blockIdx.x == 0) for (int e = 0; e < 32; ++e) for (int p = PADSTART[e] + TOT[e] + tid; p < PADSTART[e + 1]; p += NTHREADS) SRCTOK[p] = 0;
    const int slot = wave & 3, half = wave >> 2;
    for (int it = 0; half == 0; ++it) {
        const int tile = blockIdx.x + (4 * it + slot) * G; if (tile >= 1024) break;
        const int m = lane, row = m >> 2, k = m & 3; const size_t t = (size_t)tile * 16 + row;
        const int e = TOPE[t * 4 + k]; const float g = TOPG[t * 4 + k]; int rank = 0;
        for (int mm = 0; mm < 64; ++mm) { const int em = __shfl(e, mm); rank += (mm < m && em == e) ? 1 : 0; }
        const int pos = PADSTART[e] + PPRE[(tile >> 6) * 32 + e] + TC[tile * 32 + e] + rank;
        if (half == 0) { ROWGATE[pos] = g; ROWSCALE[pos] = TOKSCALE[t]; POSOF[t * 4 + k] = pos; SRCTOK[pos] = (int)t; }
    }
}

__device__ __forceinline__ void final_combine(unsigned char* ws, int G) {
    CArgs& a = *kargs(); const int wave = wave_id(), lane = lane_id();
    const int gw = blockIdx.x * NWAVES + wave, NGW = G * NWAVES;
    const bf16_t* H = (const bf16_t*)(ws + WS_H); const unsigned char* YB = (const unsigned char*)(ws + WS_YB); const int* POSOF = (const int*)(ws + WS_POSOF);
    f32x4 gg[8];
#pragma unroll
    for (int j = 0; j < 8; ++j) gg[j] = ((const f32x4*)a.in[I_NORM_FINAL_G] + lane)[64 * j];
    for (int t0 = gw; t0 < S_; t0 += 2 * NGW) {
        const int t1 = t0 + NGW; const bool two = t1 < S_; const int tb = two ? t1 : t0;
        int pa[4], pb[4];
#pragma unroll
        for (int k = 0; k < 4; ++k) { pa[k] = POSOF[(size_t)t0 * 4 + k]; pb[k] = POSOF[(size_t)tb * 4 + k]; }
        f32x4 va[8], vb[8];
        { const bf16_t* xa = H + (size_t)t0 * DM + 4 * lane; const bf16_t* xb = H + (size_t)tb * DM + 4 * lane;
#pragma unroll
          for (int j = 0; j < 8; ++j) { va[j] = ld_bf16x4(xa + 256 * j); vb[j] = ld_bf16x4(xb + 256 * j); } }
        unsigned ya[4][8], yb[4][8];
#pragma unroll
        for (int k = 0; k < 4; ++k) { const unsigned* ra = (const unsigned*)(YB + (size_t)pa[k] * DM) + lane; const unsigned* rb = (const unsigned*)(YB + (size_t)pb[k] * DM) + lane;
#pragma unroll
            for (int j = 0; j < 8; ++j) { ya[k][j] = ra[64 * j]; yb[k][j] = rb[64 * j]; } }
#define FC_FINISH(V, Y, T) do {                                                                                                                         \
        _Pragma("unroll") for (int k = 0; k < 4; ++k) _Pragma("unroll") for (int j = 0; j < 8; ++j) { const unsigned y = Y[k][j];                        \
            const auto lo = __builtin_amdgcn_cvt_pk_f32_fp8(y, false), hi = __builtin_amdgcn_cvt_pk_f32_fp8(y, true);                                    \
            V[j].x += lo[0] * (1.0f / YB_SCALE); V[j].y += lo[1] * (1.0f / YB_SCALE); V[j].z += hi[0] * (1.0f / YB_SCALE); V[j].w += hi[1] * (1.0f / YB_SCALE); } \
        float s = 0.f;                                                                                                                                   \
        _Pragma("unroll") for (int j = 0; j < 8; ++j) s += (V[j].x * V[j].x + V[j].y * V[j].y) + (V[j].z * V[j].z + V[j].w * V[j].w);                   \
        const float r = rsqrtf(wave_sum(s) * (1.f / 2048.f) + EPS_);                                                                                    \
        f32x4* o = (f32x4*)(a.out + (size_t)(T) * DM) + lane;                                                                                           \
        _Pragma("unroll") for (int j = 0; j < 8; ++j) o[64 * j] = (f32x4){V[j].x * r * gg[j].x, V[j].y * r * gg[j].y, V[j].z * r * gg[j].z, V[j].w * r * gg[j].w}; } while (0)
        FC_FINISH(va, ya, t0);
        if (two) FC_FINISH(vb, yb, t1);
#undef FC_FINISH
    }
}

__global__ void __launch_bounds__(NTHREADS, 2) fwd_kernel(Args args) {
    extern __shared__ __attribute__((aligned(16))) unsigned char lds_raw[];
    LAS unsigned char* lds = (LAS unsigned char*)lds_raw;
    volatile LAS unsigned* MISC = (volatile LAS unsigned*)(lds + MISC_OFF);
    const int tid = threadIdx.x;
    const int G = gridDim.x, c = blockIdx.x;
    CArgs* ka = kargs();
    unsigned char* ws = ka->ws;
    unsigned* ctl = (unsigned*)(ws + WS_CTL);
    for (int u = tid; u < 64; u += NTHREADS) MISC[u] = 0u;
    __syncthreads();
    const int lo = ka->ph_lo, hi = ka->ph_hi;
    const bool multi = (hi - lo) > 1;
    XcdBarrier bar; bar.bar = ctl + CW_BAR; bar.x = 0; bar.st = nullptr;
    if (multi) bar = xcd_barrier_post(ctl + CW_BAR, MISC + 8);
#define IN(k) (lo <= (k) && (k) < hi)
#define SEAM(k) do { if (IN(k) && IN((k) + 1)) xcd_barrier(bar); } while (0)

    if (IN(0)) { p0_prologue(ws, lds, G); }
    SEAM(0);
    if (IN(1)) {
        pg8::Gemm g{DM / 2, DM / 2, DM / 2}; pg8::DenseOrder O; O.init(ws + WS_XN, ws + WS_WIN, S_, NIN, DM / 2, DM / 2, G, c);
        EpiInProjI8 E{EpiInProj{(bf16_t*)(ws + WS_Q), (bf16_t*)(ws + WS_XR), ctl + CW_VMAX}, (const float*)(ws + WS_INSCALE), (const float*)(ws + WS_SBIN)};
        pg8::gemm_phase<EpiInProjI8, pg8::DenseOrder, true, true>(lds, g, O, E);
    }
    SEAM(1);
    if (IN(2)) { rg_local(ws, lds, c, G); __syncthreads(); convert_v_fp8(ws, lds, G); }
    SEAM(2);
    if (IN(3)) {
        carry_scan(ws, lds, G);
        if (c < 16) {
            pg8::Gemm g{DM, DM, DM}; SmallOrder O{(const char*)(ws + WS_MEMN), (const char*)(ws + WS_WCKV), c};
            EpiSmall E{(bf16_t*)(ws + WS_KM), (bf16_t*)(ws + WS_VT)};
            pg8::gemm_phase<EpiSmall, SmallOrder, true>(lds, g, O, E); }
        attn_phase(ws, (char*)lds_raw, MISC, G);
    }
    SEAM(3);
    if (IN(4)) { post_mix(ws, G); }
    SEAM(4);
    if (IN(5)) {
        pg8::Gemm g{DM / 2, DM / 2, DM / 2}; pg8::DenseOrder O; O.init(ws + WS_MIX, ws + WS_WOUT, S_, DM, DM / 2, DM / 2, G, c);
        EpiResNormI8 E{EpiResNormF32{kargs()->in[I_X], (bf16_t*)(ws + WS_H), (unsigned char*)(ws + WS_XN), (float*)(ws + WS_SSQ)}, (const float*)(ws + WS_MIXSCALE), (const float*)(ws + WS_SBOUT)};
        pg8::gemm_phase<EpiResNormI8, pg8::DenseOrder, true, true>(lds, g, O, E);
    }
    SEAM(5);
    if (IN(7)) {
        pg8::Gemm g{DM / 2, DM / 2, DM / 2}; pg8::DenseOrder O; O.init(ws + WS_XN, ws + WS_WCQ, S_, DM, DM / 2, DM / 2, G, c);
        LAS float* RL = (LAS float*)(lds + 131072);
        { const float* SSQ = (const float*)(ws + WS_SSQ);
          for (int it = tid; it < 8 * 256; it += NTHREADS) { const int ui = it >> 8, row = it & 255; pg8::Unit u;
              if (O.next(ui, u)) { const f32x4* p = (const f32x4*)(SSQ + (size_t)(u.pm * 256 + row) * 32); f32x4 a4 = p[0];
#pragma unroll
                  for (int j = 1; j < 8; ++j) a4 += p[j];
                  RL[it] = rsqrtf(((a4[0] + a4[1]) + (a4[2] + a4[3])) * (1.f / 2048.f) + EPS_); } }
          __syncthreads(); }
        EpiBf16RowScale E{(bf16_t*)(ws + WS_QC), DM, RL, (const float*)(ws + WS_SBCQ)};
        pg8::gemm_phase<EpiBf16RowScale, pg8::DenseOrder, true, false, true>(lds, g, O, E);
    }
    SEAM(7);
    if (IN(8)) {
        pg8::Gemm g{512, DM, DM}; HeadOrderS O{(const char*)(ws + WS_QC), (const char*)(ws + WS_KM), G, c};
        EpiScore E{(bf16_t*)(ws + WS_PC), (float*)(ws + WS_LPART)};
        pg8::gemm_phase<EpiScore, HeadOrderS, true>(lds, g, O, E);
    }
    if (G != 256) SEAM(8);
    if (IN(9)) {
        pg8::Gemm g{256, 1024, 256}; HeadOrderO O{(const char*)(ws + WS_PC), (const char*)(ws + WS_VT), G, c};
        EpiCrossO E{(unsigned char*)(ws + WS_OC), (const float*)(ws + WS_LPART)};
        pg8::gemm_phase<EpiCrossO, HeadOrderO, true>(lds, g, O, E);
    }
    SEAM(9);
    if (IN(10)) {
        pg8::Gemm g{DM / 2, DM / 2, DM / 2}; pg8::DenseOrder O; O.init(ws + WS_OC, ws + WS_WCO, S_, DM, DM / 2, DM / 2, G, c);
        EpiResF32 E{(const bf16_t*)(ws + WS_H), (bf16_t*)(ws + WS_H), (const float*)(ws + WS_SBCO), 1.0f / 16.0f};
        pg8::gemm_phase<EpiResF32, pg8::DenseOrder, true, false, true>(lds, g, O, E);
    }
    SEAM(10);
    if (IN(11)) { ffn_norm_router(ws, lds, G); }
    SEAM(11);
    if (IN(12)) { moe_route(ws, lds, G); }
    SEAM(12);
    if (IN(13)) {
        pg8::Gemm g{DM / 2, DM / 2, DM / 2}; GroupOrderG O{(const char*)(ws + WS_XN), (const char*)(ws + WS_WGU), (const int*)(ws + WS_TILEEXP), (const int*)(ws + WS_SRCTOK), (size_t)4096 * 2048, (size_t)256 * 2048, *(const int*)(ws + WS_NRT), 16, G, c};
        EpiGateUpI8 E{(signed char*)(ws + WS_ACT), kargs()->in[I_B_GU], (const float*)(ws + WS_ROWSCALE), (const float*)(ws + WS_SBGU)};
        pg8::gemm_phase<EpiGateUpI8, GroupOrderG, true, true>(lds, g, O, E);
    }
    SEAM(13);
    if (IN(14)) {
        pg8::Gemm g{DM / 2, DM / 2, DM / 2}; GroupOrder O{(const char*)(ws + WS_ACT), (const char*)(ws + WS_WDN), (const int*)(ws + WS_TILEEXP), (size_t)2048 * 2048, (size_t)256 * 2048, *(const int*)(ws + WS_NRT), 8, G, c};
        EpiDown E{(unsigned char*)(ws + WS_YB), kargs()->in[I_B_DN], (const float*)(ws + WS_ROWGATE), (const float*)(ws + WS_SBDN)};
        pg8::gemm_phase<EpiDown, GroupOrder, true, true>(lds, g, O, E);
    }
    SEAM(14);
    if (IN(15)) { final_combine(ws, G); }
#undef IN
#undef SEAM
}

extern "C" void kernel_launch(void* const* d_in, const int* in_sizes, int n_in, void* d_out, int out_size, void* d_ws, size_t ws_size, hipStream_t stream) {
    static int grid = 0;
    if (grid == 0) {
        if (n_in != 31 || out_size != S_ * DM || ws_size < WS_END) { fprintf(stderr, "kernel_launch: unexpected shapes (n_in %d, out %d, ws %zu); nothing launched\n", n_in, out_size, ws_size); grid = -1; return; }
        int dev = 0, cus = 0, per_cu = 0;
        if (hipGetDevice(&dev) != hipSuccess || hipDeviceGetAttribute(&cus, hipDeviceAttributeMultiprocessorCount, dev) != hipSuccess) { grid = -1; return; }
        if (hipFuncSetAttribute((const void*)fwd_kernel, hipFuncAttributeMaxDynamicSharedMemorySize, LDS_BYTES) != hipSuccess) { fprintf(stderr, "kernel_launch: hipFuncSetAttribute failed\n"); grid = -1; return; }
        if (hipOccupancyMaxActiveBlocksPerMultiprocessor(&per_cu, (const void*)fwd_kernel, NTHREADS, LDS_BYTES) != hipSuccess || per_cu < 1)
            fprintf(stderr, "kernel_launch: occupancy query reports %d workgroups per CU\n", per_cu);
        (void)hipGetLastError();
        grid = cus;
    }
    if (grid < 0) return;
    if (hipMemsetAsync((char*)d_ws + WS_CTL, 0, CTL_ZERO_BYTES, stream) != hipSuccess) return;
    Args a{};
    for (int i = 0; i < 31; ++i) a.in[i] = (const float*)d_in[i];
    a.out = (float*)d_out; a.ws = (unsigned char*)d_ws;
#if MK_N_LAUNCHES == 1
    a.ph_lo = 0; a.ph_hi = N_PHASES;
    hipLaunchKernelGGL(fwd_kernel, dim3(grid), dim3(NTHREADS), LDS_BYTES, stream, a);
#else
    for (int p = 0; p < N_PHASES; ++p) { a.ph_lo = p; a.ph_hi = p + 1; hipLaunchKernelGGL(fwd_kernel, dim3(grid), dim3(NTHREADS), LDS_BYTES, stream, a);
#ifdef PROBE_DUP_MASK
        if ((PROBE_DUP_MASK >> p) & 1) hipLaunchKernelGGL(fwd_kernel, dim3(grid), dim3(NTHREADS), LDS_BYTES, stream, a);
#endif
    }
#endif
}
```
